# Optimizing an MI355X kernel written in HIP

```python
import jax, jax.numpy as jnp
from jax import lax
import numpy as np

D_MODEL = 2048
BATCH = 4
SEQ = 2048
DEPTH = 2

GRID_W = 64
CTX_LEN = 256
CONV_W = 1024
CONV_K = 3
MLA_HEADS = 8
MLA_NOPE = 128
MLA_ROPE = 64
MLA_V = 128
Q_LORA = 512
KV_LORA = 256
MLA_W = MLA_HEADS * MLA_V
MLA_SCALE = (MLA_NOPE + MLA_ROPE) ** -0.5
NA_HEADS = 16
NA_HD = 64
NA_W = NA_HEADS * NA_HD
NA_KH = 8
NA_KW = 16
NA_SCALE = NA_HD ** -0.5
FNET_GROUPS = 4
FNET_GW = 256
FNET_W = FNET_GROUPS * FNET_GW

N_BRANCH = 4
Q_BLOCK = 128
ROPE_THETA = 10000.0
EPS = 1e-6
IN_WIDTHS = (KV_LORA + MLA_ROPE, NA_W, NA_W, Q_LORA, NA_W, CONV_W, CONV_W, CONV_W, FNET_W,
             CONV_W, MLA_W, NA_W, FNET_W, N_BRANCH * D_MODEL)
KV_COLS = KV_LORA + MLA_ROPE + 2 * NA_W
N_IN = sum(IN_WIDTHS)

kernel_name = 'hybrid_parallel_mixer_diffusion_block'


def _split(h, widths):
    offs = np.cumsum(widths)[:-1].tolist()
    return jnp.split(h, offs, axis=-1)


def _rmsnorm(x, g):
    xf = x.astype(jnp.float32)
    y = xf * lax.rsqrt(jnp.mean(xf * xf, axis=-1, keepdims=True) + EPS)
    return (y * g.astype(jnp.float32)).astype(x.dtype)


def _heads(t, h, d):
    return t.reshape(t.shape[0], t.shape[1], h, d)


def _axial_rope(x):
    n = x.shape[1]
    nf = MLA_ROPE // 4
    t = jnp.arange(n, dtype=jnp.int32)
    pos = jnp.stack([t // GRID_W, t % GRID_W], axis=-1).astype(jnp.float32)
    inv = ROPE_THETA ** (-jnp.arange(nf, dtype=jnp.float32) / nf)
    ang = pos[:, :, None] * inv
    cos = jnp.cos(ang)[None, :, None]
    sin = jnp.sin(ang)[None, :, None]
    xr = x.astype(jnp.float32).reshape(x.shape[:-1] + (2, 2, nf))
    a, b = xr[..., 0, :], xr[..., 1, :]
    out = jnp.stack([a * cos - b * sin, a * sin + b * cos], axis=-2)
    return out.reshape(x.shape).astype(x.dtype)


def _dense_attention(q, k, v, scale):
    b, s, h, d = q.shape
    nb = s // Q_BLOCK
    qb = q.reshape(b, nb, Q_BLOCK, h, d).swapaxes(0, 1)

    def one(qi):
        sc = jnp.einsum('bqhd,bkhd->bhqk', qi, k, preferred_element_type=jnp.float32) * scale
        p = jax.nn.softmax(sc, axis=-1).astype(v.dtype)
        return jnp.einsum('bhqk,bkhv->bqhv', p, v)

    out = lax.map(one, qb)
    return out.swapaxes(0, 1).reshape(b, s, h, v.shape[-1])


def _neighbourhood_attention(q, k, v, kc, vc, rpb):
    b, s, h, d = q.shape
    rows = s // GRID_W
    kh = min(NA_KH, rows)
    kw = NA_KW
    qg = q.reshape(b, rows, GRID_W, h, d).swapaxes(0, 1)
    kg = k.reshape(b, rows, GRID_W, h, d)
    vg = v.reshape(b, rows, GRID_W, h, d)
    row_start = jnp.clip(jnp.arange(rows, dtype=jnp.int32) - kh // 2, 0, rows - kh)
    cols = jnp.arange(GRID_W, dtype=jnp.int32)
    col_idx = jnp.clip(cols - kw // 2, 0, GRID_W - kw)[:, None] + jnp.arange(kw, dtype=jnp.int32)
    col_off = col_idx - cols[:, None] + (NA_KW - 1)

    def one(args):
        r, qr = args
        rs = row_start[r]
        kn = lax.dynamic_slice_in_dim(kg, rs, kh, axis=1)[:, :, col_idx]
        vn = lax.dynamic_slice_in_dim(vg, rs, kh, axis=1)[:, :, col_idx]
        row_off = rs + jnp.arange(kh, dtype=jnp.int32) - r + (NA_KH - 1)
        bias = rpb[:, row_off[None, :, None], col_off[:, None, :]].astype(jnp.float32)
        s_nb = jnp.einsum('bchd,bicjhd->bhcij', qr, kn, preferred_element_type=jnp.float32) * NA_SCALE + bias
        s_cx = jnp.einsum('bchd,bkhd->bhck', qr, kc, preferred_element_type=jnp.float32) * NA_SCALE
        logits = jnp.concatenate([s_nb.reshape(b, h, GRID_W, kh * kw), s_cx], axis=-1)
        p = jax.nn.softmax(logits, axis=-1).astype(v.dtype)
        p_nb = p[..., :kh * kw].reshape(b, h, GRID_W, kh, kw)
        p_cx = p[..., kh * kw:]
        return (jnp.einsum('bhcij,bicjhd->bchd', p_nb, vn)
                + jnp.einsum('bhck,bkhd->bchd', p_cx, vc))

    out = lax.map(one, (jnp.arange(rows, dtype=jnp.int32), qg))
    return out.swapaxes(0, 1).reshape(b, s, h * d)


def _short_conv(z, w):
    return lax.conv_general_dilated(z, w.astype(z.dtype)[:, None, :], (1,),
                                    [(CONV_K // 2, CONV_K // 2)],
                                    dimension_numbers=('NWC', 'WIO', 'NWC'),
                                    feature_group_count=z.shape[-1])


def _fourier(v):
    b, n, _ = v.shape
    f = jnp.fft.fft2(v.astype(jnp.float32).reshape(b, n, FNET_GROUPS, FNET_GW), axes=(1, 3), norm='ortho')
    return f.real.reshape(b, n, FNET_W).astype(v.dtype)


def _mla_kv(h, g_kv, w_ukv, rotate):
    b, n, _ = h.shape
    c_kv, k_r = _split(h, (KV_LORA, MLA_ROPE))
    kv = (_rmsnorm(c_kv, g_kv) @ w_ukv).reshape(b, n, MLA_HEADS, MLA_NOPE + MLA_V)
    k_nope, v = _split(kv, (MLA_NOPE, MLA_V))
    k_r = k_r[:, :, None, :]
    if rotate:
        k_r = _axial_rope(k_r)
    k = jnp.concatenate([k_nope, jnp.broadcast_to(k_r, (b, n, MLA_HEADS, MLA_ROPE))], axis=-1)
    return k, v


def _mla_q(h, g_q, w_uq, rotate):
    b, n, _ = h.shape
    q = (_rmsnorm(h, g_q) @ w_uq).reshape(b, n, MLA_HEADS, MLA_NOPE + MLA_ROPE)
    q_nope, q_r = _split(q, (MLA_NOPE, MLA_ROPE))
    if rotate:
        q_r = _axial_rope(q_r)
    return jnp.concatenate([q_nope, q_r], axis=-1)


def _combine(parts, mla_o, na_o, conv_w, w_p_conv, w_p_mla, w_p_na, w_p_fnet, w_out):
    cb, cc, cx, fv, g_cv, g_ml, g_na, g_fn, mg = parts[5:]
    conv_o = cb * _short_conv(cc * cx, conv_w)
    fn_o = _fourier(fv)
    b, n, _ = mg.shape
    gates = jax.nn.sigmoid(mg).reshape(b, n, N_BRANCH, D_MODEL)
    branches = ((conv_o, g_cv, w_p_conv), (mla_o, g_ml, w_p_mla), (na_o, g_na, w_p_na), (fn_o, g_fn, w_p_fnet))
    m = gates[:, :, 0] * ((conv_o * jax.nn.silu(g_cv)) @ w_p_conv)
    for i in range(1, N_BRANCH):
        o, g, w = branches[i]
        m = m + gates[:, :, i] * ((o * jax.nn.silu(g)) @ w)
    return m @ w_out


def _layer(xc, xl, c, c_ctx, g_pre, g_post, w_ada, b_ada, w_in, g_q, g_kv, w_uq, w_ukv,
           conv_w, na_rpb, w_p_conv, w_p_mla, w_p_na, w_p_fnet, w_out, ctx_out):
    shl, scl, gtl = jnp.split(jax.nn.silu(c) @ w_ada + b_ada, 3, axis=-1)
    shc, scc, gtc = jnp.split(jax.nn.silu(c_ctx) @ w_ada + b_ada, 3, axis=-1)
    ul = _rmsnorm(xl, g_pre) * (1 + scl[:, None]) + shl[:, None]
    uc = _rmsnorm(xc, g_pre) * (1 + scc) + shc
    b, s, _ = xl.shape

    pl = _split(ul @ w_in, IN_WIDTHS)
    if ctx_out:
        pc = _split(uc @ w_in, IN_WIDTHS)
    else:
        pc = _split(uc @ w_in[:, :KV_COLS], IN_WIDTHS[:3])

    kc_m, vc_m = _mla_kv(pc[0], g_kv, w_ukv, False)
    kc_n = _heads(pc[1], NA_HEADS, NA_HD)
    vc_n = _heads(pc[2], NA_HEADS, NA_HD)

    kl_m, vl_m = _mla_kv(pl[0], g_kv, w_ukv, True)
    ql_m = _mla_q(pl[3], g_q, w_uq, True)
    mla_l = _dense_attention(ql_m, jnp.concatenate([kc_m, kl_m], axis=1),
                             jnp.concatenate([vc_m, vl_m], axis=1), MLA_SCALE).reshape(b, s, MLA_W)
    na_l = _neighbourhood_attention(_heads(pl[4], NA_HEADS, NA_HD), _heads(pl[1], NA_HEADS, NA_HD),
                                    _heads(pl[2], NA_HEADS, NA_HD), kc_n, vc_n, na_rpb)
    yl = _combine(pl, mla_l, na_l, conv_w, w_p_conv, w_p_mla, w_p_na, w_p_fnet, w_out)
    xl_new = xl + gtl[:, None] * _rmsnorm(yl, g_post)

    if not ctx_out:
        return None, xl_new
    qc_m = _mla_q(pc[3], g_q, w_uq, False)
    mla_c = _dense_attention(qc_m, kc_m, vc_m, MLA_SCALE).reshape(xc.shape[0], xc.shape[1], MLA_W)
    na_c = _dense_attention(_heads(pc[4], NA_HEADS, NA_HD), kc_n, vc_n, NA_SCALE).reshape(xc.shape[0], xc.shape[1], NA_W)
    yc = _combine(pc, mla_c, na_c, conv_w, w_p_conv, w_p_mla, w_p_na, w_p_fnet, w_out)
    xc_new = xc + gtc * _rmsnorm(yc, g_post)
    return xc_new, xl_new


def setup_inputs(seed: int = 0) -> dict:
    key = jax.random.key(seed)
    ks = jax.random.split(key, 20)

    def nrm(k, shape, scale):
        return jax.random.normal(k, shape, jnp.float32) * scale

    return {
        'x': nrm(ks[0], (BATCH, SEQ, D_MODEL), 1.0),
        'c': nrm(ks[1], (BATCH, D_MODEL), 1.0),
        'ctx': nrm(ks[2], (BATCH, CTX_LEN, D_MODEL), 1.0),
        'c_ctx': nrm(ks[3], (D_MODEL,), 1.0),
        'g_pre': 1.0 + nrm(ks[4], (DEPTH, D_MODEL), 0.05),
        'g_post': 1.0 + nrm(ks[5], (DEPTH, D_MODEL), 0.05),
        'w_ada': nrm(ks[6], (DEPTH, D_MODEL, 3 * D_MODEL), 0.5 * D_MODEL ** -0.5),
        'b_ada': nrm(ks[7], (DEPTH, 3 * D_MODEL), 0.02),
        'w_in': nrm(ks[8], (DEPTH, D_MODEL, N_IN), D_MODEL ** -0.5),
        'g_q': 1.0 + nrm(ks[9], (DEPTH, Q_LORA), 0.05),
        'g_kv': 1.0 + nrm(ks[10], (DEPTH, KV_LORA), 0.05),
        'w_uq': nrm(ks[11], (DEPTH, Q_LORA, MLA_HEADS * (MLA_NOPE + MLA_ROPE)), Q_LORA ** -0.5),
        'w_ukv': nrm(ks[12], (DEPTH, KV_LORA, MLA_HEADS * (MLA_NOPE + MLA_V)), KV_LORA ** -0.5),
        'conv_w': nrm(ks[13], (DEPTH, CONV_K, CONV_W), CONV_K ** -0.5),
        'na_rpb': nrm(ks[14], (DEPTH, NA_HEADS, 2 * NA_KH - 1, 2 * NA_KW - 1), 0.1),
        'w_p_conv': nrm(ks[15], (DEPTH, CONV_W, D_MODEL), CONV_W ** -0.5),
        'w_p_mla': nrm(ks[16], (DEPTH, MLA_W, D_MODEL), MLA_W ** -0.5),
        'w_p_na': nrm(ks[17], (DEPTH, NA_W, D_MODEL), NA_W ** -0.5),
        'w_p_fnet': nrm(ks[18], (DEPTH, FNET_W, D_MODEL), FNET_W ** -0.5),
        'w_out': nrm(ks[19], (DEPTH, D_MODEL, D_MODEL), D_MODEL ** -0.5),
    }


def reference(x, c, ctx, c_ctx, g_pre, g_post, w_ada, b_ada, w_in, g_q, g_kv, w_uq, w_ukv,
              conv_w, na_rpb, w_p_conv, w_p_mla, w_p_na, w_p_fnet, w_out):
    xl, xc = x, ctx
    for i in range(DEPTH):
        xc, xl = _layer(xc, xl, c, c_ctx, g_pre[i], g_post[i], w_ada[i], b_ada[i], w_in[i],
                        g_q[i], g_kv[i], w_uq[i], w_ukv[i], conv_w[i], na_rpb[i],
                        w_p_conv[i], w_p_mla[i], w_p_na[i], w_p_fnet[i], w_out[i],
                        i < DEPTH - 1)
    return xl
```

```cpp
#include <hip/hip_runtime.h>
#include <hip/hip_cooperative_groups.h>
#include <cstdio>
#include <cstdint>
namespace cg = cooperative_groups;
#ifndef PROBE_DUP
#define PROBE_DUP -1
#endif

#define GAS __attribute__((address_space(1)))
typedef unsigned short bf16_t;
typedef GAS bf16_t gbf;
typedef GAS float gf32;
typedef GAS unsigned char gu8;
typedef float f32x4 __attribute__((ext_vector_type(4)));
typedef unsigned u32x4 __attribute__((ext_vector_type(4)));
typedef unsigned u32x2 __attribute__((ext_vector_type(2)));

constexpr int DM = 2048, NB = 4, SEQ = 2048, CTXL = 256, DEPTH = 2;
constexpr int NLAT = NB * SEQ, NCTX = NB * CTXL, NROW = NLAT + NCTX;
constexpr int N_IN = 20288, NP = 20480;
constexpr int PP = 12288 + 64;
constexpr int KP2 = DM + 64;
constexpr int KP1 = 1024 + 64;
constexpr int KP4 = 4096 + 64;
constexpr int C_CKV = 0, C_KR = 256, C_NAK = 512, C_NAV = 1536, C_QL = 2560, C_NAQ = 3072, C_CB = 4096, C_CC = 5120, C_CX = 6144, C_FV = 7168,
              C_GCV = 8192, C_GML = 9216, C_GNA = 10240, C_GFN = 11264, C_MG = 12288;
constexpr int KVC_P = 2560;
constexpr int KMW = 1536, VMW = 1024, QMW = 1536, ABW = 4160;
constexpr float EPS = 1e-6f;
constexpr float LOG2E = 1.4426950408889634f;
constexpr float QSCALE = 0.07216878364870322f * LOG2E;
constexpr float NASCALE = 0.125f * LOG2E;
constexpr int NTHREADS = 512, NWAVES = 8;
constexpr int LDS_BYTES = 147456;

constexpr size_t al256(size_t x) { return (x + 255) / 256 * 256; }
constexpr size_t WS_WIN = 0;
constexpr size_t WS_WUKV = WS_WIN + al256((size_t)2 * NP * KP2 * 2);
constexpr size_t WS_WUQ = WS_WUKV + al256((size_t)2 * 2048 * 256 * 2);
constexpr size_t WS_WP = WS_WUQ + al256((size_t)2 * 1536 * 512 * 2);
constexpr size_t WS_WO = WS_WP + al256((size_t)2 * 4 * 2048 * KP1 * 2);
constexpr size_t WS_MOD = WS_WO + al256((size_t)2 * 2048 * KP2 * 2);
constexpr size_t WS_ROPE = WS_MOD + al256((size_t)2 * 5 * 6144 * 4);
constexpr size_t WS_DC = WS_ROPE + al256((size_t)64 * 16 * 2 * 4);
constexpr size_t WS_DN = WS_DC + al256((size_t)512 * 256 * 2);
constexpr size_t WS_DNC = WS_DN + al256((size_t)2048 * KP4 * 2);
constexpr size_t WS_U = WS_DNC + al256((size_t)256 * 512 * 2);
constexpr size_t WS_P = WS_U + al256((size_t)NROW * KP2 * 2);
constexpr size_t WS_KM = WS_P + al256((size_t)NROW * PP * 2);
constexpr size_t WS_VM = WS_KM + al256((size_t)NROW * KMW * 2);
constexpr size_t WS_QM = WS_VM + al256((size_t)NROW * VMW * 2);
constexpr size_t WS_AB = WS_QM + al256((size_t)NROW * QMW * 2);
constexpr size_t WS_GT = WS_AB + al256((size_t)NROW * ABW * 2);
constexpr size_t WS_GTC = WS_GT + al256((size_t)4 * 1024 * KP4 * 2);
constexpr size_t WS_MF = WS_GTC + al256((size_t)4 * 1024 * 512 * 2);
constexpr size_t WS_MB = WS_MF + al256((size_t)NROW * DM * 4);
constexpr size_t WS_Y = WS_MB + al256((size_t)NROW * KP2 * 2);
constexpr size_t WS_RKV = WS_Y + al256((size_t)NROW * DM * 4);
constexpr size_t WS_RQ = WS_RKV + al256((size_t)NROW * 4);
constexpr size_t WS_XL = WS_RQ + al256((size_t)NROW * 4);
constexpr size_t WS_NK = WS_XL + al256((size_t)NROW * DM * 4);
constexpr size_t WS_NV = WS_NK + al256((size_t)NROW * 1024 * 2);
constexpr size_t WS_NQ = WS_NV + al256((size_t)NROW * 1024 * 2);
constexpr size_t WS_MG = WS_NQ + al256((size_t)NROW * 1024 * 2);
constexpr size_t WS_SSQ = WS_MG + al256((size_t)4 * NROW * DM * 2);
constexpr size_t WS_BAR = WS_SSQ + al256((size_t)NCTX * 8 * 4);
constexpr size_t WS_END = WS_BAR + 16384;

struct Params { const gf32* in[20]; gf32* out; gu8* ws; };
enum { I_X = 0, I_C, I_CTX, I_CCTX, I_GPRE, I_GPOST, I_WADA, I_BADA, I_WIN, I_GQ, I_GKV, I_WUQ, I_WUKV, I_CONVW, I_RPB, I_WPC, I_WPM, I_WPN, I_WPF, I_WOUT };

__device__ __forceinline__ size_t hm_row(int r, int h, int NH) {
    return r < NLAT ? (size_t)(((r >> 11) * NH + h) * SEQ + (r & (SEQ - 1))) : (size_t)NB * NH * SEQ + (size_t)((((r - NLAT) >> 8) * NH + h) * CTXL + ((r - NLAT) & (CTXL - 1)));
}

__device__ __forceinline__ size_t mg_off(int z, int r, int c) { return ((((size_t)z * (NROW / 256) + (r >> 8)) * (DM / 256) + (c >> 8)) * 256 + (r & 255)) * 256 + (c & 255); }

__device__ __forceinline__ unsigned f2bf(float f) { unsigned u = __builtin_bit_cast(unsigned, f); return (u + 0x7fffu + ((u >> 16) & 1u)) >> 16; }
typedef float f32x2_t __attribute__((ext_vector_type(2))); typedef __bf16 bf16x2_t __attribute__((ext_vector_type(2)));
__device__ __forceinline__ unsigned pk2(float lo, float hi) { f32x2_t v = {lo, hi}; bf16x2_t b = __builtin_convertvector(v, bf16x2_t); return __builtin_bit_cast(unsigned, b); }
__device__ __forceinline__ float bf2f(unsigned short b) { return __builtin_bit_cast(float, (unsigned)b << 16); }
__device__ __forceinline__ float bflo(unsigned w) { return __builtin_bit_cast(float, w << 16); }
__device__ __forceinline__ float bfhi(unsigned w) { return __builtin_bit_cast(float, w & 0xffff0000u); }
__device__ __forceinline__ u32x2 pk4(f32x4 v) { u32x2 r; r.x = pk2(v[0], v[1]); r.y = pk2(v[2], v[3]); return r; }
__device__ __forceinline__ u32x4 pk8(f32x4 a, f32x4 b) { u32x4 r; r.x = pk2(a[0], a[1]); r.y = pk2(a[2], a[3]); r.z = pk2(b[0], b[1]); r.w = pk2(b[2], b[3]); return r; }
__device__ __forceinline__ void unpk8(u32x4 w, f32x4& a, f32x4& b) { a = (f32x4){bflo(w.x), bfhi(w.x), bflo(w.y), bfhi(w.y)}; b = (f32x4){bflo(w.z), bfhi(w.z), bflo(w.w), bfhi(w.w)}; }
__device__ __forceinline__ f32x4 unpk4(u32x2 w) { return (f32x4){bflo(w.x), bfhi(w.x), bflo(w.y), bfhi(w.y)}; }
__device__ __forceinline__ float sigmoidf_(float x) { return __builtin_amdgcn_rcpf(1.0f + __builtin_amdgcn_exp2f(x * -LOG2E)); }
__device__ __forceinline__ float siluf_(float x) { return x * __builtin_amdgcn_rcpf(1.0f + __builtin_amdgcn_exp2f(x * -LOG2E)); }
__device__ __forceinline__ float wave_sum(float v) {
#pragma unroll
    for (int o = 1; o < 64; o <<= 1) v += __shfl_xor(v, o);
    return v;
}
__device__ __forceinline__ float wave_max(float v) {
#pragma unroll
    for (int o = 1; o < 64; o <<= 1) v = fmaxf(v, __shfl_xor(v, o));
    return v;
}

typedef __attribute__((address_space(4))) const unsigned char* kargp_t;
__device__ __forceinline__ kargp_t karg_op() { kargp_t k = (kargp_t)__builtin_amdgcn_kernarg_segment_ptr(); asm volatile("" : "+s"(k)); return k; }
__device__ __forceinline__ const gf32* pin(int i) { return *(const gf32* const __attribute__((address_space(4)))*)(karg_op() + 8 * i); }
__device__ __forceinline__ gf32* pout() { return *(gf32* const __attribute__((address_space(4)))*)(karg_op() + 8 * 20); }
__device__ __forceinline__ gu8* wsb() { return *(gu8* const __attribute__((address_space(4)))*)(karg_op() + 8 * 21); }
__device__ __forceinline__ int tid_op() { int t = threadIdx.x; asm volatile("" : "+v"(t)); return t; }

struct GemmJob { const gbf* A; int lda; const gbf* Bt; int ldb; int M, N, K; };

#define LAS __attribute__((address_space(3)))
typedef short bf16x8 __attribute__((ext_vector_type(8)));
namespace fg {
constexpr int BM = 256, BK = 64, HALF = 128, HTB = HALF * BK * 2, STAGE_BYTES = 8 * HTB, NXCD = 8, WGM = 4;
__device__ __forceinline__ int lds_byte(int r, int c) { const int st = (r >> 4) * 2 + (c >> 5), rr = r & 15, cc = c & 31, ob = rr * 64 + cc * 2; return st * 1024 + (ob ^ (((ob >> 9) & 1) << 5)); }
__device__ __forceinline__ void stage_rc(int b, int& R, int& C) { const int st = b / 1024, sb = b % 1024, swz = sb ^ (((sb >> 9) & 1) << 5); R = (st >> 1) * 16 + swz / 64; C = (st & 1) * 32 + (swz % 64) / 2; }
__device__ __forceinline__ int perm32(int rho) { const int n = rho >> 4, i = rho & 15; return 8 * (i >> 2) + 4 * n + (i & 3); }
struct Unit { const GAS char* A; const GAS char* B; int pm, pn, z; };
template <class Map> struct Sched {
    Map map; int nM, nN, nz, G, c;
    __device__ __forceinline__ bool next(int i, Unit& u) const {
        const int per = nM * nN, nwg = per * nz; const long L = (long)i * G + c; if (L >= nwg) return false;
        int wgid = (int)L; { const int q = nwg / NXCD, r = nwg % NXCD, xcd = wgid % NXCD, off = wgid / NXCD; wgid = (xcd < r ? xcd * (q + 1) : r * (q + 1) + (xcd - r) * q) + off; }
        const int z = wgid / per, w = wgid % per;
        const int nig = WGM * nN, gidx = w / nig, fm = gidx * WGM, gsz = (nM - fm) < WGM ? (nM - fm) : WGM;
        u.pm = fm + ((w % nig) % gsz); u.pn = (w % nig) / gsz; u.z = z; u.A = (const GAS char*)map.a(z, u.pm); u.B = (const GAS char*)map.b(z, u.pn); return true;
    }
};
template <class Epi, class S_>
__device__ __forceinline__ void gemm(LAS unsigned char* lds, int lda, int ldb, int K, const S_& S, const Epi& E) {
    const int tid = tid_op(), wid = __builtin_amdgcn_readfirstlane(tid >> 6), lane = tid & 63, wr = wid >> 2, wc = wid & 3, fr = lane & 15, fq = lane >> 4;
    int Kop = K; asm volatile("" : "+s"(Kop));
    const int nt = Kop / BK;
    unsigned voffA[2], voffB[2];
#pragma unroll
    for (int i = 0; i < 2; ++i) { int R, C; stage_rc(tid * 16 + i * 8192, R, C); const int Rb = Epi::PERM ? ((R & ~31) + perm32(R & 31)) : R;
        voffA[i] = (unsigned)(R * lda + C) * 2u; voffB[i] = (unsigned)(Rb * ldb + C) * 2u; }
    const size_t kstep = (size_t)(BK * 2);
    const size_t hstepA = (size_t)HALF * lda * 2, hstepB = (size_t)HALF * ldb * 2;
    const unsigned ldsw = (unsigned)wid * 1024u;
    const int aoff = lds_byte(wr * 64 + fr, fq * 8), boff = lds_byte(wc * 32 + fr, fq * 8);
#define FG_SA(b, h) (((b) * 2 + (h)) * HTB)
#define FG_SB(b, h) ((4 + (b) * 2 + (h)) * HTB)
#define FG_STAGE(bufoff, gbase, voff) do { _Pragma("unroll") for (int _i = 0; _i < 2; ++_i) \
        __builtin_amdgcn_global_load_lds((const GAS unsigned*)((const GAS char*)(gbase) + (voff)[_i]), (LAS unsigned*)(lds + (bufoff) + ldsw + _i * 8192), 16, 0, 0); } while (0)
#define FG_LDA(dst, b, h) do { _Pragma("unroll") for (int m = 0; m < 4; ++m) _Pragma("unroll") for (int k = 0; k < 2; ++k) dst[m][k] = *(const LAS bf16x8*)(lds + FG_SA(b, h) + aoff + m * 2048 + k * 1024); } while (0)
#define FG_LDB(dst, b, h) do { _Pragma("unroll") for (int n = 0; n < 2; ++n) _Pragma("unroll") for (int k = 0; k < 2; ++k) dst[n][k] = *(const LAS bf16x8*)(lds + FG_SB(b, h) + boff + n * 2048 + k * 1024); } while (0)
#define FG_MMA(ai, bj, At, Bt) do { __builtin_amdgcn_s_setprio(1); _Pragma("unroll") for (int m = 0; m < 4; ++m) _Pragma("unroll") for (int n = 0; n < 2; ++n) _Pragma("unroll") for (int k = 0; k < 2; ++k) \
        acc[ai][bj][m][n] = __builtin_amdgcn_mfma_f32_16x16x32_bf16(Bt[n][k], At[m][k], acc[ai][bj][m][n], 0, 0, 0); __builtin_amdgcn_s_setprio(0); } while (0)
#define FG_WAIT_V(n) asm volatile("s_waitcnt vmcnt(" #n ")" ::: "memory")
#define FG_WAIT_L(n) asm volatile("s_waitcnt lgkmcnt(" #n ")" ::: "memory")
#define FG_BAR __builtin_amdgcn_s_barrier()
#define FG_SCHED __builtin_amdgcn_sched_barrier(0)
    Unit cur, nxt; int ui = 0;
    if (!S.next(0, cur)) return;
    f32x4 acc[2][2][4][2];
#pragma unroll
    for (int a = 0; a < 2; ++a)
#pragma unroll
        for (int b = 0; b < 2; ++b)
#pragma unroll
            for (int m = 0; m < 4; ++m)
#pragma unroll
                for (int n = 0; n < 2; ++n) acc[a][b][m][n] = (f32x4){0.f, 0.f, 0.f, 0.f};
    bf16x8 At[4][2], B0[2][2], B1[2][2];
    const GAS char* cA = cur.A; const GAS char* cB = cur.B;
    FG_STAGE(FG_SB(0, 0), cB, voffB); FG_STAGE(FG_SB(0, 1), cB + hstepB, voffB); FG_STAGE(FG_SA(0, 0), cA, voffA); FG_STAGE(FG_SA(0, 1), cA + hstepA, voffA);
    if (wr == 1) FG_BAR;
    FG_WAIT_V(2); FG_BAR;
    FG_STAGE(FG_SB(1, 0), cB + kstep, voffB); FG_STAGE(FG_SA(1, 0), cA + kstep, voffA); FG_STAGE(FG_SB(1, 1), cB + hstepB + kstep, voffB);
    FG_WAIT_V(6); FG_BAR;
    for (;;) {
        const bool has_next = S.next(ui + 1, nxt);
        const GAS char* nA = has_next ? nxt.A : cA; const GAS char* nB = has_next ? nxt.B : cB;
        for (int t = 0; t < nt; t += 2) {
            const bool last = (t == nt - 2);
            const GAS char* a1 = cA + (size_t)(t + 1) * kstep;
            const GAS char* a2 = last ? nA : cA + (size_t)(t + 2) * kstep; const GAS char* b2 = last ? nB : cB + (size_t)(t + 2) * kstep;
            const GAS char* a3 = a2 + kstep; const GAS char* b3 = b2 + kstep;
            FG_LDB(B0, 0, 0); FG_LDB(B1, 0, 1); FG_SCHED; FG_LDA(At, 0, 0); FG_STAGE(FG_SA(1, 1), a1 + hstepA, voffA);
            FG_WAIT_V(8); FG_WAIT_L(0); FG_BAR; FG_MMA(0, 0, At, B0); FG_MMA(0, 1, At, B1); FG_BAR; FG_SCHED;
            FG_LDA(At, 0, 1); FG_STAGE(FG_SB(0, 0), b2, voffB); FG_STAGE(FG_SB(0, 1), b2 + hstepB, voffB); FG_STAGE(FG_SA(0, 0), a2, voffA);
            FG_WAIT_V(8); FG_WAIT_L(0); FG_BAR; FG_MMA(1, 0, At, B0); FG_MMA(1, 1, At, B1); FG_BAR; FG_SCHED;
            FG_LDB(B0, 1, 0); FG_LDB(B1, 1, 1); FG_SCHED; FG_LDA(At, 1, 0); FG_STAGE(FG_SA(0, 1), a2 + hstepA, voffA);
            FG_WAIT_V(8); FG_WAIT_L(0); FG_BAR; FG_MMA(0, 0, At, B0); FG_MMA(0, 1, At, B1); FG_BAR; FG_SCHED;
            FG_LDA(At, 1, 1); FG_STAGE(FG_SB(1, 0), b3, voffB); FG_STAGE(FG_SB(1, 1), b3 + hstepB, voffB); FG_STAGE(FG_SA(1, 0), a3, voffA);
            FG_WAIT_V(8); FG_WAIT_L(0); FG_BAR; FG_MMA(1, 0, At, B0); FG_MMA(1, 1, At, B1); FG_BAR; FG_SCHED;
        }
        if (wr == 0) FG_BAR;
        bool keep_acc = false;
        {
            const auto Ez = E.z(cur.z);
            if constexpr (Epi::CHAIN) keep_acc = (cur.z < 3);
#pragma unroll
            for (int ai = 0; ai < 2; ++ai)
#pragma unroll
                for (int m = 0; m < 4; ++m)
#pragma unroll
                    for (int bj = 0; bj < 2; ++bj) {
                        const int row_ = cur.pm * BM + ai * HALF + wr * 64 + m * 16 + fr, col_ = cur.pn * BM + bj * HALF + wc * 32 + (Epi::PERM ? 8 : 4) * fq;
                        if constexpr (Epi::CHAIN) Ez.chain(row_, col_, acc[ai][bj][m][0], acc[ai][bj][m][1], cur.z);
                        else Ez(row_, col_, acc[ai][bj][m][0], acc[ai][bj][m][1]);
                        if (bj == 1 && (m & 1)) asm volatile("" ::: "memory");
                    }
        }
        if (!has_next) break;
        if (!keep_acc) {
#pragma unroll
        for (int a = 0; a < 2; ++a)
#pragma unroll
            for (int b = 0; b < 2; ++b)
#pragma unroll
                for (int m = 0; m < 4; ++m)
#pragma unroll
                    for (int n = 0; n < 2; ++n) acc[a][b][m][n] = (f32x4){0.f, 0.f, 0.f, 0.f};
        }
        cur = nxt; cA = nA; cB = nB; ++ui;
        if (wr == 1) FG_BAR;
    }
    FG_WAIT_V(0);
    FG_BAR;
#undef FG_SA
#undef FG_SB
#undef FG_STAGE
#undef FG_LDA
#undef FG_LDB
#undef FG_MMA
#undef FG_WAIT_V
#undef FG_WAIT_L
#undef FG_BAR
#undef FG_SCHED
}

struct UnitM { const GAS char* A; const GAS char* B; int lda, ldb, nt, pm, pn, z, job; };
template <class EpiM, class SM>
__device__ __forceinline__ void gemm_multi(LAS unsigned char* lds, const SM& S, const EpiM& E) {
    const int tid = tid_op(), wid = __builtin_amdgcn_readfirstlane(tid >> 6), lane = tid & 63, wr = wid >> 2, wc = wid & 3, fr = lane & 15, fq = lane >> 4;
    int sR[2], sRb[2], sC[2];
#pragma unroll
    for (int i = 0; i < 2; ++i) { stage_rc(tid * 16 + i * 8192, sR[i], sC[i]); sRb[i] = (sR[i] & ~31) + perm32(sR[i] & 31); }
    const size_t kstep = (size_t)(BK * 2);
    const unsigned ldsw = (unsigned)wid * 1024u;
    const int aoff = lds_byte(wr * 64 + fr, fq * 8), boff = lds_byte(wc * 32 + fr, fq * 8);
#define FG_SA(b, h) (((b) * 2 + (h)) * HTB)
#define FG_SB(b, h) ((4 + (b) * 2 + (h)) * HTB)
#define FG_STAGE(bufoff, gbase, voff) do { _Pragma("unroll") for (int _i = 0; _i < 2; ++_i) \
        __builtin_amdgcn_global_load_lds((const GAS unsigned*)((const GAS char*)(gbase) + (voff)[_i]), (LAS unsigned*)(lds + (bufoff) + ldsw + _i * 8192), 16, 0, 0); } while (0)
#define FG_LDA(dst, b, h) do { _Pragma("unroll") for (int m = 0; m < 4; ++m) _Pragma("unroll") for (int k = 0; k < 2; ++k) dst[m][k] = *(const LAS bf16x8*)(lds + FG_SA(b, h) + aoff + m * 2048 + k * 1024); } while (0)
#define FG_LDB(dst, b, h) do { _Pragma("unroll") for (int n = 0; n < 2; ++n) _Pragma("unroll") for (int k = 0; k < 2; ++k) dst[n][k] = *(const LAS bf16x8*)(lds + FG_SB(b, h) + boff + n * 2048 + k * 1024); } while (0)
#define FG_MMA(ai, bj, At, Bt) do { __builtin_amdgcn_s_setprio(1); _Pragma("unroll") for (int m = 0; m < 4; ++m) _Pragma("unroll") for (int n = 0; n < 2; ++n) _Pragma("unroll") for (int k = 0; k < 2; ++k) \
        acc[ai][bj][m][n] = __builtin_amdgcn_mfma_f32_16x16x32_bf16(Bt[n][k], At[m][k], acc[ai][bj][m][n], 0, 0, 0); __builtin_amdgcn_s_setprio(0); } while (0)
#define FG_WAIT_V(n) asm volatile("s_waitcnt vmcnt(" #n ")" ::: "memory")
#define FG_WAIT_L(n) asm volatile("s_waitcnt lgkmcnt(" #n ")" ::: "memory")
#define FG_BAR __builtin_amdgcn_s_barrier()
#define FG_SCHED __builtin_amdgcn_sched_barrier(0)
#define FG_OFFS(u, vA, vB, hA, hB) do { _Pragma("unroll") for (int _i = 0; _i < 2; ++_i) { vA[_i] = (unsigned)(sR[_i] * (u).lda + sC[_i]) * 2u; vB[_i] = (unsigned)(sRb[_i] * (u).ldb + sC[_i]) * 2u; } \
        hA = (size_t)HALF * (u).lda * 2; hB = (size_t)HALF * (u).ldb * 2; } while (0)
    UnitM cur, nxt; int ui = 0;
    if (!S.next(0, cur)) return;
    unsigned vAc[2], vBc[2], vAn[2], vBn[2]; size_t hAc, hBc, hAn, hBn;
    FG_OFFS(cur, vAc, vBc, hAc, hBc);
    f32x4 acc[2][2][4][2];
#pragma unroll
    for (int a = 0; a < 2; ++a)
#pragma unroll
        for (int b = 0; b < 2; ++b)
#pragma unroll
            for (int m = 0; m < 4; ++m)
#pragma unroll
                for (int n = 0; n < 2; ++n) acc[a][b][m][n] = (f32x4){0.f, 0.f, 0.f, 0.f};
    bf16x8 At[4][2], B0[2][2], B1[2][2];
    const GAS char* cA = cur.A; const GAS char* cB = cur.B;
    FG_STAGE(FG_SB(0, 0), cB, vBc); FG_STAGE(FG_SB(0, 1), cB + hBc, vBc); FG_STAGE(FG_SA(0, 0), cA, vAc); FG_STAGE(FG_SA(0, 1), cA + hAc, vAc);
    if (wr == 1) FG_BAR;
    FG_WAIT_V(2); FG_BAR;
    FG_STAGE(FG_SB(1, 0), cB + kstep, vBc); FG_STAGE(FG_SA(1, 0), cA + kstep, vAc); FG_STAGE(FG_SB(1, 1), cB + hBc + kstep, vBc);
    FG_WAIT_V(6); FG_BAR;
    for (;;) {
        const bool has_next = S.next(ui + 1, nxt);
        if (!has_next) nxt = cur;
        FG_OFFS(nxt, vAn, vBn, hAn, hBn);
        const GAS char* nA = nxt.A; const GAS char* nB = nxt.B;
        const int nt = cur.nt;
        for (int t = 0; t < nt; t += 2) {
            const bool last = (t == nt - 2);
            const GAS char* a1 = cA + (size_t)(t + 1) * kstep;
            const GAS char* a2 = last ? nA : cA + (size_t)(t + 2) * kstep; const GAS char* b2 = last ? nB : cB + (size_t)(t + 2) * kstep;
            const GAS char* a3 = a2 + kstep; const GAS char* b3 = b2 + kstep;
            unsigned vA2[2], vB2[2];
#pragma unroll
            for (int _i = 0; _i < 2; ++_i) { vA2[_i] = last ? vAn[_i] : vAc[_i]; vB2[_i] = last ? vBn[_i] : vBc[_i]; }
            const size_t hA2 = last ? hAn : hAc, hB2 = last ? hBn : hBc;
            FG_LDB(B0, 0, 0); FG_LDB(B1, 0, 1); FG_SCHED; FG_LDA(At, 0, 0); FG_STAGE(FG_SA(1, 1), a1 + hAc, vAc);
            FG_WAIT_V(8); FG_WAIT_L(0); FG_BAR; FG_MMA(0, 0, At, B0); FG_MMA(0, 1, At, B1); FG_BAR; FG_SCHED;
            FG_LDA(At, 0, 1); FG_STAGE(FG_SB(0, 0), b2, vB2); FG_STAGE(FG_SB(0, 1), b2 + hB2, vB2); FG_STAGE(FG_SA(0, 0), a2, vA2);
            FG_WAIT_V(8); FG_WAIT_L(0); FG_BAR; FG_MMA(1, 0, At, B0); FG_MMA(1, 1, At, B1); FG_BAR; FG_SCHED;
            FG_LDB(B0, 1, 0); FG_LDB(B1, 1, 1); FG_SCHED; FG_LDA(At, 1, 0); FG_STAGE(FG_SA(0, 1), a2 + hA2, vA2);
            FG_WAIT_V(8); FG_WAIT_L(0); FG_BAR; FG_MMA(0, 0, At, B0); FG_MMA(0, 1, At, B1); FG_BAR; FG_SCHED;
            FG_LDA(At, 1, 1); FG_STAGE(FG_SB(1, 0), b3, vB2); FG_STAGE(FG_SB(1, 1), b3 + hB2, vB2); FG_STAGE(FG_SA(1, 0), a3, vA2);
            FG_WAIT_V(8); FG_WAIT_L(0); FG_BAR; FG_MMA(1, 0, At, B0); FG_MMA(1, 1, At, B1); FG_BAR; FG_SCHED;
        }
        if (wr == 0) FG_BAR;
#pragma unroll
        for (int ai = 0; ai < 2; ++ai)
#pragma unroll
            for (int m = 0; m < 4; ++m)
#pragma unroll
                for (int bj = 0; bj < 2; ++bj) {
                    E.apply(cur, cur.pm * BM + ai * HALF + wr * 64 + m * 16 + fr, cur.pn * BM + bj * HALF + wc * 32 + 8 * fq, acc[ai][bj][m][0], acc[ai][bj][m][1]);
                    if (bj == 1 && (m & 1)) asm volatile("" ::: "memory");
                }
        if (!has_next) break;
#pragma unroll
        for (int a = 0; a < 2; ++a)
#pragma unroll
            for (int b = 0; b < 2; ++b)
#pragma unroll
                for (int m = 0; m < 4; ++m)
#pragma unroll
                    for (int n = 0; n < 2; ++n) acc[a][b][m][n] = (f32x4){0.f, 0.f, 0.f, 0.f};
        cur = nxt; cA = nA; cB = nB; ++ui;
#pragma unroll
        for (int _i = 0; _i < 2; ++_i) { vAc[_i] = vAn[_i]; vBc[_i] = vBn[_i]; }
        hAc = hAn; hBc = hBn;
        if (wr == 1) FG_BAR;
    }
    FG_WAIT_V(0);
    FG_BAR;
#undef FG_SA
#undef FG_SB
#undef FG_STAGE
#undef FG_LDA
#undef FG_LDB
#undef FG_MMA
#undef FG_WAIT_V
#undef FG_WAIT_L
#undef FG_BAR
#undef FG_SCHED
#undef FG_OFFS
}
struct SchedBranch { const gbf* AB; const gbf* WpT; int nM, nN, G, c, pm0;
    __device__ __forceinline__ bool next(int i, Unit& u) const {
        const int nwg = nM * nN; const long L = (long)(i >> 2) * G + c; if (L >= nwg) return false;
        int wgid = (int)L; { const int q = nwg / NXCD, r = nwg % NXCD, xcd = wgid % NXCD, off = wgid / NXCD; wgid = (xcd < r ? xcd * (q + 1) : r * (q + 1) + (xcd - r) * q) + off; }
        const int nig = WGM * nN, gidx = wgid / nig, fm = gidx * WGM, gsz = (nM - fm) < WGM ? (nM - fm) : WGM;
        u.pm = fm + ((wgid % nig) % gsz); u.pn = (wgid % nig) / gsz; u.z = i & 3;
        u.A = (const GAS char*)(AB + (size_t)(pm0 + u.pm) * BM * ABW + u.z * 1024); u.B = (const GAS char*)(WpT + ((size_t)u.z * 2048 + (size_t)u.pn * BM) * KP1); return true;
    }
};
struct MapPlain { const gbf* A; int lda; const gbf* Bt; int ldb;
    __device__ __forceinline__ const gbf* a(int, int pm) const { return A + (size_t)pm * BM * lda; }
    __device__ __forceinline__ const gbf* b(int, int pn) const { return Bt + (size_t)pn * BM * ldb; } };
}

template <class Epi>
__device__ __forceinline__ void gemm_fast_plain(unsigned char* lds, const GemmJob j, const Epi& E, int gid, int G) {
    __syncthreads();
    fg::Sched<fg::MapPlain> S{fg::MapPlain{j.A, j.lda, j.Bt, j.ldb}, j.M / 256, j.N / 256, 1, G, gid};
    fg::gemm((LAS unsigned char*)lds, j.lda, j.ldb, j.K, S, E);
    __syncthreads();
}

struct MapF1 { const gbf* DC; const gbf* Pfv; int zrows;
    __device__ __forceinline__ const gbf* a(int, int pm) const { return DC + (size_t)pm * 256 * 256; }
    __device__ __forceinline__ const gbf* b(int z, int pn) const { return Pfv + ((size_t)(z >> 2) * zrows + (size_t)pn * 256) * PP + (z & 3) * 256; } };
struct MapF2 { const gbf* DN; const gbf* GT; int ld;
    __device__ __forceinline__ const gbf* a(int, int pm) const { return DN + (size_t)pm * 256 * ld; }
    __device__ __forceinline__ const gbf* b(int z, int pn) const { return GT + ((size_t)z * 1024 + (size_t)pn * 256) * ld; } };
template <class Map, class Epi>
__device__ __forceinline__ void gemm_fast_z(unsigned char* lds, const Map& map, int lda, int ldb, int K, int nM, int nN, int nz, const Epi& E, int c, int Gs) {
    __syncthreads();
    if (c >= 0) { fg::Sched<Map> S{map, nM, nN, nz, Gs, c}; fg::gemm((LAS unsigned char*)lds, lda, ldb, K, S, E); }
    __syncthreads();
}

template <class Epi>
__device__ __forceinline__ void gemm_run(unsigned char* lds, const GemmJob j, const Epi& E, int first, int stride) {
    gemm_fast_plain(lds, j, E, first, stride);
}

struct EpiInProj {
    static constexpr bool PERM = true, CHAIN = false;
    gbf* P; int row0; gbf* NK; gbf* NV; gbf* NQ; gbf* MG;
    __device__ __forceinline__ EpiInProj z(int) const { return *this; }
    __device__ __forceinline__ void operator()(int row, int col, f32x4 a, f32x4 b) const {
        if (col >= C_MG) {
#pragma unroll
            for (int i = 0; i < 4; ++i) { a[i] = sigmoidf_(fminf(fmaxf(a[i], -30.f), 30.f)); b[i] = sigmoidf_(fminf(fmaxf(b[i], -30.f), 30.f)); }
        } else if (col >= C_GCV) {
#pragma unroll
            for (int i = 0; i < 4; ++i) { a[i] = siluf_(a[i]); b[i] = siluf_(b[i]); }
        } else if (col >= C_NAQ && col < C_CB) { a = a * NASCALE; b = b * NASCALE; }
        const int r = row0 + row;
        if (col >= C_MG) { const int cc = col - C_MG; __builtin_nontemporal_store(pk8(a, b), (GAS u32x4*)(MG + mg_off(cc >> 11, r, cc & 2047))); }
        else if (col >= C_NAK && col < C_CB && !(col >= C_QL && col < C_NAQ)) {
            const int sel = (col < C_NAV) ? 0 : (col < C_QL) ? 1 : 2, cc = (col < C_NAV) ? col - C_NAK : (col < C_QL) ? col - C_NAV : col - C_NAQ;
            __builtin_nontemporal_store(pk8(a, b), (GAS u32x4*)(NK + (size_t)sel * ((WS_NV - WS_NK) / 2) + hm_row(r, cc >> 6, 16) * 64 + (cc & 63)));
        } else __builtin_nontemporal_store(pk8(a, b), (GAS u32x4*)(P + (size_t)r * PP + col));
    }
};
struct EpiInProjC1 {
    static constexpr bool PERM = true, CHAIN = false;
    gbf* P; gbf* NK; gbf* KM; gf32* SSQ;
    __device__ __forceinline__ EpiInProjC1 z(int) const { return *this; }
    __device__ __forceinline__ void operator()(int row, int col, f32x4 a, f32x4 b) const {
        const int r = NLAT + row;
        if (col < 256) {
            *(GAS u32x4*)(P + (size_t)r * PP + col) = pk8(a, b);
            float s = a[0] * a[0] + a[1] * a[1] + a[2] * a[2] + a[3] * a[3] + b[0] * b[0] + b[1] * b[1] + b[2] * b[2] + b[3] * b[3];
            s += __shfl_xor(s, 16); s += __shfl_xor(s, 32);
            if ((col & 31) == 0) SSQ[(size_t)row * 8 + (col >> 5)] = s;
        } else if (col < 512) {
            if (col < 320) { const u32x4 v = pk8(a, b);
#pragma unroll
                for (int h = 0; h < 8; ++h) *(GAS u32x4*)(KM + hm_row(r, h, 8) * 192 + 128 + (col - 256)) = v; }
        } else {
            const int sel = (col < C_NAV) ? 0 : 1, cc = (col < C_NAV) ? col - C_NAK : col - C_NAV;
            *(GAS u32x4*)(NK + (size_t)sel * ((WS_NV - WS_NK) / 2) + hm_row(r, cc >> 6, 16) * 64 + (cc & 63)) = pk8(a, b);
        }
    }
};
struct EpiKvUp {
    static constexpr bool PERM = true, CHAIN = false;
    gbf* KM; gbf* VM; const gf32* rstd; int row0;
    __device__ __forceinline__ EpiKvUp z(int) const { return *this; }
    __device__ __forceinline__ void operator()(int row, int col, f32x4 a, f32x4 b) const {
        const int r = row0 + row, h = col >> 8, jj = col & 255; const float s = rstd[r];
        const size_t hr = hm_row(r, h, 8); gbf* p = (jj < 128) ? KM + hr * 192 + jj : VM + hr * 128 + (jj - 128);
        *(GAS u32x4*)p = pk8(a * s, b * s);
    }
};
struct EpiQUp {
    static constexpr bool PERM = false, CHAIN = false;
    gbf* QM; const gf32* rstd; const gf32* rope; int row0;
    __device__ __forceinline__ EpiQUp z(int) const { return *this; }
    __device__ __forceinline__ void operator()(int row, int col, f32x4 a, f32x4 b) const {
        const int r = row0 + row, h = col / 192, jj = col - h * 192; const float s = rstd[r] * QSCALE;
        a = a * s; b = b * s;
        if (jj >= 128 && r < NLAT) {
            const int t = r & (SEQ - 1), e = jj - 128, pos = (e < 32) ? (t >> 6) : (t & 63), f0 = e & 15;
            const gf32* rp = rope + (pos * 16 + f0) * 2;
#pragma unroll
            for (int i = 0; i < 4; ++i) { const float c = rp[2 * i], sn = rp[2 * i + 1]; const float x = a[i], y = b[i]; a[i] = x * c - y * sn; b[i] = x * sn + y * c; }
        }
        gbf* p = QM + hm_row(r, h, 8) * 192 + jj;
        *(GAS u32x2*)p = pk4(a); *(GAS u32x2*)(p + 16) = pk4(b);
    }
};
struct EpiF1 {
    static constexpr bool PERM = true, CHAIN = false;
    gbf* GT; int S; int g;
    __device__ __forceinline__ EpiF1 z(int zz) const { return EpiF1{GT + (size_t)(zz >> 2) * 1024 * 2 * S, S, zz & 3}; }
    __device__ __forceinline__ void operator()(int row, int col, f32x4 a, f32x4 b) const {
        *(GAS u32x4*)(GT + (size_t)(g * 256 + (row & 255)) * (2 * S) + (row >> 8) * S + col) = pk8(a, b);
    }
};
struct EpiF2 {
    static constexpr bool PERM = true, CHAIN = false;
    gbf* AB; const gbf* P; int row0; int zrows;
    __device__ __forceinline__ EpiF2 z(int zz) const { return EpiF2{AB, P, row0 + zz * zrows, zrows}; }
    __device__ __forceinline__ void operator()(int row, int col, f32x4 a, f32x4 b) const {
        const size_t r = (size_t)(row0 + row);
        f32x4 ga, gb; unpk8(*(const GAS u32x4*)(P + r * PP + C_GFN + col), ga, gb);
        *(GAS u32x4*)(AB + r * ABW + 3072 + col) = pk8(a * ga, b * gb);
    }
};
struct EpiBranch {
    static constexpr bool PERM = true, CHAIN = false;
    gf32* MF; gbf* MB; const gbf* P; int i; int row0;
    __device__ __forceinline__ EpiBranch z(int) const { return *this; }
    __device__ __forceinline__ void operator()(int row, int col, f32x4 a, f32x4 b) const {
        const size_t r = (size_t)(row0 + row);
        f32x4 ga, gb; unpk8(*(const GAS u32x4*)(P + r * PP + C_MG + i * DM + col), ga, gb);
        gf32* m = MF + r * DM + col;
        f32x4 va = a * ga, vb = b * gb;
        if (i > 0) { va += *(const GAS f32x4*)m; vb += *(const GAS f32x4*)(m + 4); }
        if (i < 3) { *(GAS f32x4*)m = va; *(GAS f32x4*)(m + 4) = vb; }
        else *(GAS u32x4*)(MB + r * DM + col) = pk8(va, vb);
    }
};
struct EpiChain {
    static constexpr bool PERM = true, CHAIN = true;
    gbf* MB; const gbf* P; int row0;
    __device__ __forceinline__ EpiChain z(int) const { return *this; }
    __device__ __forceinline__ void chain(int row, int col, f32x4& a, f32x4& b, int zz) const {
        const size_t r = (size_t)(row0 + row);
        if (zz < 3) {
            f32x4 ga, gb, ha, hb; unpk8(__builtin_nontemporal_load((const GAS u32x4*)(P + mg_off(zz, (int)r, col))), ga, gb); unpk8(__builtin_nontemporal_load((const GAS u32x4*)(P + mg_off(zz + 1, (int)r, col))), ha, hb);
#pragma unroll
            for (int i = 0; i < 4; ++i) { a[i] *= ga[i] * __builtin_amdgcn_rcpf(ha[i]); b[i] *= gb[i] * __builtin_amdgcn_rcpf(hb[i]); }
        } else {
            f32x4 ga, gb; unpk8(__builtin_nontemporal_load((const GAS u32x4*)(P + mg_off(3, (int)r, col))), ga, gb);
            *(GAS u32x4*)(MB + r * KP2 + col) = pk8(a * ga, b * gb);
        }
    }
};
struct EpiOut {
    static constexpr bool PERM = true, CHAIN = false;
    gf32* Y; int row0;
    __device__ __forceinline__ EpiOut z(int) const { return *this; }
    __device__ __forceinline__ void operator()(int row, int col, f32x4 a, f32x4 b) const {
        gf32* p = Y + (size_t)(row0 + row) * DM + col; *(GAS f32x4*)p = a; *(GAS f32x4*)(p + 4) = b;
    }
};

struct EpiC2 {
    gbf* KM; gbf* VM; gbf* QM; gbf* GT; gbf* GTC; const gf32* RKV; const gf32* RQ; const gf32* rope; const gf32* SSQ;
    __device__ __forceinline__ void apply(const fg::UnitM& u, int row, int col, f32x4 a, f32x4 b) const {
        if (u.job == 0) {
            const int h = col >> 8, jj = col & 255; float s;
            if (SSQ != nullptr && row >= NLAT) { const f32x4 s0 = *(const GAS f32x4*)(SSQ + (size_t)(row - NLAT) * 8), s1 = *(const GAS f32x4*)(SSQ + (size_t)(row - NLAT) * 8 + 4);
                s = rsqrtf(((s0[0] + s0[1]) + (s0[2] + s0[3]) + (s1[0] + s1[1]) + (s1[2] + s1[3])) * (1.0f / 256.0f) + EPS); }
            else s = RKV[row];
            const size_t hr = hm_row(row, h, 8); gbf* p = (jj < 128) ? KM + hr * 192 + jj : VM + hr * 128 + (jj - 128);
            *(GAS u32x4*)p = pk8(a * s, b * s);
        } else if (u.job == 1) {
            const int h = col / 192, jj = col - h * 192; const float s = RQ[row] * QSCALE;
            a = a * s; b = b * s;
            if (jj >= 128 && row < NLAT) {
                const int t = row & (SEQ - 1), e = jj - 128, pos = (e < 32) ? (t >> 6) : (t & 63), f0 = e & 15; const bool second = (e & 16) != 0;
                const gf32* rp = rope + (pos * 16 + f0) * 2;
                const f32x4 cs0 = *(const GAS f32x4*)rp, cs1 = *(const GAS f32x4*)(rp + 4), cs2 = *(const GAS f32x4*)(rp + 8), cs3 = *(const GAS f32x4*)(rp + 12);
                const float cc[8] = {cs0[0], cs0[2], cs1[0], cs1[2], cs2[0], cs2[2], cs3[0], cs3[2]}, ss[8] = {cs0[1], cs0[3], cs1[1], cs1[3], cs2[1], cs2[3], cs3[1], cs3[3]};
#pragma unroll
                for (int i = 0; i < 4; ++i) { const float ya = __shfl_xor(a[i], 32), yb = __shfl_xor(b[i], 32);
                    a[i] = second ? (ya * ss[i] + a[i] * cc[i]) : (a[i] * cc[i] - ya * ss[i]);
                    b[i] = second ? (yb * ss[4 + i] + b[i] * cc[4 + i]) : (b[i] * cc[4 + i] - yb * ss[4 + i]); }
            }
            *(GAS u32x4*)(QM + hm_row(row, h, 8) * 192 + jj) = pk8(a, b);
        } else {
            const int S_ = (u.job == 2) ? SEQ : CTXL, ld_ = (u.job == 2) ? KP4 : 2 * CTXL; gbf* G_ = (u.job == 2) ? GT : GTC; const int bb = u.z >> 2, g = u.z & 3;
            *(GAS u32x4*)(G_ + (size_t)bb * 1024 * ld_ + (size_t)(g * 256 + (row & 255)) * ld_ + (row >> 8) * S_ + col) = pk8(a, b);
        }
    }
};
struct SchedC2 {
    const gbf* P; const gbf* WukvT; const gbf* WuqT; const gbf* DC; int nq_tiles, n3, G, c;
    __device__ __forceinline__ bool next(int i, fg::UnitM& u) const {
        int L = i * G + c; const int n0 = (NROW / 256) * 8, n1 = nq_tiles * 6, n2 = 16 * 2 * 8;
        if (L < n0) { u.job = 0; u.pm = L >> 3; u.pn = L & 7; u.z = 0; u.lda = PP; u.ldb = 256; u.nt = 4;
            u.A = (const GAS char*)(P + (size_t)u.pm * 256 * PP + C_CKV); u.B = (const GAS char*)(WukvT + (size_t)u.pn * 256 * 256); return true; }
        L -= n0;
        if (L < n1) { u.job = 1; u.pm = L / 6; u.pn = L % 6; u.z = 0; u.lda = PP; u.ldb = 512; u.nt = 8;
            u.A = (const GAS char*)(P + (size_t)u.pm * 256 * PP + C_QL); u.B = (const GAS char*)(WuqT + (size_t)u.pn * 256 * 512); return true; }
        L -= n1;
        if (L < n2) { u.job = 2; u.z = L >> 4; u.pm = (L >> 3) & 1; u.pn = L & 7; u.lda = 256; u.ldb = PP; u.nt = 4;
            u.A = (const GAS char*)(DC + (size_t)u.pm * 256 * 256); u.B = (const GAS char*)(P + ((size_t)(u.z >> 2) * SEQ + (size_t)u.pn * 256) * PP + C_FV + (u.z & 3) * 256); return true; }
        L -= n2;
        if (L < n3) { u.job = 3; u.z = L >> 1; u.pm = L & 1; u.pn = 0; u.lda = 256; u.ldb = PP; u.nt = 4;
            u.A = (const GAS char*)(DC + (size_t)u.pm * 256 * 256); u.B = (const GAS char*)(P + ((size_t)NLAT + (size_t)(u.z >> 2) * CTXL) * PP + C_FV + (u.z & 3) * 256); return true; }
        return false;
    }
};

__device__ __forceinline__ void transpose_item(const gf32* W, int K, int N, gbf* WT, int ldt, const gf32* kscale, bool win_remap, int item, int lane, float* scr) {
    const int nblk = N / 32, kb = item / nblk, nb = item % nblk, k0 = 64 * kb, n0 = 32 * nb;
#pragma unroll 8
    for (int i = 0; i < 32; ++i) { const int kk = 2 * i + (lane >> 5); float v = __builtin_nontemporal_load(W + (size_t)(k0 + kk) * N + n0 + (lane & 31)); if (kscale) v *= kscale[k0 + kk]; scr[kk * 33 + (lane & 31)] = v; }
    __builtin_amdgcn_fence(__ATOMIC_RELEASE, "wavefront"); asm volatile("s_waitcnt lgkmcnt(0)" ::: "memory");
    const int c = lane & 7, nd0 = (win_remap && n0 >= 320) ? n0 + 192 : n0;
#pragma unroll
    for (int j = 0; j < 4; ++j) { const int n = (lane >> 3) + 8 * j; const float* s = scr + (8 * c) * 33 + n;
        u32x4 o; o.x = pk2(s[0 * 33], s[1 * 33]); o.y = pk2(s[2 * 33], s[3 * 33]); o.z = pk2(s[4 * 33], s[5 * 33]); o.w = pk2(s[6 * 33], s[7 * 33]);
        __builtin_nontemporal_store(o, (GAS u32x4*)(WT + (size_t)(nd0 + n) * ldt + k0 + 8 * c)); }
    asm volatile("s_waitcnt lgkmcnt(0)" ::: "memory");
}

__device__ __forceinline__ void phase0(const Params& p, unsigned char* lds, int gid, int G) {
    const int tid = tid_op(), lane = tid & 63, wid = tid >> 6;
    gu8* ws = wsb();
    {
        float* sv = (float*)lds;
        float* part = sv + 5 * 2048;
        bool have = false;
        for (int it = gid; it < 2 * 96; it += G) {
            if (!have) {
                for (int i = tid; i < 5 * 2048; i += NTHREADS) { const float v = (i < 4 * 2048) ? pin(I_C)[i] : pin(I_CCTX)[i - 4 * 2048]; sv[i] = siluf_(v); }
                have = true;
            }
            __syncthreads();
            const int l = it / 96, nb = it % 96;
            const gf32* W = pin(I_WADA) + (size_t)l * DM * 6144 + nb * 64 + lane;
            float a0 = 0.f, a1 = 0.f, a2 = 0.f, a3 = 0.f, a4 = 0.f;
#pragma unroll 8
            for (int k = wid * 256; k < wid * 256 + 256; ++k) {
                const float w = W[(size_t)k * 6144];
                a0 = fmaf(sv[k], w, a0); a1 = fmaf(sv[2048 + k], w, a1); a2 = fmaf(sv[4096 + k], w, a2); a3 = fmaf(sv[6144 + k], w, a3); a4 = fmaf(sv[8192 + k], w, a4);
            }
            part[(wid * 5 + 0) * 64 + lane] = a0; part[(wid * 5 + 1) * 64 + lane] = a1; part[(wid * 5 + 2) * 64 + lane] = a2; part[(wid * 5 + 3) * 64 + lane] = a3; part[(wid * 5 + 4) * 64 + lane] = a4;
            __syncthreads();
            if (tid < 320) {
                const int r = tid / 64, cidx = tid % 64; float s = 0.f;
#pragma unroll
                for (int w = 0; w < 8; ++w) s += part[(w * 5 + r) * 64 + cidx];
                const int n = nb * 64 + cidx;
                ((gf32*)(ws + WS_MOD))[((size_t)l * 5 + r) * 6144 + n] = s + pin(I_BADA)[(size_t)l * 6144 + n];
            }
        }
        __syncthreads();
    }
    {
        const long gt = (long)gid * NTHREADS + tid, NT = (long)G * NTHREADS;
        gf32* rope = (gf32*)(ws + WS_ROPE);
        for (long i = gt; i < 64 * 16; i += NT) { const int pos = (int)(i >> 4), f = (int)(i & 15); const float inv = exp2f(-(float)f * (13.287712379549449f / 16.0f)); const float ang = (float)pos * inv;
            rope[2 * i] = cosf(ang); rope[2 * i + 1] = sinf(ang); }
        gbf* DC = (gbf*)(ws + WS_DC);
        for (long i = gt; i < 512 * 256; i += NT) { const int m = (int)(i >> 8), k = (int)(i & 255); const int jdx = ((m & 255) * k) & 255; const float ang = (float)jdx * (6.283185307179586f / 256.0f);
            DC[i] = (bf16_t)f2bf((m < 256 ? cosf(ang) : sinf(ang)) * 0.0625f); }
        gbf* DN = (gbf*)(ws + WS_DN);
        for (long i = gt; i < (long)2048 * 4096; i += NT) { const int n = (int)(i >> 12), k = (int)(i & 4095); const int jdx = (n * (k & 2047)) & 2047; const float ang = (float)jdx * (6.283185307179586f / 2048.0f);
            DN[(size_t)n * KP4 + k] = (bf16_t)f2bf((k < 2048 ? cosf(ang) : -sinf(ang)) * 0.02209708691207961f); }
        gbf* DNC = (gbf*)(ws + WS_DNC);
        for (long i = gt; i < 256 * 512; i += NT) { const int n = (int)(i >> 9), k = (int)(i & 511); const int jdx = (n * (k & 255)) & 255; const float ang = (float)jdx * (6.283185307179586f / 256.0f);
            DNC[i] = (bf16_t)f2bf((k < 256 ? cosf(ang) : -sinf(ang)) * 0.0625f); }
        for (long i = gt; i < (long)2 * 192 * DM / 8; i += NT) { const int l = (int)(i / (192 * DM / 8)); const long r = i % (192 * DM / 8);
            *(GAS u32x4*)((gbf*)(ws + WS_WIN) + (size_t)l * NP * KP2 + (size_t)(320 + r / (DM / 8)) * KP2 + (r % (DM / 8)) * 8) = (u32x4){0u, 0u, 0u, 0u}; }
    }
    {
        float* scr = (float*)lds + wid * (64 * 33);
        const int gw = gid * NWAVES + wid, NGW = G * NWAVES;
        constexpr int I_IN = 32 * 634, I_KV = 4 * 64, I_Q = 8 * 48, I_P = 16 * 64, I_O = 32 * 64;
        constexpr int PER_L = I_IN + I_KV + I_Q + 4 * I_P + I_O;
        for (int it = gw; it < 2 * PER_L; it += NGW) {
            const int l = it / PER_L; int r = it % PER_L;
            if (r < I_IN) { transpose_item(pin(I_WIN) + (size_t)l * DM * N_IN, DM, N_IN, (gbf*)(ws + WS_WIN) + (size_t)l * NP * KP2, KP2, nullptr, true, r, lane, scr); continue; } r -= I_IN;
            if (r < I_KV) { transpose_item(pin(I_WUKV) + (size_t)l * 256 * 2048, 256, 2048, (gbf*)(ws + WS_WUKV) + (size_t)l * 2048 * 256, 256, pin(I_GKV) + l * 256, false, r, lane, scr); continue; } r -= I_KV;
            if (r < I_Q) { transpose_item(pin(I_WUQ) + (size_t)l * 512 * 1536, 512, 1536, (gbf*)(ws + WS_WUQ) + (size_t)l * 1536 * 512, 512, pin(I_GQ) + l * 512, false, r, lane, scr); continue; } r -= I_Q;
            if (r < 4 * I_P) { const int b = r / I_P; const gf32* W = pin(I_WPC + b) + (size_t)l * 1024 * 2048;
                transpose_item(W, 1024, 2048, (gbf*)(ws + WS_WP) + ((size_t)l * 4 + b) * 2048 * KP1, KP1, nullptr, false, r % I_P, lane, scr); continue; } r -= 4 * I_P;
            transpose_item(pin(I_WOUT) + (size_t)l * 2048 * 2048, 2048, 2048, (gbf*)(ws + WS_WO) + (size_t)l * 2048 * KP2, KP2, nullptr, false, r, lane, scr);
        }
    }
}

__device__ __forceinline__ void u_row(const f32x4 (&v)[8], float rstd, const gf32* gpre, const gf32* mod  , gbf* urow, int lane) {
#pragma unroll
    for (int j = 0; j < 8; ++j) { const int c = 4 * lane + 256 * j;
        const f32x4 g = *(const GAS f32x4*)(gpre + c), sh = *(const GAS f32x4*)(mod + c), sc = *(const GAS f32x4*)(mod + 2048 + c);
        const f32x4 o = v[j] * rstd * g * (sc + 1.0f) + sh;
        *(GAS u32x2*)(urow + c) = pk4(o); }
}
__device__ __forceinline__ void phase_uprep0(const Params& p, int gid, int G) {
    const int tid = tid_op(), lane = tid & 63, gw = gid * NWAVES + (tid >> 6), NGW = G * NWAVES;
    const gf32* mod0 = (const gf32*)(wsb() + WS_MOD);
    gbf* U = (gbf*)(wsb() + WS_U);
    for (int r = gw; r < NROW; r += NGW) {
        const gf32* xr = (r < NLAT) ? pin(I_X) + (size_t)r * DM : pin(I_CTX) + (size_t)(r - NLAT) * DM;
        const int mr = (r < NLAT) ? (r >> 11) : 4;
        f32x4 v[8]; float s = 0.f;
#pragma unroll
        for (int j = 0; j < 8; ++j) { v[j] = *(const GAS f32x4*)(xr + 4 * lane + 256 * j); s += v[j][0] * v[j][0] + v[j][1] * v[j][1] + v[j][2] * v[j][2] + v[j][3] * v[j][3]; }
        const float rstd = rsqrtf(wave_sum(s) * (1.0f / DM) + EPS);
        u_row(v, rstd, pin(I_GPRE), mod0 + (size_t)mr * 6144, U + (size_t)r * KP2, lane);
    }
}
__device__ __forceinline__ void phase_final(const Params& p, int l, int rbeg, int rend, int cu, int ncu) {
    const int tid = tid_op(), lane = tid & 63, gw = rbeg + cu * NWAVES + (tid >> 6), NGW = ncu * NWAVES;
    const gf32* mod = (const gf32*)(wsb() + WS_MOD) + (size_t)l * 5 * 6144;
    const gf32* Y = (const gf32*)(wsb() + WS_Y);
    gf32* XL = (gf32*)(wsb() + WS_XL);
    gbf* U = (gbf*)(wsb() + WS_U);
    const int nrows = rend;
    auto xrow = [&](int r) -> const gf32* { return (l == 0) ? ((r < NLAT) ? pin(I_X) + (size_t)r * DM : pin(I_CTX) + (size_t)(r - NLAT) * DM) : XL + (size_t)r * DM; };
    f32x4 y[8], x[8], yn[8], xn[8];
    if (gw < nrows) { const gf32* yr = Y + (size_t)gw * DM; const gf32* xr = xrow(gw);
#pragma unroll
        for (int j = 0; j < 8; ++j) { y[j] = *(const GAS f32x4*)(yr + 4 * lane + 256 * j); x[j] = *(const GAS f32x4*)(xr + 4 * lane + 256 * j); } }
    for (int r = gw; r < nrows; r += NGW) {
        const int rn = r + NGW;
        if (rn < nrows) { const gf32* yr = Y + (size_t)rn * DM; const gf32* xr = xrow(rn);
#pragma unroll
            for (int j = 0; j < 8; ++j) { yn[j] = *(const GAS f32x4*)(yr + 4 * lane + 256 * j); xn[j] = *(const GAS f32x4*)(xr + 4 * lane + 256 * j); } }
        const int mr = (r < NLAT) ? (r >> 11) : 4;
        gf32* orow = (l == 0) ? XL + (size_t)r * DM : pout() + (size_t)r * DM;
        float s = 0.f;
#pragma unroll
        for (int j = 0; j < 8; ++j) s += y[j][0] * y[j][0] + y[j][1] * y[j][1] + y[j][2] * y[j][2] + y[j][3] * y[j][3];
        const float rstd = rsqrtf(wave_sum(s) * (1.0f / DM) + EPS);
        float s2 = 0.f;
#pragma unroll
        for (int j = 0; j < 8; ++j) { const int c = 4 * lane + 256 * j;
            const f32x4 g = *(const GAS f32x4*)(pin(I_GPOST) + (size_t)l * DM + c), gt = *(const GAS f32x4*)(mod + (size_t)mr * 6144 + 4096 + c);
            const f32x4 o = x[j] + gt * (y[j] * rstd * g);
            *(GAS f32x4*)(orow + c) = o; y[j] = o; s2 += o[0] * o[0] + o[1] * o[1] + o[2] * o[2] + o[3] * o[3]; }
        if (l == 0) {
            const float rstd2 = rsqrtf(wave_sum(s2) * (1.0f / DM) + EPS);
            u_row(y, rstd2, pin(I_GPRE) + DM, mod + 5 * 6144 + (size_t)mr * 6144, U + (size_t)r * KP2, lane);
        }
#pragma unroll
        for (int j = 0; j < 8; ++j) { y[j] = yn[j]; x[j] = xn[j]; }
    }
}
__device__ __forceinline__ void c1_loadz(const gbf* pr, bool ok, int lane, f32x4 (&z)[4]) {
#pragma unroll
    for (int j = 0; j < 4; ++j) { const int c = 4 * lane + 256 * j;
        if (ok) z[j] = unpk4(*(const GAS u32x2*)(pr + C_CC + c)) * unpk4(*(const GAS u32x2*)(pr + C_CX + c)); else z[j] = (f32x4){0.f, 0.f, 0.f, 0.f}; }
}
__device__ __forceinline__ void phase_c1(const Params& p, int l, int nrows, int gid, int G) {
    const int tid = tid_op(), lane = tid & 63, gw = gid * NWAVES + (tid >> 6), NGW = G * NWAVES;
    const gbf* P = (const gbf*)(wsb() + WS_P);
    gbf* KM = (gbf*)(wsb() + WS_KM); gbf* AB = (gbf*)(wsb() + WS_AB);
    gf32* RKV = (gf32*)(wsb() + WS_RKV); gf32* RQ = (gf32*)(wsb() + WS_RQ);
    const gf32* rope = (const gf32*)(wsb() + WS_ROPE);
    const gf32* cw = pin(I_CONVW) + (size_t)l * 3 * 1024;
    const int chunk = (nrows + NGW - 1) / NGW, rbeg = gw * chunk, rend = min(rbeg + chunk, nrows);
    if (rbeg >= rend) return;
    f32x4 w0[4], w1[4], w2[4];
#pragma unroll
    for (int j = 0; j < 4; ++j) { const int c = 4 * lane + 256 * j; w0[j] = *(const GAS f32x4*)(cw + c); w1[j] = *(const GAS f32x4*)(cw + 1024 + c); w2[j] = *(const GAS f32x4*)(cw + 2048 + c); }
    auto seqpos = [](int r, int& t, int& slen) { if (r < NLAT) { t = r & (SEQ - 1); slen = SEQ; } else { t = (r - NLAT) & (CTXL - 1); slen = CTXL; } };
    f32x4 zp[4], zc[4], zn[4];
    { int t, slen; seqpos(rbeg, t, slen); const bool full0 = (rbeg < NLAT) || (l == 0);
      c1_loadz(P + (size_t)(rbeg - 1) * PP, full0 && t > 0, lane, zp); c1_loadz(P + (size_t)rbeg * PP, full0, lane, zc); (void)slen; }
    for (int r = rbeg; r < rend; ++r) {
        const gbf* pr = P + (size_t)r * PP;
        const bool full = (r < NLAT) || (l == 0);
        int t, slen; seqpos(r, t, slen);
        c1_loadz(pr + PP, (r + 1 < NROW) && ((r + 1 < NLAT) || (l == 0)), lane, zn);
        const float mp = (t > 0) ? 1.f : 0.f, mn = (t < slen - 1) ? 1.f : 0.f;
        const u32x2 ckv = *(const GAS u32x2*)(pr + C_CKV + 4 * lane);
        u32x2 q0 = {0u, 0u}, q1 = {0u, 0u}, cb[4], gc[4];
        if (full) { q0 = *(const GAS u32x2*)(pr + C_QL + 4 * lane); q1 = *(const GAS u32x2*)(pr + C_QL + 256 + 4 * lane);
#pragma unroll
            for (int j = 0; j < 4; ++j) { const int c = 4 * lane + 256 * j; cb[j] = *(const GAS u32x2*)(pr + C_CB + c); gc[j] = *(const GAS u32x2*)(pr + C_GCV + c); } }
        float x = bf2f(pr[C_KR + lane]);
        float rc = 1.f, rsn = 0.f;
        if (r < NLAT) { const int tt = r & (SEQ - 1), pos = (lane < 32) ? (tt >> 6) : (tt & 63), f = lane & 15; rc = rope[(pos * 16 + f) * 2]; rsn = rope[(pos * 16 + f) * 2 + 1]; }
        { const f32x4 v = unpk4(ckv); const float s = wave_sum(v[0] * v[0] + v[1] * v[1] + v[2] * v[2] + v[3] * v[3]);
          if (lane == 0) RKV[r] = rsqrtf(s * (1.0f / 256.0f) + EPS); }
        if (full) { const f32x4 v0 = unpk4(q0), v1 = unpk4(q1);
          const float s = wave_sum(v0[0] * v0[0] + v0[1] * v0[1] + v0[2] * v0[2] + v0[3] * v0[3] + v1[0] * v1[0] + v1[1] * v1[1] + v1[2] * v1[2] + v1[3] * v1[3]);
          if (lane == 0) RQ[r] = rsqrtf(s * (1.0f / 512.0f) + EPS); }
        {
          const float y = __shfl_xor(x, 16);
          x = (lane & 16) ? (y * rsn + x * rc) : (x * rc - y * rsn);
          const bf16_t o = (bf16_t)f2bf(x);
#pragma unroll
          for (int h = 0; h < 8; ++h) KM[hm_row(r, h, 8) * 192 + 128 + lane] = o; }
        if (full) {
#pragma unroll
          for (int j = 0; j < 4; ++j) { const int c = 4 * lane + 256 * j;
              const f32x4 o = (zp[j] * (w0[j] * mp) + zc[j] * w1[j] + zn[j] * (w2[j] * mn)) * unpk4(cb[j]) * unpk4(gc[j]);
              *(GAS u32x2*)(AB + (size_t)r * ABW + c) = pk4(o); } }
#pragma unroll
        for (int j = 0; j < 4; ++j) { zp[j] = zc[j]; zc[j] = zn[j]; }
    }
}

namespace fa {
typedef float f32x16 __attribute__((ext_vector_type(16)));
typedef short s16x4 __attribute__((ext_vector_type(4)));
constexpr float THRL = 8.0f;
__device__ __forceinline__ int crow(int r, int hi) { return (r & 3) + 8 * (r >> 2) + 4 * hi; }
__device__ __forceinline__ unsigned cvtpk(float lo, float hi) { unsigned r; asm volatile("v_cvt_pk_bf16_f32 %0, %1, %2" : "=v"(r) : "v"(lo), "v"(hi)); return r; }
template <int OFF> __device__ __forceinline__ s16x4 tr_read(int vb) { s16x4 r; asm volatile("ds_read_b64_tr_b16 %0, %1 offset:%2" : "=&v"(r) : "v"(vb), "i"(OFF) : "memory"); return r; }
__device__ __forceinline__ int v_rd_base(int lane) { return ((lane & 3) << 3) | (((lane >> 2) & 3) << 6) | (((lane >> 4) & 1) << 5) | (((lane >> 5) & 1) << 8); }
template <int NCB, int D0> __device__ __forceinline__ void pv_one(f32x16& od, int vb, bf16x8 pa0, bf16x8 pa1, bf16x8 pa2, bf16x8 pa3) {
    constexpr int KS = 2 * NCB * 512, HF = NCB * 512, B = D0 * 512;
    const s16x4 l0 = tr_read<B + 0 * KS>(vb), h0 = tr_read<B + 0 * KS + HF>(vb), l1 = tr_read<B + 1 * KS>(vb), h1 = tr_read<B + 1 * KS + HF>(vb);
    const s16x4 l2 = tr_read<B + 2 * KS>(vb), h2 = tr_read<B + 2 * KS + HF>(vb), l3 = tr_read<B + 3 * KS>(vb), h3 = tr_read<B + 3 * KS + HF>(vb);
    asm volatile("s_waitcnt lgkmcnt(0)" ::: "memory"); __builtin_amdgcn_sched_barrier(0);
#define FA_PK(L, H) (bf16x8){L[0], L[1], L[2], L[3], H[0], H[1], H[2], H[3]}
    od = __builtin_amdgcn_mfma_f32_32x32x16_bf16(pa0, FA_PK(l0, h0), od, 0, 0, 0);
    od = __builtin_amdgcn_mfma_f32_32x32x16_bf16(pa1, FA_PK(l1, h1), od, 0, 0, 0);
    od = __builtin_amdgcn_mfma_f32_32x32x16_bf16(pa2, FA_PK(l2, h2), od, 0, 0, 0);
    od = __builtin_amdgcn_mfma_f32_32x32x16_bf16(pa3, FA_PK(l3, h3), od, 0, 0, 0);
#undef FA_PK
}
struct Desc {
    const gbf* Q; int ldq;
    const gbf* K; int ldk;
    const gbf* V; int ldv;
    int row0a, nta, row0b, NT;
    const gbf* G; int ldg;
    gbf* O; int ldo;
    int r0, wr0; const gf32* rpb;
    int hsa, hsb;
};
template <int N> __device__ __forceinline__ void wait_bar() {
    if constexpr (N == 0) asm volatile("s_waitcnt vmcnt(0) lgkmcnt(0)\n\ts_barrier" ::: "memory");
    else if constexpr (N == 2) asm volatile("s_waitcnt vmcnt(2) lgkmcnt(0)\n\ts_barrier" ::: "memory");
    else if constexpr (N == 5) asm volatile("s_waitcnt vmcnt(5) lgkmcnt(0)\n\ts_barrier" ::: "memory");
    else static_assert(N == 0, "wait_bar count");
}
template <int N> __device__ __forceinline__ void wait_bar2() {
    if constexpr (N == 0) asm volatile("s_waitcnt vmcnt(0) lgkmcnt(0)\n\ts_barrier" ::: "memory");
    else if constexpr (N == 1) asm volatile("s_waitcnt vmcnt(1) lgkmcnt(0)\n\ts_barrier" ::: "memory");
    else if constexpr (N == 2) asm volatile("s_waitcnt vmcnt(2) lgkmcnt(0)\n\ts_barrier" ::: "memory");
    else if constexpr (N == 5) asm volatile("s_waitcnt vmcnt(5) lgkmcnt(0)\n\ts_barrier" ::: "memory");
    else static_assert(N == 0, "wait_bar2 count");
}
template <int MODE, unsigned L0 = 0xFFFFu, unsigned L1 = 0xFFFFu> __device__ __forceinline__ void partial_sm(f32x16& p0, f32x16& p1, float& m_reg, float& alpha) {
    if constexpr (MODE == 1) {
#pragma unroll
        for (int r = 0; r < 16; ++r) { p0[r] *= NASCALE; p1[r] *= NASCALE; }
    }
    float pmax = -3.0e38f;
#pragma unroll
    for (int r = 0; r < 16; ++r) if ((L0 >> r) & 1u) pmax = fmaxf(pmax, p0[r]);
#pragma unroll
    for (int r = 0; r < 16; ++r) if ((L1 >> r) & 1u) pmax = fmaxf(pmax, p1[r]);
    { auto rr = __builtin_amdgcn_permlane32_swap(__float_as_uint(pmax), __float_as_uint(pmax), false, false); pmax = fmaxf(__uint_as_float(rr[0]), __uint_as_float(rr[1])); }
    if (__builtin_expect(__all(pmax - m_reg <= THRL), 1)) alpha = 1.f;
    else { const float mn = fmaxf(m_reg, pmax); alpha = __builtin_amdgcn_exp2f(m_reg - mn); m_reg = mn; }
#pragma unroll
    for (int r = 0; r < 16; ++r) { if ((L0 >> r) & 1u) p0[r] = __builtin_amdgcn_exp2f(p0[r] - m_reg); else p0[r] = 0.f; if ((L1 >> r) & 1u) p1[r] -= m_reg; }
}
template <unsigned L0 = 0xFFFFu, unsigned L1 = 0xFFFFu>
__device__ __forceinline__ void finish_sm(f32x16& p0, f32x16& p1, float alpha, float& l_reg, bf16x8& pa0, bf16x8& pa1, bf16x8& pa2, bf16x8& pa3) {
#pragma unroll
    for (int r = 0; r < 16; ++r) { if ((L1 >> r) & 1u) p1[r] = __builtin_amdgcn_exp2f(p1[r]); else p1[r] = 0.f; }
    float ps = 0.f;
#pragma unroll
    for (int r = 0; r < 16; ++r) if ((L0 >> r) & 1u) ps += p0[r];
#pragma unroll
    for (int r = 0; r < 16; ++r) if ((L1 >> r) & 1u) ps += p1[r];
    { auto rr = __builtin_amdgcn_permlane32_swap(__float_as_uint(ps), __float_as_uint(ps), false, false); ps = __uint_as_float(rr[0]) + __uint_as_float(rr[1]); }
    l_reg = l_reg * alpha + ps;
#define FA_PK4(P, BASE, OUT) do { unsigned a0 = cvtpk(P[BASE + 0], P[BASE + 1]), a1 = cvtpk(P[BASE + 2], P[BASE + 3]); \
    unsigned b0_ = cvtpk(P[BASE + 4], P[BASE + 5]), b1_ = cvtpk(P[BASE + 6], P[BASE + 7]); \
    auto r0_ = __builtin_amdgcn_permlane32_swap(a0, b0_, false, false); auto r1_ = __builtin_amdgcn_permlane32_swap(a1, b1_, false, false); \
    u32x4 w_ = {r0_[0], r1_[0], r0_[1], r1_[1]}; OUT = __builtin_bit_cast(bf16x8, w_); } while (0)
    FA_PK4(p0, 0, pa0); FA_PK4(p0, 8, pa1); FA_PK4(p1, 0, pa2); FA_PK4(p1, 8, pa3);
#undef FA_PK4
}
template <unsigned L0, unsigned L1> __device__ __forceinline__ void bias_win(f32x16& p0, f32x16& p1, const LAS float* brow, int cs, int hi) {
#pragma unroll
    for (int r = 0; r < 16; ++r) { const int kc = crow(r, hi);
        if ((L0 >> r) & 1u) p0[r] = ((unsigned)(kc - cs) < 16u) ? p0[r] + brow[kc] : -30000.f;
        if ((L1 >> r) & 1u) p1[r] = ((unsigned)(kc + 32 - cs) < 16u) ? p1[r] + brow[kc + 32] : -30000.f; }
}
template <int N> __device__ __forceinline__ void wait_barn() { asm volatile("s_waitcnt vmcnt(%0) lgkmcnt(0)\n\ts_barrier" :: "n"(N) : "memory"); }
template <int DQK, int DV, int MODE, int S, int NHU = 1>
__device__ __forceinline__ void unit_pipe(LAS unsigned char* lds, const Desc& d) {
    constexpr int RB = DQK * 2, KB1 = 64 * RB, VB1 = 64 * DV * 2, KB = NHU * KB1, VB = NHU * VB1, SLOT = KB + VB, KP = KB / 8192, VP = VB / 8192, NCB = DV / 32, NK = DQK / 16, NPIECE = KP + VP;
    constexpr int DK = S - 1, DVV = S - 2, WSTEADY = DVV * NPIECE;
    static_assert(S >= 2 && WSTEADY < 64 && S * SLOT + 2048 + NHU * 1920 + 16 <= LDS_BYTES && (NHU == 1 || NHU == 4), "ring geometry");
    const int tid = tid_op(), wid = __builtin_amdgcn_readfirstlane(tid >> 6), lane = tid & 63, r32 = lane & 31, hi = lane >> 5;
    const int hl = (NHU > 1) ? (wid >> 1) : 0, wrow0 = (NHU > 1) ? (wid & 1) * 32 : wid * 32;
    LAS float* wsf = (LAS float*)(lds + S * SLOT) + wid * 64;
    LAS float* rpbs = (LAS float*)(lds + S * SLOT + 2048) + hl * 480;
    unsigned koff[KP], voff[VP], koffb[KP], voffb[VP];
#pragma unroll
    for (int i = 0; i < KP; ++i) { const int pp = (wid * KP + i) * 1024 + lane * 16, hh = pp / KB1, p = pp % KB1, row = p / RB, cs = (p % RB) >> 4, c = cs ^ ((row >> 1) & 7);
        koff[i] = (unsigned)((hh * d.hsa + row) * d.ldk + c * 8) * 2u; koffb[i] = (unsigned)(hh * (d.hsb - d.hsa) * d.ldk) * 2u; }
#pragma unroll
    for (int i = 0; i < VP; ++i) { const int pp = (wid * VP + i) * 1024 + lane * 16, hh = pp / VB1, p = pp % VB1, st = p >> 9, q = p & 511, kk = (st / NCB) * 8 + (q >> 6), c = (st % NCB) * 32 + ((q & 63) >> 1);
        const int k = (kk & ~0xC) | ((kk & 4) << 1) | ((kk & 8) >> 1); voff[i] = (unsigned)((hh * d.hsa + k) * d.ldv + c) * 2u; voffb[i] = (unsigned)(hh * (d.hsb - d.hsa) * d.ldv) * 2u; }
    int qr_row = 0, qc = 0, rs = 0, cs = 0;
    if constexpr (MODE == 2) {
        qr_row = d.r0 + ((NHU > 1) ? 0 : (wid >> 1)); qc = (wid & 1) * 32 + r32; rs = min(max(qr_row - 4, 0), 24); cs = min(max(qc - 8, 0), 48);
        for (int i = tid; i < NHU * 15 * 31; i += NTHREADS) ((LAS float*)(lds + S * SLOT + 2048))[(i / 465) * 480 + i % 465] = d.rpb[i] * LOG2E;
    }
#define FP_ACT(t) ((MODE != 2) || (t) >= d.nta || (d.wr0 + (t) >= rs && d.wr0 + (t) <= rs + 7))
#define FP_VAR(t) ((MODE == 2 && (t) < d.nta) ? 1 + (wid & 1) : 0)
#define FP_PSM(P0, P1, al, t, v) do { if ((v) == 0) partial_sm<MODE>(P0, P1, m_reg, al); \
        else { const LAS float* brow_ = rpbs + (d.wr0 + (t) - qr_row + 7) * 31 - qc + 15; \
               if ((v) == 1) { bias_win<0xFFFFu, 0x000Fu>(P0, P1, brow_, cs, hi); partial_sm<MODE, 0xFFFFu, 0x000Fu>(P0, P1, m_reg, al); } \
               else          { bias_win<0xF000u, 0xFFFFu>(P0, P1, brow_, cs, hi); partial_sm<MODE, 0xF000u, 0xFFFFu>(P0, P1, m_reg, al); } } } while (0)
#define FP_FSM(P0, P1, al, v) do { if ((v) == 0) finish_sm(P0, P1, al, l_reg, pa0, pa1, pa2, pa3); else if ((v) == 1) finish_sm<0xFFFFu, 0x000Fu>(P0, P1, al, l_reg, pa0, pa1, pa2, pa3); \
        else finish_sm<0xF000u, 0xFFFFu>(P0, P1, al, l_reg, pa0, pa1, pa2, pa3); } while (0)
#define FP_ROW(t) (((t) < d.nta) ? d.row0a + 64 * (t) : d.row0b + 64 * ((t) - d.nta))
#define FP_DMAK(t) do { const int t_ = (t); const GAS char* kb_ = (const GAS char*)(d.K + (size_t)FP_ROW(t_) * d.ldk); const int s_ = t_ % S; const unsigned sb_ = (t_ < d.nta) ? 0u : 1u; \
        _Pragma("unroll") for (int i_ = 0; i_ < KP; ++i_) __builtin_amdgcn_global_load_lds((const GAS unsigned*)(kb_ + (koff[i_] + sb_ * koffb[i_])), (LAS unsigned*)(lds + s_ * KB + (wid * KP + i_) * 1024), 16, 0, 0); } while (0)
#define FP_DMAV(t) do { const int t_ = (t); const GAS char* vb_ = (const GAS char*)(d.V + (size_t)FP_ROW(t_) * d.ldv); const int s_ = t_ % S; const unsigned sb_ = (t_ < d.nta) ? 0u : 1u; \
        _Pragma("unroll") for (int i_ = 0; i_ < VP; ++i_) __builtin_amdgcn_global_load_lds((const GAS unsigned*)(vb_ + (voff[i_] + sb_ * voffb[i_])), (LAS unsigned*)(lds + S * KB + s_ * VB + (wid * VP + i_) * 1024), 16, 0, 0); } while (0)
#pragma unroll
    for (int s = -DK; s < 0; ++s) { FP_DMAK(s + DK); if (s + DVV >= 0) FP_DMAV(s + DVV); }
    bf16x8 qr[NK];
    { const gbf* Qw = d.Q + (size_t)(hl * d.hsa + wrow0 + r32) * d.ldq + hi * 8;
#pragma unroll
      for (int d0 = 0; d0 < NK; ++d0) qr[d0] = *(const GAS bf16x8*)(Qw + d0 * 16); }
    float m_reg = -1e30f, l_reg = 0.f;
    f32x16 o[NCB];
#pragma unroll
    for (int i = 0; i < NCB; ++i) o[i] = f32x16{};
    const int vbase = (int)(unsigned)(size_t)(lds + S * KB + hl * VB1) + v_rd_base(lane);
    const int ksw = ((r32 >> 1) & 7);
    const int NT = d.NT;
#define FP_QKT(P0, P1, t) do { const LAS unsigned char* Ks_ = lds + ((t) % S) * KB + hl * KB1; P0 = f32x16{}; P1 = f32x16{}; \
        _Pragma("unroll") for (int d0 = 0; d0 < NK; ++d0) { const int cb_ = ((2 * d0 + hi) ^ ksw) << 4; \
            const bf16x8 b0_ = *(const LAS bf16x8*)(Ks_ + r32 * RB + cb_), b1_ = *(const LAS bf16x8*)(Ks_ + (32 + r32) * RB + cb_); \
            P0 = __builtin_amdgcn_mfma_f32_32x32x16_bf16(b0_, qr[d0], P0, 0, 0, 0); P1 = __builtin_amdgcn_mfma_f32_32x32x16_bf16(b1_, qr[d0], P1, 0, 0, 0); } } while (0)
#define FP_PV(t) do { const int vb_ = vbase + ((t) % S) * VB; pv_one<NCB, 0>(o[0], vb_, pa0, pa1, pa2, pa3); pv_one<NCB, 1>(o[1], vb_, pa0, pa1, pa2, pa3); \
        if constexpr (NCB == 4) { pv_one<NCB, 2>(o[2], vb_, pa0, pa1, pa2, pa3); pv_one<NCB, 3>(o[3], vb_, pa0, pa1, pa2, pa3); } } while (0)
#define FP_RESC(a) do { if (__any((a) < 1.f)) { if (hi == 0) wsf[r32] = (a); asm volatile("s_waitcnt lgkmcnt(0)" ::: "memory"); \
        _Pragma("unroll") for (int dd = 0; dd < NCB; ++dd) _Pragma("unroll") for (int r = 0; r < 16; ++r) o[dd][r] *= wsf[crow(r, hi)]; } } while (0)
#define FP_ENDWAIT(j) do { if ((j) + DK < NT) wait_barn<WSTEADY>(); else wait_barn<0>(); } while (0)
#define FP_STEP(C0, C1, alC, Pv0, Pv1, alP, j) do { \
        if ((j) + DK < NT) FP_DMAK((j) + DK); \
        if ((j) + DVV < NT) FP_DMAV((j) + DVV); \
        __builtin_amdgcn_sched_barrier(0); \
        const bool actC_ = FP_ACT(j); \
        if (actC_) { FP_QKT(C0, C1, j); } \
        FP_FSM(Pv0, Pv1, alP, varP); __builtin_amdgcn_sched_barrier(0); \
        if (actP) { FP_PV((j) - 1); } \
        const int varC_ = FP_VAR(j); \
        if (actC_) { FP_PSM(C0, C1, alC, j, varC_); FP_RESC(alC); } \
        else { _Pragma("unroll") for (int r = 0; r < 16; ++r) { C0[r] = 0.f; C1[r] = -30000.f; } alC = 1.f; }     \
        actP = actC_; varP = varC_; \
        FP_ENDWAIT(j); } while (0)
    f32x16 pA0, pA1, pB0, pB1; float alA = 1.f, alB = 1.f; bf16x8 pa0, pa1, pa2, pa3;
    wait_barn<WSTEADY>();
    if (DK < NT) FP_DMAK(DK);
    if (DVV < NT) FP_DMAV(DVV);
    bool actP = FP_ACT(0);
    int varP = FP_VAR(0);
    if (actP) { FP_QKT(pA0, pA1, 0); FP_PSM(pA0, pA1, alA, 0, varP); }
    else {
#pragma unroll
        for (int r = 0; r < 16; ++r) { pA0[r] = 0.f; pA1[r] = -30000.f; } }
    FP_ENDWAIT(0);
    for (int j = 1; j + 1 < NT; j += 2) {
        FP_STEP(pB0, pB1, alB, pA0, pA1, alA, j);
        FP_STEP(pA0, pA1, alA, pB0, pB1, alB, j + 1);
    }
    FP_STEP(pB0, pB1, alB, pA0, pA1, alA, NT - 1);
    FP_FSM(pB0, pB1, alB, varP); __builtin_amdgcn_sched_barrier(0);
    if (actP) { FP_PV(NT - 1); }
    if (hi == 0) wsf[32 + r32] = l_reg;
    wait_barn<0>();
    {
        constexpr int RS = DV + 8, CPR = DV / 8, NCHL = 32 * CPR / 64;
        LAS bf16_t* st = (LAS bf16_t*)(lds + wid * (32 * RS * 2));
        const gbf* Gw = d.G + (size_t)wrow0 * d.ldg + hl * DV; gbf* Ow = d.O + (size_t)wrow0 * d.ldo + hl * DV;
        u32x4 gv[NCHL];
#pragma unroll
        for (int i = 0; i < NCHL; ++i) { const int idx = i * 64 + lane, row = idx / CPR, cc = idx % CPR; gv[i] = *(const GAS u32x4*)(Gw + (size_t)row * d.ldg + cc * 8); }
#pragma unroll
        for (int r = 0; r < 16; ++r) { const float rl = __builtin_amdgcn_rcpf(wsf[32 + crow(r, hi)]);
#pragma unroll
            for (int dd = 0; dd < NCB; ++dd) st[crow(r, hi) * RS + dd * 32 + r32] = (bf16_t)f2bf(o[dd][r] * rl); }
        asm volatile("s_waitcnt lgkmcnt(0)" ::: "memory");
#pragma unroll
        for (int i = 0; i < NCHL; ++i) { const int idx = i * 64 + lane, row = idx / CPR, cc = idx % CPR;
            f32x4 va, vb, ga, gb; unpk8(*(const LAS u32x4*)(st + row * RS + cc * 8), va, vb); unpk8(gv[i], ga, gb);
            *(GAS u32x4*)(Ow + (size_t)row * d.ldo + cc * 8) = pk8(va * ga, vb * gb); }
    }
    asm volatile("s_waitcnt lgkmcnt(0)\n\ts_barrier" ::: "memory");
#undef FP_ROW
#undef FP_ACT
#undef FP_VAR
#undef FP_PSM
#undef FP_FSM
#undef FP_DMAK
#undef FP_DMAV
#undef FP_QKT
#undef FP_PV
#undef FP_RESC
#undef FP_ENDWAIT
#undef FP_STEP
}
}

__device__ __forceinline__ void phase_attn_fast(const Params& p, int l, unsigned char* lds_, int gid, int G) {
    LAS unsigned char* lds = (LAS unsigned char*)lds_;
    gu8* ws = wsb();
    const gbf* P = (const gbf*)(ws + WS_P); const gbf* KM = (const gbf*)(ws + WS_KM); const gbf* VM = (const gbf*)(ws + WS_VM); const gbf* QM = (const gbf*)(ws + WS_QM);
    const gbf* NK = (const gbf*)(ws + WS_NK); const gbf* NV = (const gbf*)(ws + WS_NV); const gbf* NQ = (const gbf*)(ws + WS_NQ);
    gbf* AB = (gbf*)(ws + WS_AB);
    const gf32* rpb = pin(I_RPB) + (size_t)l * 16 * 15 * 31;
    const int vcu = (G % 8 == 0) ? (gid % 8) * (G / 8) + gid / 8 : gid;
    __syncthreads();
    for (int rep = 0; rep < (PROBE_DUP == 50 ? 2 : 1); ++rep)
    for (int u = vcu; u < NB * 8 * 8; u += G) { const int b = u >> 6, h = (u >> 3) & 7, qb = u & 7; const size_t q0 = (size_t)b * SEQ + qb * 256;
        const int lat0 = (b * 8 + h) * SEQ, ctx0 = NB * 8 * SEQ + (b * 8 + h) * CTXL;
        fa::Desc d{QM + (size_t)(lat0 + qb * 256) * 192, 192, KM, 192, VM, 128, ctx0, 4, lat0, 36, P + q0 * PP + C_GML + h * 128, PP, AB + q0 * ABW + 1024 + h * 128, ABW, 0, 0, nullptr, 0, 0};
        fa::unit_pipe<192, 128, 0, 3>(lds, d); }
    const bool upper = gid >= G / 2; const int nac = upper ? gid - G / 2 : gid, nacu = (G % 16 == 0) ? (nac % 8) * (G / 16) + nac / 8 : nac;
    for (int rep = 0; rep < (PROBE_DUP == 51 ? 2 : 1); ++rep)
    for (int u4 = nacu; u4 < NB * 16 * 2; u4 += G / 2) for (int u = u4 * 4 + (upper ? 0 : 3); u < u4 * 4 + (upper ? 3 : 4); ++u) {
        const int b = u >> 7, h0 = ((u >> 5) & 3) * 4, r = u & 31, rs = min(max(r - 4, 0), 24); const size_t q0 = (size_t)b * SEQ + r * 64;
        const int lat0 = (b * 16 + h0) * SEQ, ctx0 = NB * 16 * SEQ + (b * 16 + h0) * CTXL;
        fa::Desc d{NQ + (size_t)(lat0 + r * 64) * 64, 64, NK, 64, NV, 64, lat0 + rs * 64, 8, ctx0, 12, P + q0 * PP + C_GNA + h0 * 64, PP, AB + q0 * ABW + 2048 + h0 * 64, ABW,
                   r, rs, rpb + h0 * 15 * 31, SEQ, CTXL};
        fa::unit_pipe<64, 64, 2, 2, 4>(lds, d); }
    if (l == 0) {
        for (int u = gid - G / 2; u >= 0 && u < NB * 8; u += G) { const int b = u >> 3, h = u & 7; const size_t q0 = (size_t)NLAT + b * CTXL; const int ctx0 = NB * 8 * SEQ + (b * 8 + h) * CTXL;
            fa::Desc d{QM + (size_t)ctx0 * 192, 192, KM, 192, VM, 128, ctx0, 4, 0, 4, P + q0 * PP + C_GML + h * 128, PP, AB + q0 * ABW + 1024 + h * 128, ABW, 0, 0, nullptr, 0, 0};
            fa::unit_pipe<192, 128, 0, 3>(lds, d); }
        for (int u = gid - G / 2 - 32; u >= 0 && u < NB * 16; u += G) { const int b = u >> 4, h = u & 15; const size_t q0 = (size_t)NLAT + b * CTXL; const int ctx0 = NB * 16 * SEQ + (b * 16 + h) * CTXL;
            fa::Desc d{NQ + (size_t)ctx0 * 64, 64, NK, 64, NV, 64, ctx0, 4, 0, 4, P + q0 * PP + C_GNA + h * 64, PP, AB + q0 * ABW + 2048 + h * 64, ABW, 0, 0, nullptr, 0, 0};
            fa::unit_pipe<64, 64, 0, 4>(lds, d); }
    }
    __syncthreads();
}


#define XB_TMO      128
#define XB_XCNT(j)  (256  + 64 * (j))
#define XB_XSUB(j)  (1280 + 64 * (j))
#define XB_XGEN(j)  (2304 + 64 * (j))
#define XB_TOP      3328
#define XB_TOPGEN   3392
#define XCD_BAR_WORDS 3456
#define XB_SPIN_CAP (1u << 18)
__device__ __forceinline__ unsigned xb_ld(unsigned* p)              { return __hip_atomic_load(p, __ATOMIC_RELAXED, __HIP_MEMORY_SCOPE_AGENT); }
__device__ __forceinline__ unsigned xb_add(unsigned* p, unsigned v) { return __hip_atomic_fetch_add(p, v, __ATOMIC_RELAXED, __HIP_MEMORY_SCOPE_AGENT); }
__device__ __forceinline__ unsigned xb_xcc_id() { return (unsigned)__builtin_amdgcn_s_getreg((3 << 11) | 20) & 0xFu; }
#define XB_SPIN(cond, bar) do { unsigned _sp = 0; while (cond) { __builtin_amdgcn_s_sleep(1); \
    if ((++_sp & 255u) == 0u) { if (xb_ld(&(bar)[XB_TMO])) break; if (_sp > XB_SPIN_CAP) { atomicAdd(&(bar)[XB_TMO], 1u); break; } } } } while (0)
struct XcdBarrier { unsigned* bar; unsigned x; volatile LAS unsigned* st; };
__device__ __forceinline__ XcdBarrier xcd_barrier_post(unsigned* bar, volatile LAS unsigned* st) {
    XcdBarrier b; b.bar = bar; b.x = xb_xcc_id(); b.st = st;
    if (threadIdx.x == 0) (void)xb_add(&bar[XB_XCNT(b.x)], 1u);
    return b;
}
__device__ __forceinline__ void xcd_barrier_complete(unsigned* bar, unsigned x, unsigned& nloc, unsigned& nx) {
    const unsigned G = gridDim.x * gridDim.y * gridDim.z;
    unsigned sum, cnt, mine, sp = 0u;
    for (;;) {
        sum = 0u; cnt = 0u; mine = 0u;
#pragma unroll
        for (unsigned j = 0; j < 16; ++j) { const unsigned c = xb_ld(&bar[XB_XCNT(j)]); sum += c; cnt += (c > 0u) ? 1u : 0u; mine = (j == x) ? c : mine; }
        if (sum == G) break;
        __builtin_amdgcn_s_sleep(1);
        if ((++sp & 255u) == 0u) { if (xb_ld(&bar[XB_TMO])) break; if (sp > XB_SPIN_CAP) { atomicAdd(&bar[XB_TMO], 1u); break; } }
    }
    nloc = mine > 0u ? mine : 1u; nx = cnt > 0u ? cnt : 1u;
}
__device__ __forceinline__ void xcd_barrier(const XcdBarrier& b) {
    asm volatile("s_waitcnt vmcnt(0)" ::: "memory");
    __syncthreads();
    if (threadIdx.x == 0) {
        unsigned* bar = b.bar;
        __builtin_amdgcn_s_waitcnt(0);
        unsigned nloc = b.st[0], nx = b.st[1];
        if (nloc == 0u) { xcd_barrier_complete(bar, b.x, nloc, nx); b.st[0] = nloc; b.st[1] = nx; }
        const unsigned old = xb_add(&bar[XB_XSUB(b.x)], 1u);
        const unsigned gen = old / nloc;
        if (old + 1u == (gen + 1u) * nloc) {
            __builtin_amdgcn_fence(__ATOMIC_RELEASE, "agent");
            asm volatile("s_waitcnt vmcnt(0)" ::: "memory");
            const unsigned og = xb_add(&bar[XB_TOP], 1u);
            const unsigned tg = og / nx;
            if (og + 1u == (tg + 1u) * nx) xb_add(&bar[XB_TOPGEN], 1u);
            else XB_SPIN(xb_ld(&bar[XB_TOPGEN]) == tg, bar);
            __builtin_amdgcn_fence(__ATOMIC_ACQUIRE, "agent");
            xb_add(&bar[XB_XGEN(b.x)], 1u);
            asm volatile("s_waitcnt vmcnt(0)" ::: "memory");
        } else {
            XB_SPIN(xb_ld(&bar[XB_XGEN(b.x)]) == gen, bar);
            __builtin_amdgcn_fence(__ATOMIC_ACQUIRE, "agent");
            asm volatile("s_waitcnt vmcnt(0)" ::: "memory");
        }
    }
    __syncthreads();
}

#define WSB(off) (wsb() + (off))
__global__ void __launch_bounds__(NTHREADS, 2) fwd_megakernel(Params p) {
    extern __shared__ __attribute__((aligned(16))) unsigned char lds[];
    cg::grid_group grid = cg::this_grid();
    const int gid_ = blockIdx.x, G_ = gridDim.x;
    auto sop = [](int v) { asm volatile("" : "+s"(v)); return v; };
#define gid sop(gid_)
#define G sop(G_)

    { volatile LAS unsigned* st0 = (volatile LAS unsigned*)((LAS unsigned char*)lds + LDS_BYTES - 16); if (threadIdx.x < 4) st0[threadIdx.x] = 0u; __syncthreads(); }
    (void)xcd_barrier_post((unsigned*)(wsb() + WS_BAR), (volatile LAS unsigned*)((LAS unsigned char*)lds + LDS_BYTES - 16));
    if (wsb() == nullptr) grid.sync();
#define GSYNC() xcd_barrier(XcdBarrier{(unsigned*)(wsb() + WS_BAR), xb_xcc_id(), (volatile LAS unsigned*)((LAS unsigned char*)lds + LDS_BYTES - 16)})
    for (int rep = 0; rep < (PROBE_DUP == 0 ? 2 : 1); ++rep) { phase0(p, lds, gid, G); GSYNC(); }

    for (int rep = 0; rep < (PROBE_DUP == 1 ? 2 : 1); ++rep) { phase_uprep0(p, gid, G); GSYNC(); }
    for (int l = 0; l < DEPTH; ++l) {
        const int nq = (l == 0) ? NROW : NLAT;
        for (int rep = 0; rep < (PROBE_DUP == 2 ? 2 : 1); ++rep) {
            const gbf* WinT = (const gbf*)WSB(WS_WIN) + (size_t)l * NP * KP2; gbf* U = (gbf*)WSB(WS_U); gbf* P = (gbf*)WSB(WS_P);
            gemm_run(lds, GemmJob{U, KP2, WinT, KP2, nq, NP, DM}, EpiInProj{P, 0, (gbf*)WSB(WS_NK), (gbf*)WSB(WS_NV), (gbf*)WSB(WS_NQ), (gbf*)WSB(WS_MG)}, gid, G);
            GSYNC();
        }
        for (int rep = 0; rep < (PROBE_DUP == 3 ? 2 : 1); ++rep) {
            if (l == 0) phase_c1(p, l, NROW, gid, G);
            else if (gid < 40) gemm_run(lds, GemmJob{(const gbf*)WSB(WS_U) + (size_t)NLAT * KP2, KP2, (const gbf*)WSB(WS_WIN) + (size_t)l * NP * KP2, KP2, NCTX, KVC_P, DM},
                                        EpiInProjC1{(gbf*)WSB(WS_P), (gbf*)WSB(WS_NK), (gbf*)WSB(WS_KM), (gf32*)WSB(WS_SSQ)}, gid, 40);
            else phase_c1(p, l, NLAT, gid - 40, G - 40);
            GSYNC();
        }
        for (int rep = 0; rep < (PROBE_DUP == 4 ? 2 : 1); ++rep) {
            __syncthreads();
            { SchedC2 S{(const gbf*)WSB(WS_P), (const gbf*)WSB(WS_WUKV) + (size_t)l * 2048 * 256, (const gbf*)WSB(WS_WUQ) + (size_t)l * 1536 * 512, (const gbf*)WSB(WS_DC), nq / 256, l == 0 ? 32 : 0, G, gid};
              EpiC2 E{(gbf*)WSB(WS_KM), (gbf*)WSB(WS_VM), (gbf*)WSB(WS_QM), (gbf*)WSB(WS_GT), (gbf*)WSB(WS_GTC), (const gf32*)WSB(WS_RKV), (const gf32*)WSB(WS_RQ), (const gf32*)WSB(WS_ROPE), l == 1 ? (const gf32*)WSB(WS_SSQ) : (const gf32*)nullptr};
              fg::gemm_multi((LAS unsigned char*)lds, S, E); }
            __syncthreads();
            GSYNC();
        }
        for (int rep = 0; rep < (PROBE_DUP == 5 ? 2 : 1); ++rep) {
        phase_attn_fast(p, l, lds, gid, G);
        for (int rep2 = 0; rep2 < (PROBE_DUP == 52 ? 2 : 1); ++rep2)
        gemm_fast_z(lds, MapF2{(const gbf*)WSB(WS_DN), (const gbf*)WSB(WS_GT), KP4}, KP4, KP4, 2 * SEQ, SEQ / 256, 4, NB, EpiF2{(gbf*)WSB(WS_AB), (const gbf*)WSB(WS_P), 0, SEQ}, gid < G / 2 ? gid : -1, G / 2);
        if (l == 0) gemm_fast_z(lds, MapF2{(const gbf*)WSB(WS_DNC), (const gbf*)WSB(WS_GTC), 2 * CTXL}, 2 * CTXL, 2 * CTXL, 2 * CTXL, 1, 4, NB, EpiF2{(gbf*)WSB(WS_AB), (const gbf*)WSB(WS_P), NLAT, CTXL}, gid - G / 2 - 96, G);
        GSYNC();
        }
        const gbf* WpT = (const gbf*)WSB(WS_WP) + (size_t)l * 4 * 2048 * KP1; const gbf* WoT = (const gbf*)WSB(WS_WO) + (size_t)l * 2048 * KP2;
        const int NC = G / 8;
        for (int rep = 0; rep < (PROBE_DUP == 6 ? 2 : 1); ++rep) {
          __syncthreads();
          { fg::SchedBranch S{(const gbf*)WSB(WS_AB), WpT, NLAT / 256, DM / 256, G, gid, 0};
            fg::gemm((LAS unsigned char*)lds, ABW, KP1, 1024, S, EpiChain{(gbf*)WSB(WS_MB), (const gbf*)WSB(WS_MG), 0}); }
          __syncthreads();
          GSYNC();
        }
        for (int rep = 0; rep < (PROBE_DUP == 7 ? 2 : 1); ++rep) {
          if (l == 0) {
            __syncthreads();
            if (gid < NC) { fg::SchedBranch S{(const gbf*)WSB(WS_AB), WpT, NCTX / 256, DM / 256, NC, gid, NLAT / 256};
                            fg::gemm((LAS unsigned char*)lds, ABW, KP1, 1024, S, EpiChain{(gbf*)WSB(WS_MB), (const gbf*)WSB(WS_MG), NLAT}); }
            else { fg::Sched<fg::MapPlain> S{fg::MapPlain{(const gbf*)WSB(WS_MB), KP2, WoT, KP2}, NLAT / 256, DM / 256, 1, G - NC, gid - NC};
                   fg::gemm((LAS unsigned char*)lds, KP2, KP2, DM, S, EpiOut{(gf32*)WSB(WS_Y), 0}); }
            __syncthreads();
          } else gemm_run(lds, GemmJob{(const gbf*)WSB(WS_MB), KP2, WoT, KP2, NLAT, DM, DM}, EpiOut{(gf32*)WSB(WS_Y), 0}, gid, G);
          GSYNC();
        }
        for (int rep = 0; rep < (PROBE_DUP == 8 ? 2 : 1); ++rep) {
          if (l == 0) {
            if (gid < NC) gemm_run(lds, GemmJob{(const gbf*)WSB(WS_MB) + (size_t)NLAT * KP2, KP2, WoT, KP2, NCTX, DM, DM}, EpiOut{(gf32*)WSB(WS_Y), NLAT}, gid, NC);
            else phase_final(p, l, 0, NLAT, gid - NC, G - NC);
            GSYNC();
            phase_final(p, l, NLAT, NROW, gid, G);
            GSYNC();
          } else {
            phase_final(p, l, 0, NLAT, gid, G);
            if (rep + 1 < (PROBE_DUP == 8 ? 2 : 1)) GSYNC();
          }
        }
    }
}
#undef gid
#undef G

extern "C" void kernel_launch(void* const* d_in, const int* in_sizes, int n_in, void* d_out, int out_size, void* d_ws, size_t ws_size, hipStream_t stream) {
    static int grid_blocks = 0;
    if (grid_blocks == 0) {
        if (n_in != 20 || out_size != NLAT * DM || ws_size < WS_END) { fprintf(stderr, "kernel_launch: unexpected shapes (n_in %d out %d ws %zu, need ws >= %zu)\n", n_in, out_size, ws_size, (size_t)WS_END); grid_blocks = -1; return; }
        int dev = 0, cus = 0, per_cu = 0;
        hipGetDevice(&dev);
        hipDeviceGetAttribute(&cus, hipDeviceAttributeMultiprocessorCount, dev);
        if (hipFuncSetAttribute((const void*)fwd_megakernel, hipFuncAttributeMaxDynamicSharedMemorySize, LDS_BYTES) != hipSuccess) { fprintf(stderr, "kernel_launch: hipFuncSetAttribute failed\n"); grid_blocks = -1; return; }
        if (hipOccupancyMaxActiveBlocksPerMultiprocessor(&per_cu, (const void*)fwd_megakernel, NTHREADS, LDS_BYTES) != hipSuccess || per_cu < 1) { fprintf(stderr, "kernel_launch: occupancy query failed (%d)\n", per_cu); grid_blocks = -1; return; }
        grid_blocks = cus;
        fprintf(stderr, "kernel_launch: cus %d per_cu %d grid %d\n", cus, per_cu, grid_blocks);
    }
    if (grid_blocks < 0) return;
    if (hipMemsetAsync((char*)d_ws + WS_BAR, 0, 16384, stream) != hipSuccess) { fprintf(stderr, "kernel_launch: hipMemsetAsync of the barrier words failed\n"); return; }
    Params p{};
    for (int i = 0; i < 20; ++i) p.in[i] = (const gf32*)d_in[i];
    p.out = (gf32*)d_out; p.ws = (gu8*)d_ws;
    void* args[] = {&p};
    hipError_t e = hipLaunchCooperativeKernel((const void*)fwd_megakernel, dim3(grid_blocks), dim3(NTHREADS), args, LDS_BYTES, stream);
    if (e != hipSuccess) fprintf(stderr, "kernel_launch: cooperative launch failed: %s (grid %d)\n", hipGetErrorString(e), grid_blocks);
}
```

```cpp
#include <hip/hip_runtime.h>
#include <hip/hip_cooperative_groups.h>
#include <cstdio>
#include <cstdint>
namespace cg = cooperative_groups;
#ifndef PROBE_DUP
#define PROBE_DUP -1
#endif

#define GAS __attribute__((address_space(1)))
typedef unsigned short bf16_t;
typedef GAS bf16_t gbf;
typedef GAS float gf32;
typedef GAS unsigned char gu8;
typedef float f32x4 __attribute__((ext_vector_type(4)));
typedef unsigned u32x4 __attribute__((ext_vector_type(4)));
typedef unsigned u32x2 __attribute__((ext_vector_type(2)));

constexpr int DM = 2048, NB = 4, SEQ = 2048, CTXL = 256, DEPTH = 2;
constexpr int NLAT = NB * SEQ, NCTX = NB * CTXL, NROW = NLAT + NCTX;
constexpr int N_IN = 20288, NP = 20480;
constexpr int PP = 12288 + 64;
constexpr int KP2 = DM + 64;
constexpr int KP1 = 1024 + 64;
constexpr int KP4 = 4096 + 64;
constexpr int C_CKV = 0, C_KR = 256, C_NAK = 512, C_NAV = 1536, C_QL = 2560, C_NAQ = 3072, C_CB = 4096, C_CC = 5120, C_CX = 6144, C_FV = 7168,
              C_GCV = 8192, C_GML = 9216, C_GNA = 10240, C_GFN = 11264, C_MG = 12288;
constexpr int KVC_P = 2560;
constexpr int KMW = 1536, VMW = 1024, QMW = 1536, ABW = 4160;
constexpr float EPS = 1e-6f;
constexpr float LOG2E = 1.4426950408889634f;
constexpr float QSCALE = 0.07216878364870322f * LOG2E;
constexpr float NASCALE = 0.125f * LOG2E;
constexpr int NTHREADS = 512, NWAVES = 8;
constexpr int LDS_BYTES = 147456;

constexpr size_t al256(size_t x) { return (x + 255) / 256 * 256; }
constexpr size_t WS_WIN = 0;
constexpr size_t WS_WUKV = WS_WIN + al256((size_t)2 * NP * KP2 * 2);
constexpr size_t WS_WUQ = WS_WUKV + al256((size_t)2 * 2048 * 256 * 2);
constexpr size_t WS_WP = WS_WUQ + al256((size_t)2 * 1536 * 512 * 2);
constexpr size_t WS_WO = WS_WP + al256((size_t)2 * 4 * 2048 * KP1 * 2);
constexpr size_t WS_MOD = WS_WO + al256((size_t)2 * 2048 * KP2 * 2);
constexpr size_t WS_ROPE = WS_MOD + al256((size_t)2 * 5 * 6144 * 4);
constexpr size_t WS_DC = WS_ROPE + al256((size_t)64 * 16 * 2 * 4);
constexpr size_t WS_DN = WS_DC + al256((size_t)512 * 256 * 2);
constexpr size_t WS_DNC = WS_DN + al256((size_t)2048 * KP4 * 2);
constexpr size_t WS_U = WS_DNC + al256((size_t)256 * 512 * 2);
constexpr size_t WS_P = WS_U + al256((size_t)NROW * KP2 * 2);
constexpr size_t WS_KM = WS_P + al256((size_t)NROW * PP * 2);
constexpr size_t WS_VM = WS_KM + al256((size_t)NROW * KMW * 2);
constexpr size_t WS_QM = WS_VM + al256((size_t)NROW * VMW * 2);
constexpr size_t WS_AB = WS_QM + al256((size_t)NROW * QMW * 2);
constexpr size_t WS_GT = WS_AB + al256((size_t)NROW * ABW * 2);
constexpr size_t WS_GTC = WS_GT + al256((size_t)4 * 1024 * KP4 * 2);
constexpr size_t WS_MF = WS_GTC + al256((size_t)4 * 1024 * 512 * 2);
constexpr size_t WS_MB = WS_MF + al256((size_t)NROW * DM * 4);
constexpr size_t WS_Y = WS_MB + al256((size_t)NROW * KP2 * 2);
constexpr size_t WS_RKV = WS_Y + al256((size_t)NROW * DM * 4);
constexpr size_t WS_RQ = WS_RKV + al256((size_t)NROW * 4);
constexpr size_t WS_XL = WS_RQ + al256((size_t)NROW * 4);
constexpr size_t WS_NK = WS_XL + al256((size_t)NROW * DM * 4);
constexpr size_t WS_NV = WS_NK + al256((size_t)NROW * 1024 * 2);
constexpr size_t WS_NQ = WS_NV + al256((size_t)NROW * 1024 * 2);
constexpr size_t WS_MG = WS_NQ + al256((size_t)NROW * 1024 * 2);
constexpr size_t WS_SSQ = WS_MG + al256((size_t)4 * NROW * DM * 2);
constexpr size_t WS_BAR = WS_SSQ + al256((size_t)NCTX * 8 * 4);
constexpr size_t WS_END = WS_BAR + 16384;

struct Params { const gf32* in[20]; gf32* out; gu8* ws; };
enum { I_X = 0, I_C, I_CTX, I_CCTX, I_GPRE, I_GPOST, I_WADA, I_BADA, I_WIN, I_GQ, I_GKV, I_WUQ, I_WUKV, I_CONVW, I_RPB, I_WPC, I_WPM, I_WPN, I_WPF, I_WOUT };

__device__ __forceinline__ size_t hm_row(int r, int h, int NH) {
    return r < NLAT ? (size_t)(((r >> 11) * NH + h) * SEQ + (r & (SEQ - 1))) : (size_t)NB * NH * SEQ + (size_t)((((r - NLAT) >> 8) * NH + h) * CTXL + ((r - NLAT) & (CTXL - 1)));
}

__device__ __forceinline__ size_t mg_off(int z, int r, int c) { return ((((size_t)z * (NROW / 256) + (r >> 8)) * (DM / 256) + (c >> 8)) * 256 + (r & 255)) * 256 + (c & 255); }

__device__ __forceinline__ unsigned f2bf(float f) { unsigned u = __builtin_bit_cast(unsigned, f); return (u + 0x7fffu + ((u >> 16) & 1u)) >> 16; }
typedef float f32x2_t __attribute__((ext_vector_type(2))); typedef __bf16 bf16x2_t __attribute__((ext_vector_type(2)));
__device__ __forceinline__ unsigned pk2(float lo, float hi) { f32x2_t v = {lo, hi}; bf16x2_t b = __builtin_convertvector(v, bf16x2_t); return __builtin_bit_cast(unsigned, b); }
__device__ __forceinline__ float bf2f(unsigned short b) { return __builtin_bit_cast(float, (unsigned)b << 16); }
__device__ __forceinline__ float bflo(unsigned w) { return __builtin_bit_cast(float, w << 16); }
__device__ __forceinline__ float bfhi(unsigned w) { return __builtin_bit_cast(float, w & 0xffff0000u); }
__device__ __forceinline__ u32x2 pk4(f32x4 v) { u32x2 r; r.x = pk2(v[0], v[1]); r.y = pk2(v[2], v[3]); return r; }
__device__ __forceinline__ u32x4 pk8(f32x4 a, f32x4 b) { u32x4 r; r.x = pk2(a[0], a[1]); r.y = pk2(a[2], a[3]); r.z = pk2(b[0], b[1]); r.w = pk2(b[2], b[3]); return r; }
__device__ __forceinline__ void unpk8(u32x4 w, f32x4& a, f32x4& b) { a = (f32x4){bflo(w.x), bfhi(w.x), bflo(w.y), bfhi(w.y)}; b = (f32x4){bflo(w.z), bfhi(w.z), bflo(w.w), bfhi(w.w)}; }
__device__ __forceinline__ f32x4 unpk4(u32x2 w) { return (f32x4){bflo(w.x), bfhi(w.x), bflo(w.y), bfhi(w.y)}; }
__device__ __forceinline__ float sigmoidf_(float x) { return __builtin_amdgcn_rcpf(1.0f + __builtin_amdgcn_exp2f(x * -LOG2E)); }
__device__ __forceinline__ float siluf_(float x) { return x * __builtin_amdgcn_rcpf(1.0f + __builtin_amdgcn_exp2f(x * -LOG2E)); }
__device__ __forceinline__ float wave_sum(float v) {
#pragma unroll
    for (int o = 1; o < 64; o <<= 1) v += __shfl_xor(v, o);
    return v;
}
__device__ __forceinline__ float wave_max(float v) {
#pragma unroll
    for (int o = 1; o < 64; o <<= 1) v = fmaxf(v, __shfl_xor(v, o));
    return v;
}

typedef __attribute__((address_space(4))) const unsigned char* kargp_t;
__device__ __forceinline__ kargp_t karg_op() { kargp_t k = (kargp_t)__builtin_amdgcn_kernarg_segment_ptr(); asm volatile("" : "+s"(k)); return k; }
__device__ __forceinline__ const gf32* pin(int i) { return *(const gf32* const __attribute__((address_space(4)))*)(karg_op() + 8 * i); }
__device__ __forceinline__ gf32* pout() { return *(gf32* const __attribute__((address_space(4)))*)(karg_op() + 8 * 20); }
__device__ __forceinline__ gu8* wsb() { return *(gu8* const __attribute__((address_space(4)))*)(karg_op() + 8 * 21); }
__device__ __forceinline__ int tid_op() { int t = threadIdx.x; asm volatile("" : "+v"(t)); return t; }

struct GemmJob { const gbf* A; int lda; const gbf* Bt; int ldb; int M, N, K; };

#define LAS __attribute__((address_space(3)))
typedef short bf16x8 __attribute__((ext_vector_type(8)));
namespace fg {
constexpr int BM = 256, BK = 64, HALF = 128, HTB = HALF * BK * 2, STAGE_BYTES = 8 * HTB, NXCD = 8, WGM = 4;
__device__ __forceinline__ int lds_byte(int r, int c) { const int st = (r >> 4) * 2 + (c >> 5), rr = r & 15, cc = c & 31, ob = rr * 64 + cc * 2; return st * 1024 + (ob ^ (((ob >> 9) & 1) << 5)); }
__device__ __forceinline__ void stage_rc(int b, int& R, int& C) { const int st = b / 1024, sb = b % 1024, swz = sb ^ (((sb >> 9) & 1) << 5); R = (st >> 1) * 16 + swz / 64; C = (st & 1) * 32 + (swz % 64) / 2; }
__device__ __forceinline__ int perm32(int rho) { const int n = rho >> 4, i = rho & 15; return 8 * (i >> 2) + 4 * n + (i & 3); }
struct Unit { const GAS char* A; const GAS char* B; int pm, pn, z; };
template <class Map> struct Sched {
    Map map; int nM, nN, nz, G, c;
    __device__ __forceinline__ bool next(int i, Unit& u) const {
        const int per = nM * nN, nwg = per * nz; const long L = (long)i * G + c; if (L >= nwg) return false;
        int wgid = (int)L; { const int q = nwg / NXCD, r = nwg % NXCD, xcd = wgid % NXCD, off = wgid / NXCD; wgid = (xcd < r ? xcd * (q + 1) : r * (q + 1) + (xcd - r) * q) + off; }
        const int z = wgid / per, w = wgid % per;
        const int nig = WGM * nN, gidx = w / nig, fm = gidx * WGM, gsz = (nM - fm) < WGM ? (nM - fm) : WGM;
        u.pm = fm + ((w % nig) % gsz); u.pn = (w % nig) / gsz; u.z = z; u.A = (const GAS char*)map.a(z, u.pm); u.B = (const GAS char*)map.b(z, u.pn); return true;
    }
};
template <class Epi, class S_>
__device__ __forceinline__ void gemm(LAS unsigned char* lds, int lda, int ldb, int K, const S_& S, const Epi& E) {
    const int tid = tid_op(), wid = __builtin_amdgcn_readfirstlane(tid >> 6), lane = tid & 63, wr = wid >> 2, wc = wid & 3, fr = lane & 15, fq = lane >> 4;
    int Kop = K; asm volatile("" : "+s"(Kop));
    const int nt = Kop / BK;
    unsigned voffA[2], voffB[2];
#pragma unroll
    for (int i = 0; i < 2; ++i) { int R, C; stage_rc(tid * 16 + i * 8192, R, C); const int Rb = Epi::PERM ? ((R & ~31) + perm32(R & 31)) : R;
        voffA[i] = (unsigned)(R * lda + C) * 2u; voffB[i] = (unsigned)(Rb * ldb + C) * 2u; }
    const size_t kstep = (size_t)(BK * 2);
    const size_t hstepA = (size_t)HALF * lda * 2, hstepB = (size_t)HALF * ldb * 2;
    const unsigned ldsw = (unsigned)wid * 1024u;
    const int aoff = lds_byte(wr * 64 + fr, fq * 8), boff = lds_byte(wc * 32 + fr, fq * 8);
#define FG_SA(b, h) (((b) * 2 + (h)) * HTB)
#define FG_SB(b, h) ((4 + (b) * 2 + (h)) * HTB)
#define FG_STAGE(bufoff, gbase, voff) do { _Pragma("unroll") for (int _i = 0; _i < 2; ++_i) \
        __builtin_amdgcn_global_load_lds((const GAS unsigned*)((const GAS char*)(gbase) + (voff)[_i]), (LAS unsigned*)(lds + (bufoff) + ldsw + _i * 8192), 16, 0, 0); } while (0)
#define FG_LDA(dst, b, h) do { _Pragma("unroll") for (int m = 0; m < 4; ++m) _Pragma("unroll") for (int k = 0; k < 2; ++k) dst[m][k] = *(const LAS bf16x8*)(lds + FG_SA(b, h) + aoff + m * 2048 + k * 1024); } while (0)
#define FG_LDB(dst, b, h) do { _Pragma("unroll") for (int n = 0; n < 2; ++n) _Pragma("unroll") for (int k = 0; k < 2; ++k) dst[n][k] = *(const LAS bf16x8*)(lds + FG_SB(b, h) + boff + n * 2048 + k * 1024); } while (0)
#define FG_MMA(ai, bj, At, Bt) do { __builtin_amdgcn_s_setprio(1); _Pragma("unroll") for (int m = 0; m < 4; ++m) _Pragma("unroll") for (int n = 0; n < 2; ++n) _Pragma("unroll") for (int k = 0; k < 2; ++k) \
        acc[ai][bj][m][n] = __builtin_amdgcn_mfma_f32_16x16x32_bf16(Bt[n][k], At[m][k], acc[ai][bj][m][n], 0, 0, 0); __builtin_amdgcn_s_setprio(0); } while (0)
#define FG_WAIT_V(n) asm volatile("s_waitcnt vmcnt(" #n ")" ::: "memory")
#define FG_WAIT_L(n) asm volatile("s_waitcnt lgkmcnt(" #n ")" ::: "memory")
#define FG_BAR __builtin_amdgcn_s_barrier()
#define FG_SCHED __builtin_amdgcn_sched_barrier(0)
    Unit cur, nxt; int ui = 0;
    if (!S.next(0, cur)) return;
    f32x4 acc[2][2][4][2];
#pragma unroll
    for (int a = 0; a < 2; ++a)
#pragma unroll
        for (int b = 0; b < 2; ++b)
#pragma unroll
            for (int m = 0; m < 4; ++m)
#pragma unroll
                for (int n = 0; n < 2; ++n) acc[a][b][m][n] = (f32x4){0.f, 0.f, 0.f, 0.f};
    bf16x8 At[4][2], B0[2][2], B1[2][2];
    const GAS char* cA = cur.A; const GAS char* cB = cur.B;
    FG_STAGE(FG_SB(0, 0), cB, voffB); FG_STAGE(FG_SB(0, 1), cB + hstepB, voffB); FG_STAGE(FG_SA(0, 0), cA, voffA); FG_STAGE(FG_SA(0, 1), cA + hstepA, voffA);
    if (wr == 1) FG_BAR;
    FG_WAIT_V(2); FG_BAR;
    FG_STAGE(FG_SB(1, 0), cB + kstep, voffB); FG_STAGE(FG_SA(1, 0), cA + kstep, voffA); FG_STAGE(FG_SB(1, 1), cB + hstepB + kstep, voffB);
    FG_WAIT_V(6); FG_BAR;
    for (;;) {
        const bool has_next = S.next(ui + 1, nxt);
        const GAS char* nA = has_next ? nxt.A : cA; const GAS char* nB = has_next ? nxt.B : cB;
        for (int t = 0; t < nt; t += 2) {
            const bool last = (t == nt - 2);
            const GAS char* a1 = cA + (size_t)(t + 1) * kstep;
            const GAS char* a2 = last ? nA : cA + (size_t)(t + 2) * kstep; const GAS char* b2 = last ? nB : cB + (size_t)(t + 2) * kstep;
            const GAS char* a3 = a2 + kstep; const GAS char* b3 = b2 + kstep;
            FG_LDB(B0, 0, 0); FG_LDB(B1, 0, 1); FG_SCHED; FG_LDA(At, 0, 0); FG_STAGE(FG_SA(1, 1), a1 + hstepA, voffA);
            FG_WAIT_V(8); FG_WAIT_L(0); FG_BAR; FG_MMA(0, 0, At, B0); FG_MMA(0, 1, At, B1); FG_BAR; FG_SCHED;
            FG_LDA(At, 0, 1); FG_STAGE(FG_SB(0, 0), b2, voffB); FG_STAGE(FG_SB(0, 1), b2 + hstepB, voffB); FG_STAGE(FG_SA(0, 0), a2, voffA);
            FG_WAIT_V(8); FG_WAIT_L(0); FG_BAR; FG_MMA(1, 0, At, B0); FG_MMA(1, 1, At, B1); FG_BAR; FG_SCHED;
            FG_LDB(B0, 1, 0); FG_LDB(B1, 1, 1); FG_SCHED; FG_LDA(At, 1, 0); FG_STAGE(FG_SA(0, 1), a2 + hstepA, voffA);
            FG_WAIT_V(8); FG_WAIT_L(0); FG_BAR; FG_MMA(0, 0, At, B0); FG_MMA(0, 1, At, B1); FG_BAR; FG_SCHED;
            FG_LDA(At, 1, 1); FG_STAGE(FG_SB(1, 0), b3, voffB); FG_STAGE(FG_SB(1, 1), b3 + hstepB, voffB); FG_STAGE(FG_SA(1, 0), a3, voffA);
            FG_WAIT_V(8); FG_WAIT_L(0); FG_BAR; FG_MMA(1, 0, At, B0); FG_MMA(1, 1, At, B1); FG_BAR; FG_SCHED;
        }
        if (wr == 0) FG_BAR;
        bool keep_acc = false;
        {
            const auto Ez = E.z(cur.z);
            if constexpr (Epi::CHAIN) keep_acc = (cur.z < 3);
#pragma unroll
            for (int ai = 0; ai < 2; ++ai)
#pragma unroll
                for (int m = 0; m < 4; ++m)
#pragma unroll
                    for (int bj = 0; bj < 2; ++bj) {
                        const int row_ = cur.pm * BM + ai * HALF + wr * 64 + m * 16 + fr, col_ = cur.pn * BM + bj * HALF + wc * 32 + (Epi::PERM ? 8 : 4) * fq;
                        if constexpr (Epi::CHAIN) Ez.chain(row_, col_, acc[ai][bj][m][0], acc[ai][bj][m][1], cur.z);
                        else Ez(row_, col_, acc[ai][bj][m][0], acc[ai][bj][m][1]);
                        if (bj == 1 && (m & 1)) asm volatile("" ::: "memory");
                    }
        }
        if (!has_next) break;
        if (!keep_acc) {
#pragma unroll
        for (int a = 0; a < 2; ++a)
#pragma unroll
            for (int b = 0; b < 2; ++b)
#pragma unroll
                for (int m = 0; m < 4; ++m)
#pragma unroll
                    for (int n = 0; n < 2; ++n) acc[a][b][m][n] = (f32x4){0.f, 0.f, 0.f, 0.f};
        }
        cur = nxt; cA = nA; cB = nB; ++ui;
        if (wr == 1) FG_BAR;
    }
    FG_WAIT_V(0);
    FG_BAR;
#undef FG_SA
#undef FG_SB
#undef FG_STAGE
#undef FG_LDA
#undef FG_LDB
#undef FG_MMA
#undef FG_WAIT_V
#undef FG_WAIT_L
#undef FG_BAR
#undef FG_SCHED
}

struct UnitM { const GAS char* A; const GAS char* B; int lda, ldb, nt, pm, pn, z, job; };
template <class EpiM, class SM>
__device__ __forceinline__ void gemm_multi(LAS unsigned char* lds, const SM& S, const EpiM& E) {
    const int tid = tid_op(), wid = __builtin_amdgcn_readfirstlane(tid >> 6), lane = tid & 63, wr = wid >> 2, wc = wid & 3, fr = lane & 15, fq = lane >> 4;
    int sR[2], sRb[2], sC[2];
#pragma unroll
    for (int i = 0; i < 2; ++i) { stage_rc(tid * 16 + i * 8192, sR[i], sC[i]); sRb[i] = (sR[i] & ~31) + perm32(sR[i] & 31); }
    const size_t kstep = (size_t)(BK * 2);
    const unsigned ldsw = (unsigned)wid * 1024u;
    const int aoff = lds_byte(wr * 64 + fr, fq * 8), boff = lds_byte(wc * 32 + fr, fq * 8);
#define FG_SA(b, h) (((b) * 2 + (h)) * HTB)
#define FG_SB(b, h) ((4 + (b) * 2 + (h)) * HTB)
#define FG_STAGE(bufoff, gbase, voff) do { _Pragma("unroll") for (int _i = 0; _i < 2; ++_i) \
        __builtin_amdgcn_global_load_lds((const GAS unsigned*)((const GAS char*)(gbase) + (voff)[_i]), (LAS unsigned*)(lds + (bufoff) + ldsw + _i * 8192), 16, 0, 0); } while (0)
#define FG_LDA(dst, b, h) do { _Pragma("unroll") for (int m = 0; m < 4; ++m) _Pragma("unroll") for (int k = 0; k < 2; ++k) dst[m][k] = *(const LAS bf16x8*)(lds + FG_SA(b, h) + aoff + m * 2048 + k * 1024); } while (0)
#define FG_LDB(dst, b, h) do { _Pragma("unroll") for (int n = 0; n < 2; ++n) _Pragma("unroll") for (int k = 0; k < 2; ++k) dst[n][k] = *(const LAS bf16x8*)(lds + FG_SB(b, h) + boff + n * 2048 + k * 1024); } while (0)
#define FG_MMA(ai, bj, At, Bt) do { __builtin_amdgcn_s_setprio(1); _Pragma("unroll") for (int m = 0; m < 4; ++m) _Pragma("unroll") for (int n = 0; n < 2; ++n) _Pragma("unroll") for (int k = 0; k < 2; ++k) \
        acc[ai][bj][m][n] = __builtin_amdgcn_mfma_f32_16x16x32_bf16(Bt[n][k], At[m][k], acc[ai][bj][m][n], 0, 0, 0); __builtin_amdgcn_s_setprio(0); } while (0)
#define FG_WAIT_V(n) asm volatile("s_waitcnt vmcnt(" #n ")" ::: "memory")
#define FG_WAIT_L(n) asm volatile("s_waitcnt lgkmcnt(" #n ")" ::: "memory")
#define FG_BAR __builtin_amdgcn_s_barrier()
#define FG_SCHED __builtin_amdgcn_sched_barrier(0)
#define FG_OFFS(u, vA, vB, hA, hB) do { _Pragma("unroll") for (int _i = 0; _i < 2; ++_i) { vA[_i] = (unsigned)(sR[_i] * (u).lda + sC[_i]) * 2u; vB[_i] = (unsigned)(sRb[_i] * (u).ldb + sC[_i]) * 2u; } \
        hA = (size_t)HALF * (u).lda * 2; hB = (size_t)HALF * (u).ldb * 2; } while (0)
    UnitM cur, nxt; int ui = 0;
    if (!S.next(0, cur)) return;
    unsigned vAc[2], vBc[2], vAn[2], vBn[2]; size_t hAc, hBc, hAn, hBn;
    FG_OFFS(cur, vAc, vBc, hAc, hBc);
    f32x4 acc[2][2][4][2];
#pragma unroll
    for (int a = 0; a < 2; ++a)
#pragma unroll
        for (int b = 0; b < 2; ++b)
#pragma unroll
            for (int m = 0; m < 4; ++m)
#pragma unroll
                for (int n = 0; n < 2; ++n) acc[a][b][m][n] = (f32x4){0.f, 0.f, 0.f, 0.f};
    bf16x8 At[4][2], B0[2][2], B1[2][2];
    const GAS char* cA = cur.A; const GAS char* cB = cur.B;
    FG_STAGE(FG_SB(0, 0), cB, vBc); FG_STAGE(FG_SB(0, 1), cB + hBc, vBc); FG_STAGE(FG_SA(0, 0), cA, vAc); FG_STAGE(FG_SA(0, 1), cA + hAc, vAc);
    if (wr == 1) FG_BAR;
    FG_WAIT_V(2); FG_BAR;
    FG_STAGE(FG_SB(1, 0), cB + kstep, vBc); FG_STAGE(FG_SA(1, 0), cA + kstep, vAc); FG_STAGE(FG_SB(1, 1), cB + hBc + kstep, vBc);
    FG_WAIT_V(6); FG_BAR;
    for (;;) {
        const bool has_next = S.next(ui + 1, nxt);
        if (!has_next) nxt = cur;
        FG_OFFS(nxt, vAn, vBn, hAn, hBn);
        const GAS char* nA = nxt.A; const GAS char* nB = nxt.B;
        const int nt = cur.nt;
        for (int t = 0; t < nt; t += 2) {
            const bool last = (t == nt - 2);
            const GAS char* a1 = cA + (size_t)(t + 1) * kstep;
            const GAS char* a2 = last ? nA : cA + (size_t)(t + 2) * kstep; const GAS char* b2 = last ? nB : cB + (size_t)(t + 2) * kstep;
            const GAS char* a3 = a2 + kstep; const GAS char* b3 = b2 + kstep;
            unsigned vA2[2], vB2[2];
#pragma unroll
            for (int _i = 0; _i < 2; ++_i) { vA2[_i] = last ? vAn[_i] : vAc[_i]; vB2[_i] = last ? vBn[_i] : vBc[_i]; }
            const size_t hA2 = last ? hAn : hAc, hB2 = last ? hBn : hBc;
            FG_LDB(B0, 0, 0); FG_LDB(B1, 0, 1); FG_SCHED; FG_LDA(At, 0, 0); FG_STAGE(FG_SA(1, 1), a1 + hAc, vAc);
            FG_WAIT_V(8); FG_WAIT_L(0); FG_BAR; FG_MMA(0, 0, At, B0); FG_MMA(0, 1, At, B1); FG_BAR; FG_SCHED;
            FG_LDA(At, 0, 1); FG_STAGE(FG_SB(0, 0), b2, vB2); FG_STAGE(FG_SB(0, 1), b2 + hB2, vB2); FG_STAGE(FG_SA(0, 0), a2, vA2);
            FG_WAIT_V(8); FG_WAIT_L(0); FG_BAR; FG_MMA(1, 0, At, B0); FG_MMA(1, 1, At, B1); FG_BAR; FG_SCHED;
            FG_LDB(B0, 1, 0); FG_LDB(B1, 1, 1); FG_SCHED; FG_LDA(At, 1, 0); FG_STAGE(FG_SA(0, 1), a2 + hA2, vA2);
            FG_WAIT_V(8); FG_WAIT_L(0); FG_BAR; FG_MMA(0, 0, At, B0); FG_MMA(0, 1, At, B1); FG_BAR; FG_SCHED;
            FG_LDA(At, 1, 1); FG_STAGE(FG_SB(1, 0), b3, vB2); FG_STAGE(FG_SB(1, 1), b3 + hB2, vB2); FG_STAGE(FG_SA(1, 0), a3, vA2);
            FG_WAIT_V(8); FG_WAIT_L(0); FG_BAR; FG_MMA(1, 0, At, B0); FG_MMA(1, 1, At, B1); FG_BAR; FG_SCHED;
        }
        if (wr == 0) FG_BAR;
#pragma unroll
        for (int ai = 0; ai < 2; ++ai)
#pragma unroll
            for (int m = 0; m < 4; ++m)
#pragma unroll
                for (int bj = 0; bj < 2; ++bj) {
                    E.apply(cur, cur.pm * BM + ai * HALF + wr * 64 + m * 16 + fr, cur.pn * BM + bj * HALF + wc * 32 + 8 * fq, acc[ai][bj][m][0], acc[ai][bj][m][1]);
                    if (bj == 1 && (m & 1)) asm volatile("" ::: "memory");
                }
        if (!has_next) break;
#pragma unroll
        for (int a = 0; a < 2; ++a)
#pragma unroll
            for (int b = 0; b < 2; ++b)
#pragma unroll
                for (int m = 0; m < 4; ++m)
#pragma unroll
                    for (int n = 0; n < 2; ++n) acc[a][b][m][n] = (f32x4){0.f, 0.f, 0.f, 0.f};
        cur = nxt; cA = nA; cB = nB; ++ui;
#pragma unroll
        for (int _i = 0; _i < 2; ++_i) { vAc[_i] = vAn[_i]; vBc[_i] = vBn[_i]; }
        hAc = hAn; hBc = hBn;
        if (wr == 1) FG_BAR;
    }
    FG_WAIT_V(0);
    FG_BAR;
#undef FG_SA
#undef FG_SB
#undef FG_STAGE
#undef FG_LDA
#undef FG_LDB
#undef FG_MMA
#undef FG_WAIT_V
#undef FG_WAIT_L
#undef FG_BAR
#undef FG_SCHED
#undef FG_OFFS
}
struct SchedBranch { const gbf* AB; const gbf* WpT; int nM, nN, G, c, pm0;
    __device__ __forceinline__ bool next(int i, Unit& u) const {
        const int nwg = nM * nN; const long L = (long)(i >> 2) * G + c; if (L >= nwg) return false;
        int wgid = (int)L; { const int q = nwg / NXCD, r = nwg % NXCD, xcd = wgid % NXCD, off = wgid / NXCD; wgid = (xcd < r ? xcd * (q + 1) : r * (q + 1) + (xcd - r) * q) + off; }
        const int nig = WGM * nN, gidx = wgid / nig, fm = gidx * WGM, gsz = (nM - fm) < WGM ? (nM - fm) : WGM;
        u.pm = fm + ((wgid % nig) % gsz); u.pn = (wgid % nig) / gsz; u.z = i & 3;
        u.A = (const GAS char*)(AB + (size_t)(pm0 + u.pm) * BM * ABW + u.z * 1024); u.B = (const GAS char*)(WpT + ((size_t)u.z * 2048 + (size_t)u.pn * BM) * KP1); return true;
    }
};
struct SchedIn0 { const gbf* U; const gbf* WinT; int G, c, i0, i1;
    __device__ __forceinline__ bool next(int i, Unit& u) const {
        const int ii = i + i0; if (ii >= i1) return false;
        const int L = ii * G + c; if (L >= 36 * 80) return false;
        const int xcd = L & 7, off = L >> 3; int t, nNc, pn0;
        if (off < 216) { t = xcd * 216 + off; nNc = 48; pn0 = 0; } else { t = xcd * 144 + (off - 216); nNc = 32; pn0 = 48; }
        const int nig = WGM * nNc, gidx = t / nig, fm = gidx * WGM, gsz = (36 - fm) < WGM ? (36 - fm) : WGM;
        u.pm = fm + ((t % nig) % gsz); u.pn = pn0 + (t % nig) / gsz; u.z = 0;
        u.A = (const GAS char*)(U + (size_t)u.pm * BM * KP2); u.B = (const GAS char*)(WinT + (size_t)u.pn * BM * KP2); return true;
    }
};
struct MapPlain { const gbf* A; int lda; const gbf* Bt; int ldb;
    __device__ __forceinline__ const gbf* a(int, int pm) const { return A + (size_t)pm * BM * lda; }
    __device__ __forceinline__ const gbf* b(int, int pn) const { return Bt + (size_t)pn * BM * ldb; } };
}

template <class Epi>
__device__ __forceinline__ void gemm_fast_plain(unsigned char* lds, const GemmJob j, const Epi& E, int gid, int G) {
    __syncthreads();
    fg::Sched<fg::MapPlain> S{fg::MapPlain{j.A, j.lda, j.Bt, j.ldb}, j.M / 256, j.N / 256, 1, G, gid};
    fg::gemm((LAS unsigned char*)lds, j.lda, j.ldb, j.K, S, E);
    __syncthreads();
}

struct MapF1 { const gbf* DC; const gbf* Pfv; int zrows;
    __device__ __forceinline__ const gbf* a(int, int pm) const { return DC + (size_t)pm * 256 * 256; }
    __device__ __forceinline__ const gbf* b(int z, int pn) const { return Pfv + ((size_t)(z >> 2) * zrows + (size_t)pn * 256) * PP + (z & 3) * 256; } };
struct MapF2 { const gbf* DN; const gbf* GT; int ld;
    __device__ __forceinline__ const gbf* a(int, int pm) const { return DN + (size_t)pm * 256 * ld; }
    __device__ __forceinline__ const gbf* b(int z, int pn) const { return GT + ((size_t)z * 1024 + (size_t)pn * 256) * ld; } };
template <class Map, class Epi>
__device__ __forceinline__ void gemm_fast_z(unsigned char* lds, const Map& map, int lda, int ldb, int K, int nM, int nN, int nz, const Epi& E, int c, int Gs) {
    __syncthreads();
    if (c >= 0) { fg::Sched<Map> S{map, nM, nN, nz, Gs, c}; fg::gemm((LAS unsigned char*)lds, lda, ldb, K, S, E); }
    __syncthreads();
}

template <class Epi>
__device__ __forceinline__ void gemm_run(unsigned char* lds, const GemmJob j, const Epi& E, int first, int stride) {
    gemm_fast_plain(lds, j, E, first, stride);
}

struct EpiInProj {
    static constexpr bool PERM = true, CHAIN = false;
    gbf* P; int row0; gbf* NK; gbf* NV; gbf* NQ; gbf* MG;
    __device__ __forceinline__ EpiInProj z(int) const { return *this; }
    __device__ __forceinline__ void operator()(int row, int col, f32x4 a, f32x4 b) const {
        if (col >= C_MG) {
#pragma unroll
            for (int i = 0; i < 4; ++i) { a[i] = sigmoidf_(fminf(fmaxf(a[i], -30.f), 30.f)); b[i] = sigmoidf_(fminf(fmaxf(b[i], -30.f), 30.f)); }
        } else if (col >= C_GCV) {
#pragma unroll
            for (int i = 0; i < 4; ++i) { a[i] = siluf_(a[i]); b[i] = siluf_(b[i]); }
        } else if (col >= C_NAQ && col < C_CB) { a = a * NASCALE; b = b * NASCALE; }
        const int r = row0 + row;
        if (col >= C_MG) { const int cc = col - C_MG; __builtin_nontemporal_store(pk8(a, b), (GAS u32x4*)(MG + mg_off(cc >> 11, r, cc & 2047))); }
        else if (col >= C_NAK && col < C_CB && !(col >= C_QL && col < C_NAQ)) {
            const int sel = (col < C_NAV) ? 0 : (col < C_QL) ? 1 : 2, cc = (col < C_NAV) ? col - C_NAK : (col < C_QL) ? col - C_NAV : col - C_NAQ;
            __builtin_nontemporal_store(pk8(a, b), (GAS u32x4*)(NK + (size_t)sel * ((WS_NV - WS_NK) / 2) + hm_row(r, cc >> 6, 16) * 64 + (cc & 63)));
        } else __builtin_nontemporal_store(pk8(a, b), (GAS u32x4*)(P + (size_t)r * PP + col));
    }
};
struct EpiInProjC1 {
    static constexpr bool PERM = true, CHAIN = false;
    gbf* P; gbf* NK; gbf* KM; gf32* SSQ;
    __device__ __forceinline__ EpiInProjC1 z(int) const { return *this; }
    __device__ __forceinline__ void operator()(int row, int col, f32x4 a, f32x4 b) const {
        const int r = NLAT + row;
        if (col < 256) {
            *(GAS u32x4*)(P + (size_t)r * PP + col) = pk8(a, b);
            float s = a[0] * a[0] + a[1] * a[1] + a[2] * a[2] + a[3] * a[3] + b[0] * b[0] + b[1] * b[1] + b[2] * b[2] + b[3] * b[3];
            s += __shfl_xor(s, 16); s += __shfl_xor(s, 32);
            if ((col & 31) == 0) SSQ[(size_t)row * 8 + (col >> 5)] = s;
        } else if (col < 512) {
            if (col < 320) { const u32x4 v = pk8(a, b);
#pragma unroll
                for (int h = 0; h < 8; ++h) *(GAS u32x4*)(KM + hm_row(r, h, 8) * 192 + 128 + (col - 256)) = v; }
        } else {
            const int sel = (col < C_NAV) ? 0 : 1, cc = (col < C_NAV) ? col - C_NAK : col - C_NAV;
            *(GAS u32x4*)(NK + (size_t)sel * ((WS_NV - WS_NK) / 2) + hm_row(r, cc >> 6, 16) * 64 + (cc & 63)) = pk8(a, b);
        }
    }
};
struct EpiKvUp {
    static constexpr bool PERM = true, CHAIN = false;
    gbf* KM; gbf* VM; const gf32* rstd; int row0;
    __device__ __forceinline__ EpiKvUp z(int) const { return *this; }
    __device__ __forceinline__ void operator()(int row, int col, f32x4 a, f32x4 b) const {
        const int r = row0 + row, h = col >> 8, jj = col & 255; const float s = rstd[r];
        const size_t hr = hm_row(r, h, 8); gbf* p = (jj < 128) ? KM + hr * 192 + jj : VM + hr * 128 + (jj - 128);
        *(GAS u32x4*)p = pk8(a * s, b * s);
    }
};
struct EpiQUp {
    static constexpr bool PERM = false, CHAIN = false;
    gbf* QM; const gf32* rstd; const gf32* rope; int row0;
    __device__ __forceinline__ EpiQUp z(int) const { return *this; }
    __device__ __forceinline__ void operator()(int row, int col, f32x4 a, f32x4 b) const {
        const int r = row0 + row, h = col / 192, jj = col - h * 192; const float s = rstd[r] * QSCALE;
        a = a * s; b = b * s;
        if (jj >= 128 && r < NLAT) {
            const int t = r & (SEQ - 1), e = jj - 128, pos = (e < 32) ? (t >> 6) : (t & 63), f0 = e & 15;
            const gf32* rp = rope + (pos * 16 + f0) * 2;
#pragma unroll
            for (int i = 0; i < 4; ++i) { const float c = rp[2 * i], sn = rp[2 * i + 1]; const float x = a[i], y = b[i]; a[i] = x * c - y * sn; b[i] = x * sn + y * c; }
        }
        gbf* p = QM + hm_row(r, h, 8) * 192 + jj;
        *(GAS u32x2*)p = pk4(a); *(GAS u32x2*)(p + 16) = pk4(b);
    }
};
struct EpiF1 {
    static constexpr bool PERM = true, CHAIN = false;
    gbf* GT; int S; int g;
    __device__ __forceinline__ EpiF1 z(int zz) const { return EpiF1{GT + (size_t)(zz >> 2) * 1024 * 2 * S, S, zz & 3}; }
    __device__ __forceinline__ void operator()(int row, int col, f32x4 a, f32x4 b) const {
        *(GAS u32x4*)(GT + (size_t)(g * 256 + (row & 255)) * (2 * S) + (row >> 8) * S + col) = pk8(a, b);
    }
};
struct EpiF2 {
    static constexpr bool PERM = true, CHAIN = false;
    gbf* AB; const gbf* P; int row0; int zrows;
    __device__ __forceinline__ EpiF2 z(int zz) const { return EpiF2{AB, P, row0 + zz * zrows, zrows}; }
    __device__ __forceinline__ void operator()(int row, int col, f32x4 a, f32x4 b) const {
        const size_t r = (size_t)(row0 + row);
        f32x4 ga, gb; unpk8(*(const GAS u32x4*)(P + r * PP + C_GFN + col), ga, gb);
        *(GAS u32x4*)(AB + r * ABW + 3072 + col) = pk8(a * ga, b * gb);
    }
};
struct EpiBranch {
    static constexpr bool PERM = true, CHAIN = false;
    gf32* MF; gbf* MB; const gbf* P; int i; int row0;
    __device__ __forceinline__ EpiBranch z(int) const { return *this; }
    __device__ __forceinline__ void operator()(int row, int col, f32x4 a, f32x4 b) const {
        const size_t r = (size_t)(row0 + row);
        f32x4 ga, gb; unpk8(*(const GAS u32x4*)(P + r * PP + C_MG + i * DM + col), ga, gb);
        gf32* m = MF + r * DM + col;
        f32x4 va = a * ga, vb = b * gb;
        if (i > 0) { va += *(const GAS f32x4*)m; vb += *(const GAS f32x4*)(m + 4); }
        if (i < 3) { *(GAS f32x4*)m = va; *(GAS f32x4*)(m + 4) = vb; }
        else *(GAS u32x4*)(MB + r * DM + col) = pk8(va, vb);
    }
};
struct EpiChain {
    static constexpr bool PERM = true, CHAIN = true;
    gbf* MB; const gbf* P; int row0;
    __device__ __forceinline__ EpiChain z(int) const { return *this; }
    __device__ __forceinline__ void chain(int row, int col, f32x4& a, f32x4& b, int zz) const {
        const size_t r = (size_t)(row0 + row);
        if (zz < 3) {
            f32x4 ga, gb, ha, hb; unpk8(__builtin_nontemporal_load((const GAS u32x4*)(P + mg_off(zz, (int)r, col))), ga, gb); unpk8(__builtin_nontemporal_load((const GAS u32x4*)(P + mg_off(zz + 1, (int)r, col))), ha, hb);
#pragma unroll
            for (int i = 0; i < 4; ++i) { a[i] *= ga[i] * __builtin_amdgcn_rcpf(ha[i]); b[i] *= gb[i] * __builtin_amdgcn_rcpf(hb[i]); }
        } else {
            f32x4 ga, gb; unpk8(__builtin_nontemporal_load((const GAS u32x4*)(P + mg_off(3, (int)r, col))), ga, gb);
            *(GAS u32x4*)(MB + r * KP2 + col) = pk8(a * ga, b * gb);
        }
    }
};
struct EpiOut {
    static constexpr bool PERM = true, CHAIN = false;
    gf32* Y; int row0;
    __device__ __forceinline__ EpiOut z(int) const { return *this; }
    __device__ __forceinline__ void operator()(int row, int col, f32x4 a, f32x4 b) const {
        gf32* p = Y + (size_t)(row0 + row) * DM + col; *(GAS f32x4*)p = a; *(GAS f32x4*)(p + 4) = b;
    }
};

struct EpiC2 {
    gbf* KM; gbf* VM; gbf* QM; gbf* GT; gbf* GTC; const gf32* RKV; const gf32* RQ; const gf32* rope; const gf32* SSQ;
    __device__ __forceinline__ void apply(const fg::UnitM& u, int row, int col, f32x4 a, f32x4 b) const {
        if (u.job == 0) {
            const int h = col >> 8, jj = col & 255; float s;
            if (SSQ != nullptr && row >= NLAT) { const f32x4 s0 = *(const GAS f32x4*)(SSQ + (size_t)(row - NLAT) * 8), s1 = *(const GAS f32x4*)(SSQ + (size_t)(row - NLAT) * 8 + 4);
                s = rsqrtf(((s0[0] + s0[1]) + (s0[2] + s0[3]) + (s1[0] + s1[1]) + (s1[2] + s1[3])) * (1.0f / 256.0f) + EPS); }
            else s = RKV[row];
            const size_t hr = hm_row(row, h, 8); gbf* p = (jj < 128) ? KM + hr * 192 + jj : VM + hr * 128 + (jj - 128);
            *(GAS u32x4*)p = pk8(a * s, b * s);
        } else if (u.job == 1) {
            const int h = col / 192, jj = col - h * 192; const float s = RQ[row] * QSCALE;
            a = a * s; b = b * s;
            if (jj >= 128 && row < NLAT) {
                const int t = row & (SEQ - 1), e = jj - 128, pos = (e < 32) ? (t >> 6) : (t & 63), f0 = e & 15; const bool second = (e & 16) != 0;
                const gf32* rp = rope + (pos * 16 + f0) * 2;
                const f32x4 cs0 = *(const GAS f32x4*)rp, cs1 = *(const GAS f32x4*)(rp + 4), cs2 = *(const GAS f32x4*)(rp + 8), cs3 = *(const GAS f32x4*)(rp + 12);
                const float cc[8] = {cs0[0], cs0[2], cs1[0], cs1[2], cs2[0], cs2[2], cs3[0], cs3[2]}, ss[8] = {cs0[1], cs0[3], cs1[1], cs1[3], cs2[1], cs2[3], cs3[1], cs3[3]};
#pragma unroll
                for (int i = 0; i < 4; ++i) { const float ya = __shfl_xor(a[i], 32), yb = __shfl_xor(b[i], 32);
                    a[i] = second ? (ya * ss[i] + a[i] * cc[i]) : (a[i] * cc[i] - ya * ss[i]);
                    b[i] = second ? (yb * ss[4 + i] + b[i] * cc[4 + i]) : (b[i] * cc[4 + i] - yb * ss[4 + i]); }
            }
            *(GAS u32x4*)(QM + hm_row(row, h, 8) * 192 + jj) = pk8(a, b);
        } else {
            const int S_ = (u.job == 2) ? SEQ : CTXL, ld_ = (u.job == 2) ? KP4 : 2 * CTXL; gbf* G_ = (u.job == 2) ? GT : GTC; const int bb = u.z >> 2, g = u.z & 3;
            *(GAS u32x4*)(G_ + (size_t)bb * 1024 * ld_ + (size_t)(g * 256 + (row & 255)) * ld_ + (row >> 8) * S_ + col) = pk8(a, b);
        }
    }
};
struct SchedC2 {
    const gbf* P; const gbf* WukvT; const gbf* WuqT; const gbf* DC; int nq_tiles, n3, G, c;
    __device__ __forceinline__ bool next(int i, fg::UnitM& u) const {
        int L = i * G + c; const int n0 = (NROW / 256) * 8, n1 = nq_tiles * 6, n2 = 16 * 2 * 8;
        if (L < n0) { u.job = 0; u.pm = L >> 3; u.pn = L & 7; u.z = 0; u.lda = PP; u.ldb = 256; u.nt = 4;
            u.A = (const GAS char*)(P + (size_t)u.pm * 256 * PP + C_CKV); u.B = (const GAS char*)(WukvT + (size_t)u.pn * 256 * 256); return true; }
        L -= n0;
        if (L < n1) { u.job = 1; u.pm = L / 6; u.pn = L % 6; u.z = 0; u.lda = PP; u.ldb = 512; u.nt = 8;
            u.A = (const GAS char*)(P + (size_t)u.pm * 256 * PP + C_QL); u.B = (const GAS char*)(WuqT + (size_t)u.pn * 256 * 512); return true; }
        L -= n1;
        if (L < n2) { u.job = 2; u.z = L >> 4; u.pm = (L >> 3) & 1; u.pn = L & 7; u.lda = 256; u.ldb = PP; u.nt = 4;
            u.A = (const GAS char*)(DC + (size_t)u.pm * 256 * 256); u.B = (const GAS char*)(P + ((size_t)(u.z >> 2) * SEQ + (size_t)u.pn * 256) * PP + C_FV + (u.z & 3) * 256); return true; }
        L -= n2;
        if (L < n3) { u.job = 3; u.z = L >> 1; u.pm = L & 1; u.pn = 0; u.lda = 256; u.ldb = PP; u.nt = 4;
            u.A = (const GAS char*)(DC + (size_t)u.pm * 256 * 256); u.B = (const GAS char*)(P + ((size_t)NLAT + (size_t)(u.z >> 2) * CTXL) * PP + C_FV + (u.z & 3) * 256); return true; }
        return false;
    }
};

__device__ __forceinline__ void transpose_item(const gf32* W, int K, int N, gbf* WT, int ldt, const gf32* kscale, bool win_remap, int item, int lane, float* scr) {
    const int nblk = N / 32, kb = item / nblk, nb = item % nblk, k0 = 64 * kb, n0 = 32 * nb;
#pragma unroll 8
    for (int i = 0; i < 32; ++i) { const int kk = 2 * i + (lane >> 5); float v = __builtin_nontemporal_load(W + (size_t)(k0 + kk) * N + n0 + (lane & 31)); if (kscale) v *= kscale[k0 + kk]; scr[kk * 33 + (lane & 31)] = v; }
    __builtin_amdgcn_fence(__ATOMIC_RELEASE, "wavefront"); asm volatile("s_waitcnt lgkmcnt(0)" ::: "memory");
    const int c = lane & 7, nd0 = (win_remap && n0 >= 320) ? n0 + 192 : n0;
#pragma unroll
    for (int j = 0; j < 4; ++j) { const int n = (lane >> 3) + 8 * j; const float* s = scr + (8 * c) * 33 + n;
        u32x4 o; o.x = pk2(s[0 * 33], s[1 * 33]); o.y = pk2(s[2 * 33], s[3 * 33]); o.z = pk2(s[4 * 33], s[5 * 33]); o.w = pk2(s[6 * 33], s[7 * 33]);
        __builtin_nontemporal_store(o, (GAS u32x4*)(WT + (size_t)(nd0 + n) * ldt + k0 + 8 * c)); }
    asm volatile("s_waitcnt lgkmcnt(0)" ::: "memory");
}

__device__ __forceinline__ void phase0(const Params& p, unsigned char* lds, int gid, int G) {
    const int tid = tid_op(), lane = tid & 63, wid = tid >> 6;
    gu8* ws = wsb();
    {
        float* sv = (float*)lds;
        float* part = sv + 5 * 2048;
        bool have = false;
        for (int it = gid; it < 2 * 96; it += G) {
            if (!have) {
                for (int i = tid; i < 5 * 2048; i += NTHREADS) { const float v = (i < 4 * 2048) ? pin(I_C)[i] : pin(I_CCTX)[i - 4 * 2048]; sv[i] = siluf_(v); }
                have = true;
            }
            __syncthreads();
            const int l = it / 96, nb = it % 96;
            const gf32* W = pin(I_WADA) + (size_t)l * DM * 6144 + nb * 64 + lane;
            float a0 = 0.f, a1 = 0.f, a2 = 0.f, a3 = 0.f, a4 = 0.f;
#pragma unroll 8
            for (int k = wid * 256; k < wid * 256 + 256; ++k) {
                const float w = W[(size_t)k * 6144];
                a0 = fmaf(sv[k], w, a0); a1 = fmaf(sv[2048 + k], w, a1); a2 = fmaf(sv[4096 + k], w, a2); a3 = fmaf(sv[6144 + k], w, a3); a4 = fmaf(sv[8192 + k], w, a4);
            }
            part[(wid * 5 + 0) * 64 + lane] = a0; part[(wid * 5 + 1) * 64 + lane] = a1; part[(wid * 5 + 2) * 64 + lane] = a2; part[(wid * 5 + 3) * 64 + lane] = a3; part[(wid * 5 + 4) * 64 + lane] = a4;
            __syncthreads();
            if (tid < 320) {
                const int r = tid / 64, cidx = tid % 64; float s = 0.f;
#pragma unroll
                for (int w = 0; w < 8; ++w) s += part[(w * 5 + r) * 64 + cidx];
                const int n = nb * 64 + cidx;
                ((gf32*)(ws + WS_MOD))[((size_t)l * 5 + r) * 6144 + n] = s + pin(I_BADA)[(size_t)l * 6144 + n];
            }
        }
        __syncthreads();
    }
    {
        const long gt = (long)gid * NTHREADS + tid, NT = (long)G * NTHREADS;
        gf32* rope = (gf32*)(ws + WS_ROPE);
        for (long i = gt; i < 64 * 16; i += NT) { const int pos = (int)(i >> 4), f = (int)(i & 15); const float inv = exp2f(-(float)f * (13.287712379549449f / 16.0f)); const float ang = (float)pos * inv;
            rope[2 * i] = cosf(ang); rope[2 * i + 1] = sinf(ang); }
        gbf* DC = (gbf*)(ws + WS_DC);
        for (long i = gt; i < 512 * 256; i += NT) { const int m = (int)(i >> 8), k = (int)(i & 255); const int jdx = ((m & 255) * k) & 255; const float ang = (float)jdx * (6.283185307179586f / 256.0f);
            DC[i] = (bf16_t)f2bf((m < 256 ? cosf(ang) : sinf(ang)) * 0.0625f); }
        gbf* DN = (gbf*)(ws + WS_DN);
        for (long i = gt; i < (long)2048 * 4096; i += NT) { const int n = (int)(i >> 12), k = (int)(i & 4095); const int jdx = (n * (k & 2047)) & 2047; const float ang = (float)jdx * (6.283185307179586f / 2048.0f);
            DN[(size_t)n * KP4 + k] = (bf16_t)f2bf((k < 2048 ? cosf(ang) : -sinf(ang)) * 0.02209708691207961f); }
        gbf* DNC = (gbf*)(ws + WS_DNC);
        for (long i = gt; i < 256 * 512; i += NT) { const int n = (int)(i >> 9), k = (int)(i & 511); const int jdx = (n * (k & 255)) & 255; const float ang = (float)jdx * (6.283185307179586f / 256.0f);
            DNC[i] = (bf16_t)f2bf((k < 256 ? cosf(ang) : -sinf(ang)) * 0.0625f); }
        for (long i = gt; i < (long)2 * 192 * DM / 8; i += NT) { const int l = (int)(i / (192 * DM / 8)); const long r = i % (192 * DM / 8);
            *(GAS u32x4*)((gbf*)(ws + WS_WIN) + (size_t)l * NP * KP2 + (size_t)(320 + r / (DM / 8)) * KP2 + (r % (DM / 8)) * 8) = (u32x4){0u, 0u, 0u, 0u}; }
    }
    {
        float* scr = (float*)lds + wid * (64 * 33);
        const int gw = gid * NWAVES + wid, NGW = G * NWAVES;
        constexpr int I_IN = 32 * 634, I_KV = 4 * 64, I_Q = 8 * 48, I_P = 16 * 64, I_O = 32 * 64;
        constexpr int PER_L = I_IN + I_KV + I_Q + 4 * I_P + I_O;
        for (int it = gw; it < 2 * PER_L; it += NGW) {
            const int l = it / PER_L; int r = it % PER_L;
            if (r < I_IN) { transpose_item(pin(I_WIN) + (size_t)l * DM * N_IN, DM, N_IN, (gbf*)(ws + WS_WIN) + (size_t)l * NP * KP2, KP2, nullptr, true, r, lane, scr); continue; } r -= I_IN;
            if (r < I_KV) { transpose_item(pin(I_WUKV) + (size_t)l * 256 * 2048, 256, 2048, (gbf*)(ws + WS_WUKV) + (size_t)l * 2048 * 256, 256, pin(I_GKV) + l * 256, false, r, lane, scr); continue; } r -= I_KV;
            if (r < I_Q) { transpose_item(pin(I_WUQ) + (size_t)l * 512 * 1536, 512, 1536, (gbf*)(ws + WS_WUQ) + (size_t)l * 1536 * 512, 512, pin(I_GQ) + l * 512, false, r, lane, scr); continue; } r -= I_Q;
            if (r < 4 * I_P) { const int b = r / I_P; const gf32* W = pin(I_WPC + b) + (size_t)l * 1024 * 2048;
                transpose_item(W, 1024, 2048, (gbf*)(ws + WS_WP) + ((size_t)l * 4 + b) * 2048 * KP1, KP1, nullptr, false, r % I_P, lane, scr); continue; } r -= 4 * I_P;
            transpose_item(pin(I_WOUT) + (size_t)l * 2048 * 2048, 2048, 2048, (gbf*)(ws + WS_WO) + (size_t)l * 2048 * KP2, KP2, nullptr, false, r, lane, scr);
        }
    }
}

__device__ __forceinline__ void u_row(const f32x4 (&v)[8], float rstd, const gf32* gpre, const gf32* mod  , gbf* urow, int lane) {
#pragma unroll
    for (int j = 0; j < 8; ++j) { const int c = 4 * lane + 256 * j;
        const f32x4 g = *(const GAS f32x4*)(gpre + c), sh = *(const GAS f32x4*)(mod + c), sc = *(const GAS f32x4*)(mod + 2048 + c);
        const f32x4 o = v[j] * rstd * g * (sc + 1.0f) + sh;
        *(GAS u32x2*)(urow + c) = pk4(o); }
}
__device__ __forceinline__ void phase_uprep0(const Params& p, int gid, int G) {
    const int tid = tid_op(), lane = tid & 63, gw = gid * NWAVES + (tid >> 6), NGW = G * NWAVES;
    const gf32* mod0 = (const gf32*)(wsb() + WS_MOD);
    gbf* U = (gbf*)(wsb() + WS_U);
    for (int r = gw; r < NROW; r += NGW) {
        const gf32* xr = (r < NLAT) ? pin(I_X) + (size_t)r * DM : pin(I_CTX) + (size_t)(r - NLAT) * DM;
        const int mr = (r < NLAT) ? (r >> 11) : 4;
        f32x4 v[8]; float s = 0.f;
#pragma unroll
        for (int j = 0; j < 8; ++j) { v[j] = *(const GAS f32x4*)(xr + 4 * lane + 256 * j); s += v[j][0] * v[j][0] + v[j][1] * v[j][1] + v[j][2] * v[j][2] + v[j][3] * v[j][3]; }
        const float rstd = rsqrtf(wave_sum(s) * (1.0f / DM) + EPS);
        u_row(v, rstd, pin(I_GPRE), mod0 + (size_t)mr * 6144, U + (size_t)r * KP2, lane);
    }
}
__device__ __forceinline__ void phase_final(const Params& p, int l, int rbeg, int rend, int cu, int ncu) {
    const int tid = tid_op(), lane = tid & 63, gw = rbeg + cu * NWAVES + (tid >> 6), NGW = ncu * NWAVES;
    const gf32* mod = (const gf32*)(wsb() + WS_MOD) + (size_t)l * 5 * 6144;
    const gf32* Y = (const gf32*)(wsb() + WS_Y);
    gf32* XL = (gf32*)(wsb() + WS_XL);
    gbf* U = (gbf*)(wsb() + WS_U);
    const int nrows = rend;
    auto xrow = [&](int r) -> const gf32* { return (l == 0) ? ((r < NLAT) ? pin(I_X) + (size_t)r * DM : pin(I_CTX) + (size_t)(r - NLAT) * DM) : XL + (size_t)r * DM; };
    f32x4 y[8], x[8], yn[8], xn[8];
    if (gw < nrows) { const gf32* yr = Y + (size_t)gw * DM; const gf32* xr = xrow(gw);
#pragma unroll
        for (int j = 0; j < 8; ++j) { y[j] = *(const GAS f32x4*)(yr + 4 * lane + 256 * j); x[j] = *(const GAS f32x4*)(xr + 4 * lane + 256 * j); } }
    for (int r = gw; r < nrows; r += NGW) {
        const int rn = r + NGW;
        if (rn < nrows) { const gf32* yr = Y + (size_t)rn * DM; const gf32* xr = xrow(rn);
#pragma unroll
            for (int j = 0; j < 8; ++j) { yn[j] = *(const GAS f32x4*)(yr + 4 * lane + 256 * j); xn[j] = *(const GAS f32x4*)(xr + 4 * lane + 256 * j); } }
        const int mr = (r < NLAT) ? (r >> 11) : 4;
        gf32* orow = (l == 0) ? XL + (size_t)r * DM : pout() + (size_t)r * DM;
        float s = 0.f;
#pragma unroll
        for (int j = 0; j < 8; ++j) s += y[j][0] * y[j][0] + y[j][1] * y[j][1] + y[j][2] * y[j][2] + y[j][3] * y[j][3];
        const float rstd = rsqrtf(wave_sum(s) * (1.0f / DM) + EPS);
        float s2 = 0.f;
#pragma unroll
        for (int j = 0; j < 8; ++j) { const int c = 4 * lane + 256 * j;
            const f32x4 g = *(const GAS f32x4*)(pin(I_GPOST) + (size_t)l * DM + c), gt = *(const GAS f32x4*)(mod + (size_t)mr * 6144 + 4096 + c);
            const f32x4 o = x[j] + gt * (y[j] * rstd * g);
            *(GAS f32x4*)(orow + c) = o; y[j] = o; s2 += o[0] * o[0] + o[1] * o[1] + o[2] * o[2] + o[3] * o[3]; }
        if (l == 0) {
            const float rstd2 = rsqrtf(wave_sum(s2) * (1.0f / DM) + EPS);
            u_row(y, rstd2, pin(I_GPRE) + DM, mod + 5 * 6144 + (size_t)mr * 6144, U + (size_t)r * KP2, lane);
        }
#pragma unroll
        for (int j = 0; j < 8; ++j) { y[j] = yn[j]; x[j] = xn[j]; }
    }
}
__device__ __forceinline__ void c1_loadz(const gbf* pr, bool ok, int lane, f32x4 (&z)[4]) {
#pragma unroll
    for (int j = 0; j < 4; ++j) { const int c = 4 * lane + 256 * j;
        if (ok) z[j] = unpk4(*(const GAS u32x2*)(pr + C_CC + c)) * unpk4(*(const GAS u32x2*)(pr + C_CX + c)); else z[j] = (f32x4){0.f, 0.f, 0.f, 0.f}; }
}
__device__ __forceinline__ void phase_c1(const Params& p, int l, int nrows, int gid, int G) {
    const int tid = tid_op(), lane = tid & 63, gw = gid * NWAVES + (tid >> 6), NGW = G * NWAVES;
    const gbf* P = (const gbf*)(wsb() + WS_P);
    gbf* KM = (gbf*)(wsb() + WS_KM); gbf* AB = (gbf*)(wsb() + WS_AB);
    gf32* RKV = (gf32*)(wsb() + WS_RKV); gf32* RQ = (gf32*)(wsb() + WS_RQ);
    const gf32* rope = (const gf32*)(wsb() + WS_ROPE);
    const gf32* cw = pin(I_CONVW) + (size_t)l * 3 * 1024;
    const int chunk = (nrows + NGW - 1) / NGW, rbeg = gw * chunk, rend = min(rbeg + chunk, nrows);
    if (rbeg >= rend) return;
    f32x4 w0[4], w1[4], w2[4];
#pragma unroll
    for (int j = 0; j < 4; ++j) { const int c = 4 * lane + 256 * j; w0[j] = *(const GAS f32x4*)(cw + c); w1[j] = *(const GAS f32x4*)(cw + 1024 + c); w2[j] = *(const GAS f32x4*)(cw + 2048 + c); }
    auto seqpos = [](int r, int& t, int& slen) { if (r < NLAT) { t = r & (SEQ - 1); slen = SEQ; } else { t = (r - NLAT) & (CTXL - 1); slen = CTXL; } };
    f32x4 zp[4], zc[4], zn[4];
    { int t, slen; seqpos(rbeg, t, slen); const bool full0 = (rbeg < NLAT) || (l == 0);
      c1_loadz(P + (size_t)(rbeg - 1) * PP, full0 && t > 0, lane, zp); c1_loadz(P + (size_t)rbeg * PP, full0, lane, zc); (void)slen; }
    for (int r = rbeg; r < rend; ++r) {
        const gbf* pr = P + (size_t)r * PP;
        const bool full = (r < NLAT) || (l == 0);
        int t, slen; seqpos(r, t, slen);
        c1_loadz(pr + PP, (r + 1 < NROW) && ((r + 1 < NLAT) || (l == 0)), lane, zn);
        const float mp = (t > 0) ? 1.f : 0.f, mn = (t < slen - 1) ? 1.f : 0.f;
        const u32x2 ckv = *(const GAS u32x2*)(pr + C_CKV + 4 * lane);
        u32x2 q0 = {0u, 0u}, q1 = {0u, 0u}, cb[4], gc[4];
        if (full) { q0 = *(const GAS u32x2*)(pr + C_QL + 4 * lane); q1 = *(const GAS u32x2*)(pr + C_QL + 256 + 4 * lane);
#pragma unroll
            for (int j = 0; j < 4; ++j) { const int c = 4 * lane + 256 * j; cb[j] = *(const GAS u32x2*)(pr + C_CB + c); gc[j] = *(const GAS u32x2*)(pr + C_GCV + c); } }
        float x = bf2f(pr[C_KR + lane]);
        float rc = 1.f, rsn = 0.f;
        if (r < NLAT) { const int tt = r & (SEQ - 1), pos = (lane < 32) ? (tt >> 6) : (tt & 63), f = lane & 15; rc = rope[(pos * 16 + f) * 2]; rsn = rope[(pos * 16 + f) * 2 + 1]; }
        { const f32x4 v = unpk4(ckv); const float s = wave_sum(v[0] * v[0] + v[1] * v[1] + v[2] * v[2] + v[3] * v[3]);
          if (lane == 0) RKV[r] = rsqrtf(s * (1.0f / 256.0f) + EPS); }
        if (full) { const f32x4 v0 = unpk4(q0), v1 = unpk4(q1);
          const float s = wave_sum(v0[0] * v0[0] + v0[1] * v0[1] + v0[2] * v0[2] + v0[3] * v0[3] + v1[0] * v1[0] + v1[1] * v1[1] + v1[2] * v1[2] + v1[3] * v1[3]);
          if (lane == 0) RQ[r] = rsqrtf(s * (1.0f / 512.0f) + EPS); }
        {
          const float y = __shfl_xor(x, 16);
          x = (lane & 16) ? (y * rsn + x * rc) : (x * rc - y * rsn);
          const bf16_t o = (bf16_t)f2bf(x);
#pragma unroll
          for (int h = 0; h < 8; ++h) KM[hm_row(r, h, 8) * 192 + 128 + lane] = o; }
        if (full) {
#pragma unroll
          for (int j = 0; j < 4; ++j) { const int c = 4 * lane + 256 * j;
              const f32x4 o = (zp[j] * (w0[j] * mp) + zc[j] * w1[j] + zn[j] * (w2[j] * mn)) * unpk4(cb[j]) * unpk4(gc[j]);
              *(GAS u32x2*)(AB + (size_t)r * ABW + c) = pk4(o); } }
#pragma unroll
        for (int j = 0; j < 4; ++j) { zp[j] = zc[j]; zc[j] = zn[j]; }
    }
}

namespace fa {
typedef float f32x16 __attribute__((ext_vector_type(16)));
typedef short s16x4 __attribute__((ext_vector_type(4)));
constexpr float THRL = 8.0f;
__device__ __forceinline__ int crow(int r, int hi) { return (r & 3) + 8 * (r >> 2) + 4 * hi; }
__device__ __forceinline__ unsigned cvtpk(float lo, float hi) { unsigned r; asm volatile("v_cvt_pk_bf16_f32 %0, %1, %2" : "=v"(r) : "v"(lo), "v"(hi)); return r; }
template <int OFF> __device__ __forceinline__ s16x4 tr_read(int vb) { s16x4 r; asm volatile("ds_read_b64_tr_b16 %0, %1 offset:%2" : "=&v"(r) : "v"(vb), "i"(OFF) : "memory"); return r; }
__device__ __forceinline__ int v_rd_base(int lane) { return ((lane & 3) << 3) | (((lane >> 2) & 3) << 6) | (((lane >> 4) & 1) << 5) | (((lane >> 5) & 1) << 8); }
template <int NCB, int D0> __device__ __forceinline__ void pv_one(f32x16& od, int vb, bf16x8 pa0, bf16x8 pa1, bf16x8 pa2, bf16x8 pa3) {
    constexpr int KS = 2 * NCB * 512, HF = NCB * 512, B = D0 * 512;
    const s16x4 l0 = tr_read<B + 0 * KS>(vb), h0 = tr_read<B + 0 * KS + HF>(vb), l1 = tr_read<B + 1 * KS>(vb), h1 = tr_read<B + 1 * KS + HF>(vb);
    const s16x4 l2 = tr_read<B + 2 * KS>(vb), h2 = tr_read<B + 2 * KS + HF>(vb), l3 = tr_read<B + 3 * KS>(vb), h3 = tr_read<B + 3 * KS + HF>(vb);
    asm volatile("s_waitcnt lgkmcnt(0)" ::: "memory"); __builtin_amdgcn_sched_barrier(0);
#define FA_PK(L, H) (bf16x8){L[0], L[1], L[2], L[3], H[0], H[1], H[2], H[3]}
    od = __builtin_amdgcn_mfma_f32_32x32x16_bf16(pa0, FA_PK(l0, h0), od, 0, 0, 0);
    od = __builtin_amdgcn_mfma_f32_32x32x16_bf16(pa1, FA_PK(l1, h1), od, 0, 0, 0);
    od = __builtin_amdgcn_mfma_f32_32x32x16_bf16(pa2, FA_PK(l2, h2), od, 0, 0, 0);
    od = __builtin_amdgcn_mfma_f32_32x32x16_bf16(pa3, FA_PK(l3, h3), od, 0, 0, 0);
#undef FA_PK
}
struct Desc {
    const gbf* Q; int ldq;
    const gbf* K; int ldk;
    const gbf* V; int ldv;
    int row0a, nta, row0b, NT;
    const gbf* G; int ldg;
    gbf* O; int ldo;
    int r0, wr0; const gf32* rpb;
    int hsa, hsb;
};
template <int N> __device__ __forceinline__ void wait_bar() {
    if constexpr (N == 0) asm volatile("s_waitcnt vmcnt(0) lgkmcnt(0)\n\ts_barrier" ::: "memory");
    else if constexpr (N == 2) asm volatile("s_waitcnt vmcnt(2) lgkmcnt(0)\n\ts_barrier" ::: "memory");
    else if constexpr (N == 5) asm volatile("s_waitcnt vmcnt(5) lgkmcnt(0)\n\ts_barrier" ::: "memory");
    else static_assert(N == 0, "wait_bar count");
}
template <int N> __device__ __forceinline__ void wait_bar2() {
    if constexpr (N == 0) asm volatile("s_waitcnt vmcnt(0) lgkmcnt(0)\n\ts_barrier" ::: "memory");
    else if constexpr (N == 1) asm volatile("s_waitcnt vmcnt(1) lgkmcnt(0)\n\ts_barrier" ::: "memory");
    else if constexpr (N == 2) asm volatile("s_waitcnt vmcnt(2) lgkmcnt(0)\n\ts_barrier" ::: "memory");
    else if constexpr (N == 5) asm volatile("s_waitcnt vmcnt(5) lgkmcnt(0)\n\ts_barrier" ::: "memory");
    else static_assert(N == 0, "wait_bar2 count");
}
template <int MODE, unsigned L0 = 0xFFFFu, unsigned L1 = 0xFFFFu> __device__ __forceinline__ void partial_sm(f32x16& p0, f32x16& p1, float& m_reg, float& alpha) {
    if constexpr (MODE == 1) {
#pragma unroll
        for (int r = 0; r < 16; ++r) { p0[r] *= NASCALE; p1[r] *= NASCALE; }
    }
    float pmax = -3.0e38f;
#pragma unroll
    for (int r = 0; r < 16; ++r) if ((L0 >> r) & 1u) pmax = fmaxf(pmax, p0[r]);
#pragma unroll
    for (int r = 0; r < 16; ++r) if ((L1 >> r) & 1u) pmax = fmaxf(pmax, p1[r]);
    { auto rr = __builtin_amdgcn_permlane32_swap(__float_as_uint(pmax), __float_as_uint(pmax), false, false); pmax = fmaxf(__uint_as_float(rr[0]), __uint_as_float(rr[1])); }
    if (__builtin_expect(__all(pmax - m_reg <= THRL), 1)) alpha = 1.f;
    else { const float mn = fmaxf(m_reg, pmax); alpha = __builtin_amdgcn_exp2f(m_reg - mn); m_reg = mn; }
#pragma unroll
    for (int r = 0; r < 16; ++r) { if ((L0 >> r) & 1u) p0[r] = __builtin_amdgcn_exp2f(p0[r] - m_reg); else p0[r] = 0.f; if ((L1 >> r) & 1u) p1[r] -= m_reg; }
}
template <unsigned L0 = 0xFFFFu, unsigned L1 = 0xFFFFu>
__device__ __forceinline__ void finish_sm(f32x16& p0, f32x16& p1, float alpha, float& l_reg, bf16x8& pa0, bf16x8& pa1, bf16x8& pa2, bf16x8& pa3) {
#pragma unroll
    for (int r = 0; r < 16; ++r) { if ((L1 >> r) & 1u) p1[r] = __builtin_amdgcn_exp2f(p1[r]); else p1[r] = 0.f; }
    float ps = 0.f;
#pragma unroll
    for (int r = 0; r < 16; ++r) if ((L0 >> r) & 1u) ps += p0[r];
#pragma unroll
    for (int r = 0; r < 16; ++r) if ((L1 >> r) & 1u) ps += p1[r];
    { auto rr = __builtin_amdgcn_permlane32_swap(__float_as_uint(ps), __float_as_uint(ps), false, false); ps = __uint_as_float(rr[0]) + __uint_as_float(rr[1]); }
    l_reg = l_reg * alpha + ps;
#define FA_PK4(P, BASE, OUT) do { unsigned a0 = cvtpk(P[BASE + 0], P[BASE + 1]), a1 = cvtpk(P[BASE + 2], P[BASE + 3]); \
    unsigned b0_ = cvtpk(P[BASE + 4], P[BASE + 5]), b1_ = cvtpk(P[BASE + 6], P[BASE + 7]); \
    auto r0_ = __builtin_amdgcn_permlane32_swap(a0, b0_, false, false); auto r1_ = __builtin_amdgcn_permlane32_swap(a1, b1_, false, false); \
    u32x4 w_ = {r0_[0], r1_[0], r0_[1], r1_[1]}; OUT = __builtin_bit_cast(bf16x8, w_); } while (0)
    FA_PK4(p0, 0, pa0); FA_PK4(p0, 8, pa1); FA_PK4(p1, 0, pa2); FA_PK4(p1, 8, pa3);
#undef FA_PK4
}
template <unsigned L0, unsigned L1> __device__ __forceinline__ void bias_win(f32x16& p0, f32x16& p1, const LAS float* brow, int cs, int hi) {
#pragma unroll
    for (int r = 0; r < 16; ++r) { const int kc = crow(r, hi);
        if ((L0 >> r) & 1u) p0[r] = ((unsigned)(kc - cs) < 16u) ? p0[r] + brow[kc] : -30000.f;
        if ((L1 >> r) & 1u) p1[r] = ((unsigned)(kc + 32 - cs) < 16u) ? p1[r] + brow[kc + 32] : -30000.f; }
}
template <int N> __device__ __forceinline__ void wait_barn() { asm volatile("s_waitcnt vmcnt(%0) lgkmcnt(0)\n\ts_barrier" :: "n"(N) : "memory"); }
template <int DQK, int DV, int MODE, int S, int NHU = 1>
__device__ __forceinline__ void unit_pipe(LAS unsigned char* lds, const Desc& d) {
    constexpr int RB = DQK * 2, KB1 = 64 * RB, VB1 = 64 * DV * 2, KB = NHU * KB1, VB = NHU * VB1, SLOT = KB + VB, KP = KB / 8192, VP = VB / 8192, NCB = DV / 32, NK = DQK / 16, NPIECE = KP + VP;
    constexpr int DK = S - 1, DVV = S - 2, WSTEADY = DVV * NPIECE;
    static_assert(S >= 2 && WSTEADY < 64 && S * SLOT + 2048 + NHU * 1920 + 16 <= LDS_BYTES && (NHU == 1 || NHU == 4), "ring geometry");
    const int tid = tid_op(), wid = __builtin_amdgcn_readfirstlane(tid >> 6), lane = tid & 63, r32 = lane & 31, hi = lane >> 5;
    const int hl = (NHU > 1) ? (wid >> 1) : 0, wrow0 = (NHU > 1) ? (wid & 1) * 32 : wid * 32;
    LAS float* wsf = (LAS float*)(lds + S * SLOT) + wid * 64;
    LAS float* rpbs = (LAS float*)(lds + S * SLOT + 2048) + hl * 480;
    unsigned koff[KP], voff[VP], koffb[KP], voffb[VP];
#pragma unroll
    for (int i = 0; i < KP; ++i) { const int pp = (wid * KP + i) * 1024 + lane * 16, hh = pp / KB1, p = pp % KB1, row = p / RB, cs = (p % RB) >> 4, c = cs ^ ((row >> 1) & 7);
        koff[i] = (unsigned)((hh * d.hsa + row) * d.ldk + c * 8) * 2u; koffb[i] = (unsigned)(hh * (d.hsb - d.hsa) * d.ldk) * 2u; }
#pragma unroll
    for (int i = 0; i < VP; ++i) { const int pp = (wid * VP + i) * 1024 + lane * 16, hh = pp / VB1, p = pp % VB1, st = p >> 9, q = p & 511, kk = (st / NCB) * 8 + (q >> 6), c = (st % NCB) * 32 + ((q & 63) >> 1);
        const int k = (kk & ~0xC) | ((kk & 4) << 1) | ((kk & 8) >> 1); voff[i] = (unsigned)((hh * d.hsa + k) * d.ldv + c) * 2u; voffb[i] = (unsigned)(hh * (d.hsb - d.hsa) * d.ldv) * 2u; }
    int qr_row = 0, qc = 0, rs = 0, cs = 0;
    if constexpr (MODE == 2) {
        qr_row = d.r0 + ((NHU > 1) ? 0 : (wid >> 1)); qc = (wid & 1) * 32 + r32; rs = min(max(qr_row - 4, 0), 24); cs = min(max(qc - 8, 0), 48);
        for (int i = tid; i < NHU * 15 * 31; i += NTHREADS) ((LAS float*)(lds + S * SLOT + 2048))[(i / 465) * 480 + i % 465] = d.rpb[i] * LOG2E;
    }
#define FP_ACT(t) ((MODE != 2) || (t) >= d.nta || (d.wr0 + (t) >= rs && d.wr0 + (t) <= rs + 7))
#define FP_VAR(t) ((MODE == 2 && (t) < d.nta) ? 1 + (wid & 1) : 0)
#define FP_PSM(P0, P1, al, t, v) do { if ((v) == 0) partial_sm<MODE>(P0, P1, m_reg, al); \
        else { const LAS float* brow_ = rpbs + (d.wr0 + (t) - qr_row + 7) * 31 - qc + 15; \
               if ((v) == 1) { bias_win<0xFFFFu, 0x000Fu>(P0, P1, brow_, cs, hi); partial_sm<MODE, 0xFFFFu, 0x000Fu>(P0, P1, m_reg, al); } \
               else          { bias_win<0xF000u, 0xFFFFu>(P0, P1, brow_, cs, hi); partial_sm<MODE, 0xF000u, 0xFFFFu>(P0, P1, m_reg, al); } } } while (0)
#define FP_FSM(P0, P1, al, v) do { if ((v) == 0) finish_sm(P0, P1, al, l_reg, pa0, pa1, pa2, pa3); else if ((v) == 1) finish_sm<0xFFFFu, 0x000Fu>(P0, P1, al, l_reg, pa0, pa1, pa2, pa3); \
        else finish_sm<0xF000u, 0xFFFFu>(P0, P1, al, l_reg, pa0, pa1, pa2, pa3); } while (0)
#define FP_ROW(t) (((t) < d.nta) ? d.row0a + 64 * (t) : d.row0b + 64 * ((t) - d.nta))
#define FP_DMAK(t) do { const int t_ = (t); const GAS char* kb_ = (const GAS char*)(d.K + (size_t)FP_ROW(t_) * d.ldk); const int s_ = t_ % S; const unsigned sb_ = (t_ < d.nta) ? 0u : 1u; \
        _Pragma("unroll") for (int i_ = 0; i_ < KP; ++i_) __builtin_amdgcn_global_load_lds((const GAS unsigned*)(kb_ + (koff[i_] + sb_ * koffb[i_])), (LAS unsigned*)(lds + s_ * KB + (wid * KP + i_) * 1024), 16, 0, 0); } while (0)
#define FP_DMAV(t) do { const int t_ = (t); const GAS char* vb_ = (const GAS char*)(d.V + (size_t)FP_ROW(t_) * d.ldv); const int s_ = t_ % S; const unsigned sb_ = (t_ < d.nta) ? 0u : 1u; \
        _Pragma("unroll") for (int i_ = 0; i_ < VP; ++i_) __builtin_amdgcn_global_load_lds((const GAS unsigned*)(vb_ + (voff[i_] + sb_ * voffb[i_])), (LAS unsigned*)(lds + S * KB + s_ * VB + (wid * VP + i_) * 1024), 16, 0, 0); } while (0)
#pragma unroll
    for (int s = -DK; s < 0; ++s) { FP_DMAK(s + DK); if (s + DVV >= 0) FP_DMAV(s + DVV); }
    bf16x8 qr[NK];
    { const gbf* Qw = d.Q + (size_t)(hl * d.hsa + wrow0 + r32) * d.ldq + hi * 8;
#pragma unroll
      for (int d0 = 0; d0 < NK; ++d0) qr[d0] = *(const GAS bf16x8*)(Qw + d0 * 16); }
    float m_reg = -1e30f, l_reg = 0.f;
    f32x16 o[NCB];
#pragma unroll
    for (int i = 0; i < NCB; ++i) o[i] = f32x16{};
    const int vbase = (int)(unsigned)(size_t)(lds + S * KB + hl * VB1) + v_rd_base(lane);
    const int ksw = ((r32 >> 1) & 7);
    const int NT = d.NT;
#define FP_QKT(P0, P1, t) do { const LAS unsigned char* Ks_ = lds + ((t) % S) * KB + hl * KB1; P0 = f32x16{}; P1 = f32x16{}; \
        _Pragma("unroll") for (int d0 = 0; d0 < NK; ++d0) { const int cb_ = ((2 * d0 + hi) ^ ksw) << 4; \
            const bf16x8 b0_ = *(const LAS bf16x8*)(Ks_ + r32 * RB + cb_), b1_ = *(const LAS bf16x8*)(Ks_ + (32 + r32) * RB + cb_); \
            P0 = __builtin_amdgcn_mfma_f32_32x32x16_bf16(b0_, qr[d0], P0, 0, 0, 0); P1 = __builtin_amdgcn_mfma_f32_32x32x16_bf16(b1_, qr[d0], P1, 0, 0, 0); } } while (0)
#define FP_PV(t) do { const int vb_ = vbase + ((t) % S) * VB; pv_one<NCB, 0>(o[0], vb_, pa0, pa1, pa2, pa3); pv_one<NCB, 1>(o[1], vb_, pa0, pa1, pa2, pa3); \
        if constexpr (NCB == 4) { pv_one<NCB, 2>(o[2], vb_, pa0, pa1, pa2, pa3); pv_one<NCB, 3>(o[3], vb_, pa0, pa1, pa2, pa3); } } while (0)
#define FP_RESC(a) do { if (__any((a) < 1.f)) { if (hi == 0) wsf[r32] = (a); asm volatile("s_waitcnt lgkmcnt(0)" ::: "memory"); \
        _Pragma("unroll") for (int dd = 0; dd < NCB; ++dd) _Pragma("unroll") for (int r = 0; r < 16; ++r) o[dd][r] *= wsf[crow(r, hi)]; } } while (0)
#define FP_ENDWAIT(j) do { if ((j) + DK < NT) wait_barn<WSTEADY>(); else wait_barn<0>(); } while (0)
#define FP_STEP(C0, C1, alC, Pv0, Pv1, alP, j) do { \
        if ((j) + DK < NT) FP_DMAK((j) + DK); \
        if ((j) + DVV < NT) FP_DMAV((j) + DVV); \
        __builtin_amdgcn_sched_barrier(0); \
        const bool actC_ = FP_ACT(j); \
        if (actC_) { FP_QKT(C0, C1, j); } \
        FP_FSM(Pv0, Pv1, alP, varP); __builtin_amdgcn_sched_barrier(0); \
        if (actP) { FP_PV((j) - 1); } \
        const int varC_ = FP_VAR(j); \
        if (actC_) { FP_PSM(C0, C1, alC, j, varC_); FP_RESC(alC); } \
        else { _Pragma("unroll") for (int r = 0; r < 16; ++r) { C0[r] = 0.f; C1[r] = -30000.f; } alC = 1.f; }     \
        actP = actC_; varP = varC_; \
        FP_ENDWAIT(j); } while (0)
    f32x16 pA0, pA1, pB0, pB1; float alA = 1.f, alB = 1.f; bf16x8 pa0, pa1, pa2, pa3;
    wait_barn<WSTEADY>();
    if (DK < NT) FP_DMAK(DK);
    if (DVV < NT) FP_DMAV(DVV);
    bool actP = FP_ACT(0);
    int varP = FP_VAR(0);
    if (actP) { FP_QKT(pA0, pA1, 0); FP_PSM(pA0, pA1, alA, 0, varP); }
    else {
#pragma unroll
        for (int r = 0; r < 16; ++r) { pA0[r] = 0.f; pA1[r] = -30000.f; } }
    FP_ENDWAIT(0);
    for (int j = 1; j + 1 < NT; j += 2) {
        FP_STEP(pB0, pB1, alB, pA0, pA1, alA, j);
        FP_STEP(pA0, pA1, alA, pB0, pB1, alB, j + 1);
    }
    FP_STEP(pB0, pB1, alB, pA0, pA1, alA, NT - 1);
    FP_FSM(pB0, pB1, alB, varP); __builtin_amdgcn_sched_barrier(0);
    if (actP) { FP_PV(NT - 1); }
    if (hi == 0) wsf[32 + r32] = l_reg;
    wait_barn<0>();
    {
        constexpr int RS = DV + 8, CPR = DV / 8, NCHL = 32 * CPR / 64;
        LAS bf16_t* st = (LAS bf16_t*)(lds + wid * (32 * RS * 2));
        const gbf* Gw = d.G + (size_t)wrow0 * d.ldg + hl * DV; gbf* Ow = d.O + (size_t)wrow0 * d.ldo + hl * DV;
        u32x4 gv[NCHL];
#pragma unroll
        for (int i = 0; i < NCHL; ++i) { const int idx = i * 64 + lane, row = idx / CPR, cc = idx % CPR; gv[i] = *(const GAS u32x4*)(Gw + (size_t)row * d.ldg + cc * 8); }
#pragma unroll
        for (int r = 0; r < 16; ++r) { const float rl = __builtin_amdgcn_rcpf(wsf[32 + crow(r, hi)]);
#pragma unroll
            for (int dd = 0; dd < NCB; ++dd) st[crow(r, hi) * RS + dd * 32 + r32] = (bf16_t)f2bf(o[dd][r] * rl); }
        asm volatile("s_waitcnt lgkmcnt(0)" ::: "memory");
#pragma unroll
        for (int i = 0; i < NCHL; ++i) { const int idx = i * 64 + lane, row = idx / CPR, cc = idx % CPR;
            f32x4 va, vb, ga, gb; unpk8(*(const LAS u32x4*)(st + row * RS + cc * 8), va, vb); unpk8(gv[i], ga, gb);
            *(GAS u32x4*)(Ow + (size_t)row * d.ldo + cc * 8) = pk8(va * ga, vb * gb); }
    }
    asm volatile("s_waitcnt lgkmcnt(0)\n\ts_barrier" ::: "memory");
#undef FP_ROW
#undef FP_ACT
#undef FP_VAR
#undef FP_PSM
#undef FP_FSM
#undef FP_DMAK
#undef FP_DMAV
#undef FP_QKT
#undef FP_PV
#undef FP_RESC
#undef FP_ENDWAIT
#undef FP_STEP
}
}

__device__ __forceinline__ void phase_attn_fast(const Params& p, int l, unsigned char* lds_, int gid, int G) {
    LAS unsigned char* lds = (LAS unsigned char*)lds_;
    gu8* ws = wsb();
    const gbf* P = (const gbf*)(ws + WS_P); const gbf* KM = (const gbf*)(ws + WS_KM); const gbf* VM = (const gbf*)(ws + WS_VM); const gbf* QM = (const gbf*)(ws + WS_QM);
    const gbf* NK = (const gbf*)(ws + WS_NK); const gbf* NV = (const gbf*)(ws + WS_NV); const gbf* NQ = (const gbf*)(ws + WS_NQ);
    gbf* AB = (gbf*)(ws + WS_AB);
    const gf32* rpb = pin(I_RPB) + (size_t)l * 16 * 15 * 31;
    const int vcu = (G % 8 == 0) ? (gid % 8) * (G / 8) + gid / 8 : gid;
    __syncthreads();
    for (int rep = 0; rep < (PROBE_DUP == 50 ? 2 : 1); ++rep)
    for (int u = vcu; u < NB * 8 * 8; u += G) { const int b = u >> 6, h = (u >> 3) & 7, qb = u & 7; const size_t q0 = (size_t)b * SEQ + qb * 256;
        const int lat0 = (b * 8 + h) * SEQ, ctx0 = NB * 8 * SEQ + (b * 8 + h) * CTXL;
        fa::Desc d{QM + (size_t)(lat0 + qb * 256) * 192, 192, KM, 192, VM, 128, ctx0, 4, lat0, 36, P + q0 * PP + C_GML + h * 128, PP, AB + q0 * ABW + 1024 + h * 128, ABW, 0, 0, nullptr, 0, 0};
        fa::unit_pipe<192, 128, 0, 3>(lds, d); }
    const bool upper = gid >= G / 2; const int nac = upper ? gid - G / 2 : gid, nacu = (G % 16 == 0) ? (nac % 8) * (G / 16) + nac / 8 : nac;
    for (int rep = 0; rep < (PROBE_DUP == 51 ? 2 : 1); ++rep)
    for (int u4 = nacu; u4 < NB * 16 * 2; u4 += G / 2) for (int u = u4 * 4 + (upper ? 0 : 3); u < u4 * 4 + (upper ? 3 : 4); ++u) {
        const int b = u >> 7, h0 = ((u >> 5) & 3) * 4, r = u & 31, rs = min(max(r - 4, 0), 24); const size_t q0 = (size_t)b * SEQ + r * 64;
        const int lat0 = (b * 16 + h0) * SEQ, ctx0 = NB * 16 * SEQ + (b * 16 + h0) * CTXL;
        fa::Desc d{NQ + (size_t)(lat0 + r * 64) * 64, 64, NK, 64, NV, 64, lat0 + rs * 64, 8, ctx0, 12, P + q0 * PP + C_GNA + h0 * 64, PP, AB + q0 * ABW + 2048 + h0 * 64, ABW,
                   r, rs, rpb + h0 * 15 * 31, SEQ, CTXL};
        fa::unit_pipe<64, 64, 2, 2, 4>(lds, d); }
    if (l == 0) {
        for (int u = gid - G / 2; u >= 0 && u < NB * 8; u += G) { const int b = u >> 3, h = u & 7; const size_t q0 = (size_t)NLAT + b * CTXL; const int ctx0 = NB * 8 * SEQ + (b * 8 + h) * CTXL;
            fa::Desc d{QM + (size_t)ctx0 * 192, 192, KM, 192, VM, 128, ctx0, 4, 0, 4, P + q0 * PP + C_GML + h * 128, PP, AB + q0 * ABW + 1024 + h * 128, ABW, 0, 0, nullptr, 0, 0};
            fa::unit_pipe<192, 128, 0, 3>(lds, d); }
        for (int u = gid - G / 2 - 32; u >= 0 && u < NB * 16; u += G) { const int b = u >> 4, h = u & 15; const size_t q0 = (size_t)NLAT + b * CTXL; const int ctx0 = NB * 16 * SEQ + (b * 16 + h) * CTXL;
            fa::Desc d{NQ + (size_t)ctx0 * 64, 64, NK, 64, NV, 64, ctx0, 4, 0, 4, P + q0 * PP + C_GNA + h * 64, PP, AB + q0 * ABW + 2048 + h * 64, ABW, 0, 0, nullptr, 0, 0};
            fa::unit_pipe<64, 64, 0, 4>(lds, d); }
    }
    __syncthreads();
}


#define XB_TMO      128
#define XB_XCNT(j)  (256  + 64 * (j))
#define XB_XSUB(j)  (1280 + 64 * (j))
#define XB_XGEN(j)  (2304 + 64 * (j))
#define XB_TOP      3328
#define XB_TOPGEN   3392
#define XCD_BAR_WORDS 3456
#define XB_SPIN_CAP (1u << 18)
__device__ __forceinline__ unsigned xb_ld(unsigned* p)              { return __hip_atomic_load(p, __ATOMIC_RELAXED, __HIP_MEMORY_SCOPE_AGENT); }
__device__ __forceinline__ unsigned xb_add(unsigned* p, unsigned v) { return __hip_atomic_fetch_add(p, v, __ATOMIC_RELAXED, __HIP_MEMORY_SCOPE_AGENT); }
__device__ __forceinline__ unsigned xb_xcc_id() { return (unsigned)__builtin_amdgcn_s_getreg((3 << 11) | 20) & 0xFu; }
#define XB_SPIN(cond, bar) do { unsigned _sp = 0; while (cond) { __builtin_amdgcn_s_sleep(1); \
    if ((++_sp & 255u) == 0u) { if (xb_ld(&(bar)[XB_TMO])) break; if (_sp > XB_SPIN_CAP) { atomicAdd(&(bar)[XB_TMO], 1u); break; } } } } while (0)
struct XcdBarrier { unsigned* bar; unsigned x; volatile LAS unsigned* st; };
__device__ __forceinline__ XcdBarrier xcd_barrier_post(unsigned* bar, volatile LAS unsigned* st) {
    XcdBarrier b; b.bar = bar; b.x = xb_xcc_id(); b.st = st;
    if (threadIdx.x == 0) (void)xb_add(&bar[XB_XCNT(b.x)], 1u);
    return b;
}
__device__ __forceinline__ void xcd_barrier_complete(unsigned* bar, unsigned x, unsigned& nloc, unsigned& nx) {
    const unsigned G = gridDim.x * gridDim.y * gridDim.z;
    unsigned sum, cnt, mine, sp = 0u;
    for (;;) {
        sum = 0u; cnt = 0u; mine = 0u;
#pragma unroll
        for (unsigned j = 0; j < 16; ++j) { const unsigned c = xb_ld(&bar[XB_XCNT(j)]); sum += c; cnt += (c > 0u) ? 1u : 0u; mine = (j == x) ? c : mine; }
        if (sum == G) break;
        __builtin_amdgcn_s_sleep(1);
        if ((++sp & 255u) == 0u) { if (xb_ld(&bar[XB_TMO])) break; if (sp > XB_SPIN_CAP) { atomicAdd(&bar[XB_TMO], 1u); break; } }
    }
    nloc = mine > 0u ? mine : 1u; nx = cnt > 0u ? cnt : 1u;
}
__device__ __forceinline__ void xcd_barrier(const XcdBarrier& b) {
    asm volatile("s_waitcnt vmcnt(0)" ::: "memory");
    __syncthreads();
    if (threadIdx.x == 0) {
        unsigned* bar = b.bar;
        __builtin_amdgcn_s_waitcnt(0);
        unsigned nloc = b.st[0], nx = b.st[1];
        if (nloc == 0u) { xcd_barrier_complete(bar, b.x, nloc, nx); b.st[0] = nloc; b.st[1] = nx; }
        const unsigned old = xb_add(&bar[XB_XSUB(b.x)], 1u);
        const unsigned gen = old / nloc;
        if (old + 1u == (gen + 1u) * nloc) {
            __builtin_amdgcn_fence(__ATOMIC_RELEASE, "agent");
            asm volatile("s_waitcnt vmcnt(0)" ::: "memory");
            const unsigned og = xb_add(&bar[XB_TOP], 1u);
            const unsigned tg = og / nx;
            if (og + 1u == (tg + 1u) * nx) xb_add(&bar[XB_TOPGEN], 1u);
            else XB_SPIN(xb_ld(&bar[XB_TOPGEN]) == tg, bar);
            __builtin_amdgcn_fence(__ATOMIC_ACQUIRE, "agent");
            xb_add(&bar[XB_XGEN(b.x)], 1u);
            asm volatile("s_waitcnt vmcnt(0)" ::: "memory");
        } else {
            XB_SPIN(xb_ld(&bar[XB_XGEN(b.x)]) == gen, bar);
            __builtin_amdgcn_fence(__ATOMIC_ACQUIRE, "agent");
            asm volatile("s_waitcnt vmcnt(0)" ::: "memory");
        }
    }
    __syncthreads();
}

#define WSB(off) (wsb() + (off))
__global__ void __launch_bounds__(NTHREADS, 2) fwd_megakernel(Params p) {
    extern __shared__ __attribute__((aligned(16))) unsigned char lds[];
    cg::grid_group grid = cg::this_grid();
    const int gid_ = blockIdx.x, G_ = gridDim.x;
    auto sop = [](int v) { asm volatile("" : "+s"(v)); return v; };
#define gid sop(gid_)
#define G sop(G_)

    { volatile LAS unsigned* st0 = (volatile LAS unsigned*)((LAS unsigned char*)lds + LDS_BYTES - 16); if (threadIdx.x < 4) st0[threadIdx.x] = 0u; __syncthreads(); }
    (void)xcd_barrier_post((unsigned*)(wsb() + WS_BAR), (volatile LAS unsigned*)((LAS unsigned char*)lds + LDS_BYTES - 16));
    if (wsb() == nullptr) grid.sync();
#define GSYNC() xcd_barrier(XcdBarrier{(unsigned*)(wsb() + WS_BAR), xb_xcc_id(), (volatile LAS unsigned*)((LAS unsigned char*)lds + LDS_BYTES - 16)})
    for (int rep = 0; rep < (PROBE_DUP == 0 ? 2 : 1); ++rep) { phase0(p, lds, gid, G); GSYNC(); }

    for (int rep = 0; rep < (PROBE_DUP == 1 ? 2 : 1); ++rep) { phase_uprep0(p, gid, G); GSYNC(); }
    for (int l = 0; l < DEPTH; ++l) {
        const int nq = (l == 0) ? NROW : NLAT;
        for (int rep = 0; rep < ((PROBE_DUP == 2 || PROBE_DUP == 3) ? 2 : 1); ++rep) {
            const gbf* WinT = (const gbf*)WSB(WS_WIN) + (size_t)l * NP * KP2; gbf* U = (gbf*)WSB(WS_U); gbf* P = (gbf*)WSB(WS_P);
            const EpiInProj E{P, 0, (gbf*)WSB(WS_NK), (gbf*)WSB(WS_NV), (gbf*)WSB(WS_NQ), (gbf*)WSB(WS_MG)};
            if (l == 0 && G == 256) {
                __syncthreads();
                { fg::SchedIn0 S{U, WinT, G, gid, 0, 11}; fg::gemm((LAS unsigned char*)lds, KP2, KP2, DM, S, E); }
                __syncthreads();
                GSYNC();
                if (gid < 64) { fg::SchedIn0 S{U, WinT, G, gid, 11, 12}; fg::gemm((LAS unsigned char*)lds, KP2, KP2, DM, S, E); __syncthreads(); }
                else phase_c1(p, l, NROW, gid - 64, G - 64);
                GSYNC();
            } else {
                gemm_run(lds, GemmJob{U, KP2, WinT, KP2, nq, NP, DM}, E, gid, G);
                GSYNC();
                if (l == 0) phase_c1(p, l, NROW, gid, G);
                else if (gid < 40) gemm_run(lds, GemmJob{(const gbf*)WSB(WS_U) + (size_t)NLAT * KP2, KP2, (const gbf*)WSB(WS_WIN) + (size_t)l * NP * KP2, KP2, NCTX, KVC_P, DM},
                                            EpiInProjC1{(gbf*)WSB(WS_P), (gbf*)WSB(WS_NK), (gbf*)WSB(WS_KM), (gf32*)WSB(WS_SSQ)}, gid, 40);
                else phase_c1(p, l, NLAT, gid - 40, G - 40);
                GSYNC();
            }
        }
        for (int rep = 0; rep < (PROBE_DUP == 4 ? 2 : 1); ++rep) {
            __syncthreads();
            { SchedC2 S{(const gbf*)WSB(WS_P), (const gbf*)WSB(WS_WUKV) + (size_t)l * 2048 * 256, (const gbf*)WSB(WS_WUQ) + (size_t)l * 1536 * 512, (const gbf*)WSB(WS_DC), nq / 256, l == 0 ? 32 : 0, G, gid};
              EpiC2 E{(gbf*)WSB(WS_KM), (gbf*)WSB(WS_VM), (gbf*)WSB(WS_QM), (gbf*)WSB(WS_GT), (gbf*)WSB(WS_GTC), (const gf32*)WSB(WS_RKV), (const gf32*)WSB(WS_RQ), (const gf32*)WSB(WS_ROPE), l == 1 ? (const gf32*)WSB(WS_SSQ) : (const gf32*)nullptr};
              fg::gemm_multi((LAS unsigned char*)lds, S, E); }
            __syncthreads();
            GSYNC();
        }
        for (int rep = 0; rep < (PROBE_DUP == 5 ? 2 : 1); ++rep) {
        phase_attn_fast(p, l, lds, gid, G);
        for (int rep2 = 0; rep2 < (PROBE_DUP == 52 ? 2 : 1); ++rep2)
        gemm_fast_z(lds, MapF2{(const gbf*)WSB(WS_DN), (const gbf*)WSB(WS_GT), KP4}, KP4, KP4, 2 * SEQ, SEQ / 256, 4, NB, EpiF2{(gbf*)WSB(WS_AB), (const gbf*)WSB(WS_P), 0, SEQ}, gid < G / 2 ? gid : -1, G / 2);
        if (l == 0) gemm_fast_z(lds, MapF2{(const gbf*)WSB(WS_DNC), (const gbf*)WSB(WS_GTC), 2 * CTXL}, 2 * CTXL, 2 * CTXL, 2 * CTXL, 1, 4, NB, EpiF2{(gbf*)WSB(WS_AB), (const gbf*)WSB(WS_P), NLAT, CTXL}, gid - G / 2 - 96, G);
        GSYNC();
        }
        const gbf* WpT = (const gbf*)WSB(WS_WP) + (size_t)l * 4 * 2048 * KP1; const gbf* WoT = (const gbf*)WSB(WS_WO) + (size_t)l * 2048 * KP2;
        const int NC = G / 8;
        for (int rep = 0; rep < (PROBE_DUP == 6 ? 2 : 1); ++rep) {
          __syncthreads();
          { fg::SchedBranch S{(const gbf*)WSB(WS_AB), WpT, NLAT / 256, DM / 256, G, gid, 0};
            fg::gemm((LAS unsigned char*)lds, ABW, KP1, 1024, S, EpiChain{(gbf*)WSB(WS_MB), (const gbf*)WSB(WS_MG), 0}); }
          __syncthreads();
          GSYNC();
        }
        for (int rep = 0; rep < (PROBE_DUP == 7 ? 2 : 1); ++rep) {
          if (l == 0) {
            __syncthreads();
            if (gid < NC) { fg::SchedBranch S{(const gbf*)WSB(WS_AB), WpT, NCTX / 256, DM / 256, NC, gid, NLAT / 256};
                            fg::gemm((LAS unsigned char*)lds, ABW, KP1, 1024, S, EpiChain{(gbf*)WSB(WS_MB), (const gbf*)WSB(WS_MG), NLAT}); }
            else { fg::Sched<fg::MapPlain> S{fg::MapPlain{(const gbf*)WSB(WS_MB), KP2, WoT, KP2}, NLAT / 256, DM / 256, 1, G - NC, gid - NC};
                   fg::gemm((LAS unsigned char*)lds, KP2, KP2, DM, S, EpiOut{(gf32*)WSB(WS_Y), 0}); }
            __syncthreads();
          } else gemm_run(lds, GemmJob{(const gbf*)WSB(WS_MB), KP2, WoT, KP2, NLAT, DM, DM}, EpiOut{(gf32*)WSB(WS_Y), 0}, gid, G);
          GSYNC();
        }
        for (int rep = 0; rep < (PROBE_DUP == 8 ? 2 : 1); ++rep) {
          if (l == 0) {
            if (gid < NC) gemm_run(lds, GemmJob{(const gbf*)WSB(WS_MB) + (size_t)NLAT * KP2, KP2, WoT, KP2, NCTX, DM, DM}, EpiOut{(gf32*)WSB(WS_Y), NLAT}, gid, NC);
            else phase_final(p, l, 0, NLAT, gid - NC, G - NC);
            GSYNC();
            phase_final(p, l, NLAT, NROW, gid, G);
            GSYNC();
          } else {
            phase_final(p, l, 0, NLAT, gid, G);
            if (rep + 1 < (PROBE_DUP == 8 ? 2 : 1)) GSYNC();
          }
        }
    }
}
#undef gid
#undef G

extern "C" void kernel_launch(void* const* d_in, const int* in_sizes, int n_in, void* d_out, int out_size, void* d_ws, size_t ws_size, hipStream_t stream) {
    static int grid_blocks = 0;
    if (grid_blocks == 0) {
        if (n_in != 20 || out_size != NLAT * DM || ws_size < WS_END) { fprintf(stderr, "kernel_launch: unexpected shapes (n_in %d out %d ws %zu, need ws >= %zu)\n", n_in, out_size, ws_size, (size_t)WS_END); grid_blocks = -1; return; }
        int dev = 0, cus = 0, per_cu = 0;
        hipGetDevice(&dev);
        hipDeviceGetAttribute(&cus, hipDeviceAttributeMultiprocessorCount, dev);
        if (hipFuncSetAttribute((const void*)fwd_megakernel, hipFuncAttributeMaxDynamicSharedMemorySize, LDS_BYTES) != hipSuccess) { fprintf(stderr, "kernel_launch: hipFuncSetAttribute failed\n"); grid_blocks = -1; return; }
        if (hipOccupancyMaxActiveBlocksPerMultiprocessor(&per_cu, (const void*)fwd_megakernel, NTHREADS, LDS_BYTES) != hipSuccess || per_cu < 1) { fprintf(stderr, "kernel_launch: occupancy query failed (%d)\n", per_cu); grid_blocks = -1; return; }
        grid_blocks = cus;
        fprintf(stderr, "kernel_launch: cus %d per_cu %d grid %d\n", cus, per_cu, grid_blocks);
    }
    if (grid_blocks < 0) return;
    if (hipMemsetAsync((char*)d_ws + WS_BAR, 0, 16384, stream) != hipSuccess) { fprintf(stderr, "kernel_launch: hipMemsetAsync of the barrier words failed\n"); return; }
    Params p{};
    for (int i = 0; i < 20; ++i) p.in[i] = (const gf32*)d_in[i];
    p.out = (gf32*)d_out; p.ws = (gu8*)d_ws;
    void* args[] = {&p};
    hipError_t e = hipLaunchCooperativeKernel((const void*)fwd_megakernel, dim3(grid_blocks), dim3(NTHREADS), args, LDS_BYTES, stream);
    if (e != hipSuccess) fprintf(stderr, "kernel_launch: cooperative launch failed: %s (grid %d)\n", hipGetErrorString(e), grid_blocks);
}
```

```cpp
#include <hip/hip_runtime.h>
#include <hip/hip_cooperative_groups.h>
#include <cstdio>
#include <cstdint>
namespace cg = cooperative_groups;
#ifndef PROBE_DUP
#define PROBE_DUP -1
#endif

#define GAS __attribute__((address_space(1)))
typedef unsigned short bf16_t;
typedef GAS bf16_t gbf;
typedef GAS float gf32;
typedef GAS unsigned char gu8;
typedef float f32x4 __attribute__((ext_vector_type(4)));
typedef unsigned u32x4 __attribute__((ext_vector_type(4)));
typedef unsigned u32x2 __attribute__((ext_vector_type(2)));

constexpr int DM = 2048, NB = 4, SEQ = 2048, CTXL = 256, DEPTH = 2;
constexpr int NLAT = NB * SEQ, NCTX = NB * CTXL, NROW = NLAT + NCTX;
constexpr int N_IN = 20288, NP = 20480;
constexpr int PP = 12288 + 64;
constexpr int KP2 = DM + 64;
constexpr int KP1 = 1024 + 64;
constexpr int KP4 = 4096 + 64;
constexpr int C_CKV = 0, C_KR = 256, C_NAK = 512, C_NAV = 1536, C_QL = 2560, C_NAQ = 3072, C_CB = 4096, C_CC = 5120, C_CX = 6144, C_FV = 7168,
              C_GCV = 8192, C_GML = 9216, C_GNA = 10240, C_GFN = 11264, C_MG = 12288;
constexpr int KVC_P = 2560;
constexpr int KMW = 1536, VMW = 1024, QMW = 1536, ABW = 4160;
constexpr float EPS = 1e-6f;
constexpr float LOG2E = 1.4426950408889634f;
constexpr float QSCALE = 0.07216878364870322f * LOG2E;
constexpr float NASCALE = 0.125f * LOG2E;
constexpr int NTHREADS = 512, NWAVES = 8;
constexpr int LDS_BYTES = 147456;

constexpr size_t al256(size_t x) { return (x + 255) / 256 * 256; }
constexpr size_t WS_WIN = 0;
constexpr size_t WS_WUKV = WS_WIN + al256((size_t)2 * NP * KP2 * 2);
constexpr size_t WS_WUQ = WS_WUKV + al256((size_t)2 * 2048 * 256 * 2);
constexpr size_t WS_WP = WS_WUQ + al256((size_t)2 * 1536 * 512 * 2);
constexpr size_t WS_WO = WS_WP + al256((size_t)2 * 4 * 2048 * KP1 * 2);
constexpr size_t WS_MOD = WS_WO + al256((size_t)2 * 2048 * KP2 * 2);
constexpr size_t WS_ROPE = WS_MOD + al256((size_t)2 * 5 * 6144 * 4);
constexpr size_t WS_DC = WS_ROPE + al256((size_t)64 * 16 * 2 * 4);
constexpr size_t WS_DN = WS_DC + al256((size_t)512 * 256 * 2);
constexpr size_t WS_DNC = WS_DN + al256((size_t)2048 * KP4 * 2);
constexpr size_t WS_U = WS_DNC + al256((size_t)256 * 512 * 2);
constexpr size_t WS_P = WS_U + al256((size_t)NROW * KP2 * 2);
constexpr size_t WS_KM = WS_P + al256((size_t)NROW * PP * 2);
constexpr size_t WS_VM = WS_KM + al256((size_t)NROW * KMW * 2);
constexpr size_t WS_QM = WS_VM + al256((size_t)NROW * VMW * 2);
constexpr size_t WS_AB = WS_QM + al256((size_t)NROW * QMW * 2);
constexpr size_t WS_GT = WS_AB + al256((size_t)NROW * ABW * 2);
constexpr size_t WS_GTC = WS_GT + al256((size_t)4 * 1024 * KP4 * 2);
constexpr size_t WS_MF = WS_GTC + al256((size_t)4 * 1024 * 512 * 2);
constexpr size_t WS_MB = WS_MF + al256((size_t)NROW * DM * 4);
constexpr size_t WS_Y = WS_MB + al256((size_t)NROW * KP2 * 2);
constexpr size_t WS_RKV = WS_Y + al256((size_t)NROW * DM * 4);
constexpr size_t WS_RQ = WS_RKV + al256((size_t)NROW * 4);
constexpr size_t WS_XL = WS_RQ + al256((size_t)NROW * 4);
constexpr size_t WS_NK = WS_XL + al256((size_t)NROW * DM * 4);
constexpr size_t WS_NV = WS_NK + al256((size_t)NROW * 1024 * 2);
constexpr size_t WS_NQ = WS_NV + al256((size_t)NROW * 1024 * 2);
constexpr size_t WS_MG = WS_NQ + al256((size_t)NROW * 1024 * 2);
constexpr size_t WS_SSQ = WS_MG + al256((size_t)4 * NROW * DM * 2);
constexpr size_t WS_BAR = WS_SSQ + al256((size_t)NCTX * 8 * 4);
constexpr size_t WS_END = WS_BAR + 16384;

struct Params { const gf32* in[20]; gf32* out; gu8* ws; };
enum { I_X = 0, I_C, I_CTX, I_CCTX, I_GPRE, I_GPOST, I_WADA, I_BADA, I_WIN, I_GQ, I_GKV, I_WUQ, I_WUKV, I_CONVW, I_RPB, I_WPC, I_WPM, I_WPN, I_WPF, I_WOUT };

__device__ __forceinline__ size_t hm_row(int r, int h, int NH) {
    return r < NLAT ? (size_t)(((r >> 11) * NH + h) * SEQ + (r & (SEQ - 1))) : (size_t)NB * NH * SEQ + (size_t)((((r - NLAT) >> 8) * NH + h) * CTXL + ((r - NLAT) & (CTXL - 1)));
}

__device__ __forceinline__ size_t mg_off(int z, int r, int c) { return ((((size_t)z * (NROW / 256) + (r >> 8)) * (DM / 256) + (c >> 8)) * 256 + (r & 255)) * 256 + (c & 255); }

__device__ __forceinline__ unsigned f2bf(float f) { unsigned u = __builtin_bit_cast(unsigned, f); return (u + 0x7fffu + ((u >> 16) & 1u)) >> 16; }
typedef float f32x2_t __attribute__((ext_vector_type(2))); typedef __bf16 bf16x2_t __attribute__((ext_vector_type(2)));
__device__ __forceinline__ unsigned pk2(float lo, float hi) { f32x2_t v = {lo, hi}; bf16x2_t b = __builtin_convertvector(v, bf16x2_t); return __builtin_bit_cast(unsigned, b); }
__device__ __forceinline__ float bf2f(unsigned short b) { return __builtin_bit_cast(float, (unsigned)b << 16); }
__device__ __forceinline__ float bflo(unsigned w) { return __builtin_bit_cast(float, w << 16); }
__device__ __forceinline__ float bfhi(unsigned w) { return __builtin_bit_cast(float, w & 0xffff0000u); }
__device__ __forceinline__ u32x2 pk4(f32x4 v) { u32x2 r; r.x = pk2(v[0], v[1]); r.y = pk2(v[2], v[3]); return r; }
__device__ __forceinline__ u32x4 pk8(f32x4 a, f32x4 b) { u32x4 r; r.x = pk2(a[0], a[1]); r.y = pk2(a[2], a[3]); r.z = pk2(b[0], b[1]); r.w = pk2(b[2], b[3]); return r; }
__device__ __forceinline__ void unpk8(u32x4 w, f32x4& a, f32x4& b) { a = (f32x4){bflo(w.x), bfhi(w.x), bflo(w.y), bfhi(w.y)}; b = (f32x4){bflo(w.z), bfhi(w.z), bflo(w.w), bfhi(w.w)}; }
__device__ __forceinline__ f32x4 unpk4(u32x2 w) { return (f32x4){bflo(w.x), bfhi(w.x), bflo(w.y), bfhi(w.y)}; }
__device__ __forceinline__ float sigmoidf_(float x) { return __builtin_amdgcn_rcpf(1.0f + __builtin_amdgcn_exp2f(x * -LOG2E)); }
__device__ __forceinline__ float siluf_(float x) { return x * __builtin_amdgcn_rcpf(1.0f + __builtin_amdgcn_exp2f(x * -LOG2E)); }
__device__ __forceinline__ float wave_sum(float v) {
#pragma unroll
    for (int o = 1; o < 64; o <<= 1) v += __shfl_xor(v, o);
    return v;
}
__device__ __forceinline__ float wave_max(float v) {
#pragma unroll
    for (int o = 1; o < 64; o <<= 1) v = fmaxf(v, __shfl_xor(v, o));
    return v;
}

typedef __attribute__((address_space(4))) const unsigned char* kargp_t;
__device__ __forceinline__ kargp_t karg_op() { kargp_t k = (kargp_t)__builtin_amdgcn_kernarg_segment_ptr(); asm volatile("" : "+s"(k)); return k; }
__device__ __forceinline__ const gf32* pin(int i) { return *(const gf32* const __attribute__((address_space(4)))*)(karg_op() + 8 * i); }
__device__ __forceinline__ gf32* pout() { return *(gf32* const __attribute__((address_space(4)))*)(karg_op() + 8 * 20); }
__device__ __forceinline__ gu8* wsb() { return *(gu8* const __attribute__((address_space(4)))*)(karg_op() + 8 * 21); }
__device__ __forceinline__ int tid_op() { int t = threadIdx.x; asm volatile("" : "+v"(t)); return t; }

struct GemmJob { const gbf* A; int lda; const gbf* Bt; int ldb; int M, N, K; };

#define LAS __attribute__((address_space(3)))
typedef short bf16x8 __attribute__((ext_vector_type(8)));
namespace fg {
constexpr int BM = 256, BK = 64, HALF = 128, HTB = HALF * BK * 2, STAGE_BYTES = 8 * HTB, NXCD = 8, WGM = 4;
__device__ __forceinline__ int lds_byte(int r, int c) { const int st = (r >> 4) * 2 + (c >> 5), rr = r & 15, cc = c & 31, ob = rr * 64 + cc * 2; return st * 1024 + (ob ^ (((ob >> 9) & 1) << 5)); }
__device__ __forceinline__ void stage_rc(int b, int& R, int& C) { const int st = b / 1024, sb = b % 1024, swz = sb ^ (((sb >> 9) & 1) << 5); R = (st >> 1) * 16 + swz / 64; C = (st & 1) * 32 + (swz % 64) / 2; }
__device__ __forceinline__ int perm32(int rho) { const int n = rho >> 4, i = rho & 15; return 8 * (i >> 2) + 4 * n + (i & 3); }
struct Unit { const GAS char* A; const GAS char* B; int pm, pn, z; };
template <class Map> struct Sched {
    Map map; int nM, nN, nz, G, c;
    __device__ __forceinline__ bool next(int i, Unit& u) const {
        const int per = nM * nN, nwg = per * nz; const long L = (long)i * G + c; if (L >= nwg) return false;
        int wgid = (int)L; { const int q = nwg / NXCD, r = nwg % NXCD, xcd = wgid % NXCD, off = wgid / NXCD; wgid = (xcd < r ? xcd * (q + 1) : r * (q + 1) + (xcd - r) * q) + off; }
        const int z = wgid / per, w = wgid % per;
        const int nig = WGM * nN, gidx = w / nig, fm = gidx * WGM, gsz = (nM - fm) < WGM ? (nM - fm) : WGM;
        u.pm = fm + ((w % nig) % gsz); u.pn = (w % nig) / gsz; u.z = z; u.A = (const GAS char*)map.a(z, u.pm); u.B = (const GAS char*)map.b(z, u.pn); return true;
    }
};
template <class Epi, class S_>
__device__ __forceinline__ void gemm(LAS unsigned char* lds, int lda, int ldb, int K, const S_& S, const Epi& E) {
    const int tid = tid_op(), wid = __builtin_amdgcn_readfirstlane(tid >> 6), lane = tid & 63, wr = wid >> 2, wc = wid & 3, fr = lane & 15, fq = lane >> 4;
    int Kop = K; asm volatile("" : "+s"(Kop));
    const int nt = Kop / BK;
    unsigned voffA[2], voffB[2];
#pragma unroll
    for (int i = 0; i < 2; ++i) { int R, C; stage_rc(tid * 16 + i * 8192, R, C); const int Rb = Epi::PERM ? ((R & ~31) + perm32(R & 31)) : R;
        voffA[i] = (unsigned)(R * lda + C) * 2u; voffB[i] = (unsigned)(Rb * ldb + C) * 2u; }
    const size_t kstep = (size_t)(BK * 2);
    const size_t hstepA = (size_t)HALF * lda * 2, hstepB = (size_t)HALF * ldb * 2;
    const unsigned ldsw = (unsigned)wid * 1024u;
    const int aoff = lds_byte(wr * 64 + fr, fq * 8), boff = lds_byte(wc * 32 + fr, fq * 8);
#define FG_SA(b, h) (((b) * 2 + (h)) * HTB)
#define FG_SB(b, h) ((4 + (b) * 2 + (h)) * HTB)
#define FG_STAGE(bufoff, gbase, voff) do { _Pragma("unroll") for (int _i = 0; _i < 2; ++_i) \
        __builtin_amdgcn_global_load_lds((const GAS unsigned*)((const GAS char*)(gbase) + (voff)[_i]), (LAS unsigned*)(lds + (bufoff) + ldsw + _i * 8192), 16, 0, 0); } while (0)
#define FG_LDA(dst, b, h) do { _Pragma("unroll") for (int m = 0; m < 4; ++m) _Pragma("unroll") for (int k = 0; k < 2; ++k) dst[m][k] = *(const LAS bf16x8*)(lds + FG_SA(b, h) + aoff + m * 2048 + k * 1024); } while (0)
#define FG_LDB(dst, b, h) do { _Pragma("unroll") for (int n = 0; n < 2; ++n) _Pragma("unroll") for (int k = 0; k < 2; ++k) dst[n][k] = *(const LAS bf16x8*)(lds + FG_SB(b, h) + boff + n * 2048 + k * 1024); } while (0)
#define FG_MMA(ai, bj, At, Bt) do { __builtin_amdgcn_s_setprio(1); _Pragma("unroll") for (int m = 0; m < 4; ++m) _Pragma("unroll") for (int n = 0; n < 2; ++n) _Pragma("unroll") for (int k = 0; k < 2; ++k) \
        acc[ai][bj][m][n] = __builtin_amdgcn_mfma_f32_16x16x32_bf16(Bt[n][k], At[m][k], acc[ai][bj][m][n], 0, 0, 0); __builtin_amdgcn_s_setprio(0); } while (0)
#define FG_WAIT_V(n) asm volatile("s_waitcnt vmcnt(" #n ")" ::: "memory")
#define FG_WAIT_L(n) asm volatile("s_waitcnt lgkmcnt(" #n ")" ::: "memory")
#define FG_BAR __builtin_amdgcn_s_barrier()
#define FG_SCHED __builtin_amdgcn_sched_barrier(0)
    Unit cur, nxt; int ui = 0;
    if (!S.next(0, cur)) return;
    f32x4 acc[2][2][4][2];
#pragma unroll
    for (int a = 0; a < 2; ++a)
#pragma unroll
        for (int b = 0; b < 2; ++b)
#pragma unroll
            for (int m = 0; m < 4; ++m)
#pragma unroll
                for (int n = 0; n < 2; ++n) acc[a][b][m][n] = (f32x4){0.f, 0.f, 0.f, 0.f};
    bf16x8 At[4][2], B0[2][2], B1[2][2];
    const GAS char* cA = cur.A; const GAS char* cB = cur.B;
    FG_STAGE(FG_SB(0, 0), cB, voffB); FG_STAGE(FG_SB(0, 1), cB + hstepB, voffB); FG_STAGE(FG_SA(0, 0), cA, voffA); FG_STAGE(FG_SA(0, 1), cA + hstepA, voffA);
    if (wr == 1) FG_BAR;
    FG_WAIT_V(2); FG_BAR;
    FG_STAGE(FG_SB(1, 0), cB + kstep, voffB); FG_STAGE(FG_SA(1, 0), cA + kstep, voffA); FG_STAGE(FG_SB(1, 1), cB + hstepB + kstep, voffB);
    FG_WAIT_V(6); FG_BAR;
    for (;;) {
        const bool has_next = S.next(ui + 1, nxt);
        const GAS char* nA = has_next ? nxt.A : cA; const GAS char* nB = has_next ? nxt.B : cB;
        for (int t = 0; t < nt; t += 2) {
            const bool last = (t == nt - 2);
            const GAS char* a1 = cA + (size_t)(t + 1) * kstep;
            const GAS char* a2 = last ? nA : cA + (size_t)(t + 2) * kstep; const GAS char* b2 = last ? nB : cB + (size_t)(t + 2) * kstep;
            const GAS char* a3 = a2 + kstep; const GAS char* b3 = b2 + kstep;
            FG_LDB(B0, 0, 0); FG_LDB(B1, 0, 1); FG_SCHED; FG_LDA(At, 0, 0); FG_STAGE(FG_SA(1, 1), a1 + hstepA, voffA);
            FG_WAIT_V(8); FG_WAIT_L(0); FG_BAR; FG_MMA(0, 0, At, B0); FG_MMA(0, 1, At, B1); FG_BAR; FG_SCHED;
            FG_LDA(At, 0, 1); FG_STAGE(FG_SB(0, 0), b2, voffB); FG_STAGE(FG_SB(0, 1), b2 + hstepB, voffB); FG_STAGE(FG_SA(0, 0), a2, voffA);
            FG_WAIT_V(8); FG_WAIT_L(0); FG_BAR; FG_MMA(1, 0, At, B0); FG_MMA(1, 1, At, B1); FG_BAR; FG_SCHED;
            FG_LDB(B0, 1, 0); FG_LDB(B1, 1, 1); FG_SCHED; FG_LDA(At, 1, 0); FG_STAGE(FG_SA(0, 1), a2 + hstepA, voffA);
            FG_WAIT_V(8); FG_WAIT_L(0); FG_BAR; FG_MMA(0, 0, At, B0); FG_MMA(0, 1, At, B1); FG_BAR; FG_SCHED;
            FG_LDA(At, 1, 1); FG_STAGE(FG_SB(1, 0), b3, voffB); FG_STAGE(FG_SB(1, 1), b3 + hstepB, voffB); FG_STAGE(FG_SA(1, 0), a3, voffA);
            FG_WAIT_V(8); FG_WAIT_L(0); FG_BAR; FG_MMA(1, 0, At, B0); FG_MMA(1, 1, At, B1); FG_BAR; FG_SCHED;
        }
        if (wr == 0) FG_BAR;
        bool keep_acc = false;
        {
            const auto Ez = E.z(cur.z);
            if constexpr (Epi::CHAIN) keep_acc = (cur.z < 3);
#pragma unroll
            for (int ai = 0; ai < 2; ++ai)
#pragma unroll
                for (int m = 0; m < 4; ++m)
#pragma unroll
                    for (int bj = 0; bj < 2; ++bj) {
                        const int row_ = cur.pm * BM + ai * HALF + wr * 64 + m * 16 + fr, col_ = cur.pn * BM + bj * HALF + wc * 32 + (Epi::PERM ? 8 : 4) * fq;
                        if constexpr (Epi::CHAIN) Ez.chain(row_, col_, acc[ai][bj][m][0], acc[ai][bj][m][1], cur.z);
                        else Ez(row_, col_, acc[ai][bj][m][0], acc[ai][bj][m][1]);
                        if (bj == 1 && (m & 1)) asm volatile("" ::: "memory");
                    }
        }
        if (!has_next) break;
        if (!keep_acc) {
#pragma unroll
        for (int a = 0; a < 2; ++a)
#pragma unroll
            for (int b = 0; b < 2; ++b)
#pragma unroll
                for (int m = 0; m < 4; ++m)
#pragma unroll
                    for (int n = 0; n < 2; ++n) acc[a][b][m][n] = (f32x4){0.f, 0.f, 0.f, 0.f};
        }
        cur = nxt; cA = nA; cB = nB; ++ui;
        if (wr == 1) FG_BAR;
    }
    FG_WAIT_V(0);
    FG_BAR;
#undef FG_SA
#undef FG_SB
#undef FG_STAGE
#undef FG_LDA
#undef FG_LDB
#undef FG_MMA
#undef FG_WAIT_V
#undef FG_WAIT_L
#undef FG_BAR
#undef FG_SCHED
}

struct UnitM { const GAS char* A; const GAS char* B; int lda, ldb, nt, pm, pn, z, job; };
template <class EpiM, class SM>
__device__ __forceinline__ void gemm_multi(LAS unsigned char* lds, const SM& S, const EpiM& E) {
    const int tid = tid_op(), wid = __builtin_amdgcn_readfirstlane(tid >> 6), lane = tid & 63, wr = wid >> 2, wc = wid & 3, fr = lane & 15, fq = lane >> 4;
    int sR[2], sRb[2], sC[2];
#pragma unroll
    for (int i = 0; i < 2; ++i) { stage_rc(tid * 16 + i * 8192, sR[i], sC[i]); sRb[i] = (sR[i] & ~31) + perm32(sR[i] & 31); }
    const size_t kstep = (size_t)(BK * 2);
    const unsigned ldsw = (unsigned)wid * 1024u;
    const int aoff = lds_byte(wr * 64 + fr, fq * 8), boff = lds_byte(wc * 32 + fr, fq * 8);
#define FG_SA(b, h) (((b) * 2 + (h)) * HTB)
#define FG_SB(b, h) ((4 + (b) * 2 + (h)) * HTB)
#define FG_STAGE(bufoff, gbase, voff) do { _Pragma("unroll") for (int _i = 0; _i < 2; ++_i) \
        __builtin_amdgcn_global_load_lds((const GAS unsigned*)((const GAS char*)(gbase) + (voff)[_i]), (LAS unsigned*)(lds + (bufoff) + ldsw + _i * 8192), 16, 0, 0); } while (0)
#define FG_LDA(dst, b, h) do { _Pragma("unroll") for (int m = 0; m < 4; ++m) _Pragma("unroll") for (int k = 0; k < 2; ++k) dst[m][k] = *(const LAS bf16x8*)(lds + FG_SA(b, h) + aoff + m * 2048 + k * 1024); } while (0)
#define FG_LDB(dst, b, h) do { _Pragma("unroll") for (int n = 0; n < 2; ++n) _Pragma("unroll") for (int k = 0; k < 2; ++k) dst[n][k] = *(const LAS bf16x8*)(lds + FG_SB(b, h) + boff + n * 2048 + k * 1024); } while (0)
#define FG_MMA(ai, bj, At, Bt) do { __builtin_amdgcn_s_setprio(1); _Pragma("unroll") for (int m = 0; m < 4; ++m) _Pragma("unroll") for (int n = 0; n < 2; ++n) _Pragma("unroll") for (int k = 0; k < 2; ++k) \
        acc[ai][bj][m][n] = __builtin_amdgcn_mfma_f32_16x16x32_bf16(Bt[n][k], At[m][k], acc[ai][bj][m][n], 0, 0, 0); __builtin_amdgcn_s_setprio(0); } while (0)
#define FG_WAIT_V(n) asm volatile("s_waitcnt vmcnt(" #n ")" ::: "memory")
#define FG_WAIT_L(n) asm volatile("s_waitcnt lgkmcnt(" #n ")" ::: "memory")
#define FG_BAR __builtin_amdgcn_s_barrier()
#define FG_SCHED __builtin_amdgcn_sched_barrier(0)
#define FG_OFFS(u, vA, vB, hA, hB) do { _Pragma("unroll") for (int _i = 0; _i < 2; ++_i) { vA[_i] = (unsigned)(sR[_i] * (u).lda + sC[_i]) * 2u; vB[_i] = (unsigned)(sRb[_i] * (u).ldb + sC[_i]) * 2u; } \
        hA = (size_t)HALF * (u).lda * 2; hB = (size_t)HALF * (u).ldb * 2; } while (0)
    UnitM cur, nxt; int ui = 0;
    if (!S.next(0, cur)) return;
    unsigned vAc[2], vBc[2], vAn[2], vBn[2]; size_t hAc, hBc, hAn, hBn;
    FG_OFFS(cur, vAc, vBc, hAc, hBc);
    f32x4 acc[2][2][4][2];
#pragma unroll
    for (int a = 0; a < 2; ++a)
#pragma unroll
        for (int b = 0; b < 2; ++b)
#pragma unroll
            for (int m = 0; m < 4; ++m)
#pragma unroll
                for (int n = 0; n < 2; ++n) acc[a][b][m][n] = (f32x4){0.f, 0.f, 0.f, 0.f};
    bf16x8 At[4][2], B0[2][2], B1[2][2];
    const GAS char* cA = cur.A; const GAS char* cB = cur.B;
    FG_STAGE(FG_SB(0, 0), cB, vBc); FG_STAGE(FG_SB(0, 1), cB + hBc, vBc); FG_STAGE(FG_SA(0, 0), cA, vAc); FG_STAGE(FG_SA(0, 1), cA + hAc, vAc);
    if (wr == 1) FG_BAR;
    FG_WAIT_V(2); FG_BAR;
    FG_STAGE(FG_SB(1, 0), cB + kstep, vBc); FG_STAGE(FG_SA(1, 0), cA + kstep, vAc); FG_STAGE(FG_SB(1, 1), cB + hBc + kstep, vBc);
    FG_WAIT_V(6); FG_BAR;
    for (;;) {
        const bool has_next = S.next(ui + 1, nxt);
        if (!has_next) nxt = cur;
        FG_OFFS(nxt, vAn, vBn, hAn, hBn);
        const GAS char* nA = nxt.A; const GAS char* nB = nxt.B;
        const int nt = cur.nt;
        for (int t = 0; t < nt; t += 2) {
            const bool last = (t == nt - 2);
            const GAS char* a1 = cA + (size_t)(t + 1) * kstep;
            const GAS char* a2 = last ? nA : cA + (size_t)(t + 2) * kstep; const GAS char* b2 = last ? nB : cB + (size_t)(t + 2) * kstep;
            const GAS char* a3 = a2 + kstep; const GAS char* b3 = b2 + kstep;
            unsigned vA2[2], vB2[2];
#pragma unroll
            for (int _i = 0; _i < 2; ++_i) { vA2[_i] = last ? vAn[_i] : vAc[_i]; vB2[_i] = last ? vBn[_i] : vBc[_i]; }
            const size_t hA2 = last ? hAn : hAc, hB2 = last ? hBn : hBc;
            FG_LDB(B0, 0, 0); FG_LDB(B1, 0, 1); FG_SCHED; FG_LDA(At, 0, 0); FG_STAGE(FG_SA(1, 1), a1 + hAc, vAc);
            FG_WAIT_V(8); FG_WAIT_L(0); FG_BAR; FG_MMA(0, 0, At, B0); FG_MMA(0, 1, At, B1); FG_BAR; FG_SCHED;
            FG_LDA(At, 0, 1); FG_STAGE(FG_SB(0, 0), b2, vB2); FG_STAGE(FG_SB(0, 1), b2 + hB2, vB2); FG_STAGE(FG_SA(0, 0), a2, vA2);
            FG_WAIT_V(8); FG_WAIT_L(0); FG_BAR; FG_MMA(1, 0, At, B0); FG_MMA(1, 1, At, B1); FG_BAR; FG_SCHED;
            FG_LDB(B0, 1, 0); FG_LDB(B1, 1, 1); FG_SCHED; FG_LDA(At, 1, 0); FG_STAGE(FG_SA(0, 1), a2 + hA2, vA2);
            FG_WAIT_V(8); FG_WAIT_L(0); FG_BAR; FG_MMA(0, 0, At, B0); FG_MMA(0, 1, At, B1); FG_BAR; FG_SCHED;
            FG_LDA(At, 1, 1); FG_STAGE(FG_SB(1, 0), b3, vB2); FG_STAGE(FG_SB(1, 1), b3 + hB2, vB2); FG_STAGE(FG_SA(1, 0), a3, vA2);
            FG_WAIT_V(8); FG_WAIT_L(0); FG_BAR; FG_MMA(1, 0, At, B0); FG_MMA(1, 1, At, B1); FG_BAR; FG_SCHED;
        }
        if (wr == 0) FG_BAR;
#pragma unroll
        for (int ai = 0; ai < 2; ++ai)
#pragma unroll
            for (int m = 0; m < 4; ++m)
#pragma unroll
                for (int bj = 0; bj < 2; ++bj) {
                    E.apply(cur, cur.pm * BM + ai * HALF + wr * 64 + m * 16 + fr, cur.pn * BM + bj * HALF + wc * 32 + 8 * fq, acc[ai][bj][m][0], acc[ai][bj][m][1]);
                    if (bj == 1 && (m & 1)) asm volatile("" ::: "memory");
                }
        if (!has_next) break;
#pragma unroll
        for (int a = 0; a < 2; ++a)
#pragma unroll
            for (int b = 0; b < 2; ++b)
#pragma unroll
                for (int m = 0; m < 4; ++m)
#pragma unroll
                    for (int n = 0; n < 2; ++n) acc[a][b][m][n] = (f32x4){0.f, 0.f, 0.f, 0.f};
        cur = nxt; cA = nA; cB = nB; ++ui;
#pragma unroll
        for (int _i = 0; _i < 2; ++_i) { vAc[_i] = vAn[_i]; vBc[_i] = vBn[_i]; }
        hAc = hAn; hBc = hBn;
        if (wr == 1) FG_BAR;
    }
    FG_WAIT_V(0);
    FG_BAR;
#undef FG_SA
#undef FG_SB
#undef FG_STAGE
#undef FG_LDA
#undef FG_LDB
#undef FG_MMA
#undef FG_WAIT_V
#undef FG_WAIT_L
#undef FG_BAR
#undef FG_SCHED
#undef FG_OFFS
}
struct SchedBranch { const gbf* AB; const gbf* WpT; int nM, nN, G, c, pm0;
    __device__ __forceinline__ bool next(int i, Unit& u) const {
        const int nwg = nM * nN; const long L = (long)(i >> 2) * G + c; if (L >= nwg) return false;
        int wgid = (int)L; { const int q = nwg / NXCD, r = nwg % NXCD, xcd = wgid % NXCD, off = wgid / NXCD; wgid = (xcd < r ? xcd * (q + 1) : r * (q + 1) + (xcd - r) * q) + off; }
        const int nig = WGM * nN, gidx = wgid / nig, fm = gidx * WGM, gsz = (nM - fm) < WGM ? (nM - fm) : WGM;
        u.pm = fm + ((wgid % nig) % gsz); u.pn = (wgid % nig) / gsz; u.z = i & 3;
        u.A = (const GAS char*)(AB + (size_t)(pm0 + u.pm) * BM * ABW + u.z * 1024); u.B = (const GAS char*)(WpT + ((size_t)u.z * 2048 + (size_t)u.pn * BM) * KP1); return true;
    }
};
struct SchedIn0 { const gbf* U; const gbf* WinT; int G, c, i0, i1;
    __device__ __forceinline__ bool next(int i, Unit& u) const {
        const int ii = i + i0; if (ii >= i1) return false;
        const int L = ii * G + c; if (L >= 36 * 80) return false;
        const int xcd = L & 7, off = L >> 3; int t, nNc, pn0;
        if (off < 216) { t = xcd * 216 + off; nNc = 48; pn0 = 0; } else { t = xcd * 144 + (off - 216); nNc = 32; pn0 = 48; }
        const int nig = WGM * nNc, gidx = t / nig, fm = gidx * WGM, gsz = (36 - fm) < WGM ? (36 - fm) : WGM;
        u.pm = fm + ((t % nig) % gsz); u.pn = pn0 + (t % nig) / gsz; u.z = 0;
        u.A = (const GAS char*)(U + (size_t)u.pm * BM * KP2); u.B = (const GAS char*)(WinT + (size_t)u.pn * BM * KP2); return true;
    }
};
struct MapPlain { const gbf* A; int lda; const gbf* Bt; int ldb;
    __device__ __forceinline__ const gbf* a(int, int pm) const { return A + (size_t)pm * BM * lda; }
    __device__ __forceinline__ const gbf* b(int, int pn) const { return Bt + (size_t)pn * BM * ldb; } };
}

template <class Epi>
__device__ __forceinline__ void gemm_fast_plain(unsigned char* lds, const GemmJob j, const Epi& E, int gid, int G) {
    __syncthreads();
    fg::Sched<fg::MapPlain> S{fg::MapPlain{j.A, j.lda, j.Bt, j.ldb}, j.M / 256, j.N / 256, 1, G, gid};
    fg::gemm((LAS unsigned char*)lds, j.lda, j.ldb, j.K, S, E);
    __syncthreads();
}

struct MapF1 { const gbf* DC; const gbf* Pfv; int zrows;
    __device__ __forceinline__ const gbf* a(int, int pm) const { return DC + (size_t)pm * 256 * 256; }
    __device__ __forceinline__ const gbf* b(int z, int pn) const { return Pfv + ((size_t)(z >> 2) * zrows + (size_t)pn * 256) * PP + (z & 3) * 256; } };
struct MapF2 { const gbf* DN; const gbf* GT; int ld;
    __device__ __forceinline__ const gbf* a(int, int pm) const { return DN + (size_t)pm * 256 * ld; }
    __device__ __forceinline__ const gbf* b(int z, int pn) const { return GT + ((size_t)z * 1024 + (size_t)pn * 256) * ld; } };
template <class Map, class Epi>
__device__ __forceinline__ void gemm_fast_z(unsigned char* lds, const Map& map, int lda, int ldb, int K, int nM, int nN, int nz, const Epi& E, int c, int Gs) {
    __syncthreads();
    if (c >= 0) { fg::Sched<Map> S{map, nM, nN, nz, Gs, c}; fg::gemm((LAS unsigned char*)lds, lda, ldb, K, S, E); }
    __syncthreads();
}

template <class Epi>
__device__ __forceinline__ void gemm_run(unsigned char* lds, const GemmJob j, const Epi& E, int first, int stride) {
    gemm_fast_plain(lds, j, E, first, stride);
}

struct EpiInProj {
    static constexpr bool PERM = true, CHAIN = false;
    gbf* P; int row0; gbf* NK; gbf* NV; gbf* NQ; gbf* MG;
    __device__ __forceinline__ EpiInProj z(int) const { return *this; }
    __device__ __forceinline__ void operator()(int row, int col, f32x4 a, f32x4 b) const {
        if (col >= C_MG) {
#pragma unroll
            for (int i = 0; i < 4; ++i) { a[i] = sigmoidf_(fminf(fmaxf(a[i], -30.f), 30.f)); b[i] = sigmoidf_(fminf(fmaxf(b[i], -30.f), 30.f)); }
        } else if (col >= C_GCV) {
#pragma unroll
            for (int i = 0; i < 4; ++i) { a[i] = siluf_(a[i]); b[i] = siluf_(b[i]); }
        } else if (col >= C_NAQ && col < C_CB) { a = a * NASCALE; b = b * NASCALE; }
        const int r = row0 + row;
        if (col >= C_MG) { const int cc = col - C_MG; __builtin_nontemporal_store(pk8(a, b), (GAS u32x4*)(MG + mg_off(cc >> 11, r, cc & 2047))); }
        else if (col >= C_NAK && col < C_CB && !(col >= C_QL && col < C_NAQ)) {
            const int sel = (col < C_NAV) ? 0 : (col < C_QL) ? 1 : 2, cc = (col < C_NAV) ? col - C_NAK : (col < C_QL) ? col - C_NAV : col - C_NAQ;
            __builtin_nontemporal_store(pk8(a, b), (GAS u32x4*)(NK + (size_t)sel * ((WS_NV - WS_NK) / 2) + hm_row(r, cc >> 6, 16) * 64 + (cc & 63)));
        } else __builtin_nontemporal_store(pk8(a, b), (GAS u32x4*)(P + (size_t)r * PP + col));
    }
};
struct EpiInProjC1 {
    static constexpr bool PERM = true, CHAIN = false;
    gbf* P; gbf* NK; gbf* KM; gf32* SSQ;
    __device__ __forceinline__ EpiInProjC1 z(int) const { return *this; }
    __device__ __forceinline__ void operator()(int row, int col, f32x4 a, f32x4 b) const {
        const int r = NLAT + row;
        if (col < 256) {
            *(GAS u32x4*)(P + (size_t)r * PP + col) = pk8(a, b);
            float s = a[0] * a[0] + a[1] * a[1] + a[2] * a[2] + a[3] * a[3] + b[0] * b[0] + b[1] * b[1] + b[2] * b[2] + b[3] * b[3];
            s += __shfl_xor(s, 16); s += __shfl_xor(s, 32);
            if ((col & 31) == 0) SSQ[(size_t)row * 8 + (col >> 5)] = s;
        } else if (col < 512) {
            if (col < 320) { const u32x4 v = pk8(a, b);
#pragma unroll
                for (int h = 0; h < 8; ++h) *(GAS u32x4*)(KM + hm_row(r, h, 8) * 192 + 128 + (col - 256)) = v; }
        } else {
            const int sel = (col < C_NAV) ? 0 : 1, cc = (col < C_NAV) ? col - C_NAK : col - C_NAV;
            *(GAS u32x4*)(NK + (size_t)sel * ((WS_NV - WS_NK) / 2) + hm_row(r, cc >> 6, 16) * 64 + (cc & 63)) = pk8(a, b);
        }
    }
};
struct EpiKvUp {
    static constexpr bool PERM = true, CHAIN = false;
    gbf* KM; gbf* VM; const gf32* rstd; int row0;
    __device__ __forceinline__ EpiKvUp z(int) const { return *this; }
    __device__ __forceinline__ void operator()(int row, int col, f32x4 a, f32x4 b) const {
        const int r = row0 + row, h = col >> 8, jj = col & 255; const float s = rstd[r];
        const size_t hr = hm_row(r, h, 8); gbf* p = (jj < 128) ? KM + hr * 192 + jj : VM + hr * 128 + (jj - 128);
        *(GAS u32x4*)p = pk8(a * s, b * s);
    }
};
struct EpiQUp {
    static constexpr bool PERM = false, CHAIN = false;
    gbf* QM; const gf32* rstd; const gf32* rope; int row0;
    __device__ __forceinline__ EpiQUp z(int) const { return *this; }
    __device__ __forceinline__ void operator()(int row, int col, f32x4 a, f32x4 b) const {
        const int r = row0 + row, h = col / 192, jj = col - h * 192; const float s = rstd[r] * QSCALE;
        a = a * s; b = b * s;
        if (jj >= 128 && r < NLAT) {
            const int t = r & (SEQ - 1), e = jj - 128, pos = (e < 32) ? (t >> 6) : (t & 63), f0 = e & 15;
            const gf32* rp = rope + (pos * 16 + f0) * 2;
#pragma unroll
            for (int i = 0; i < 4; ++i) { const float c = rp[2 * i], sn = rp[2 * i + 1]; const float x = a[i], y = b[i]; a[i] = x * c - y * sn; b[i] = x * sn + y * c; }
        }
        gbf* p = QM + hm_row(r, h, 8) * 192 + jj;
        *(GAS u32x2*)p = pk4(a); *(GAS u32x2*)(p + 16) = pk4(b);
    }
};
struct EpiF1 {
    static constexpr bool PERM = true, CHAIN = false;
    gbf* GT; int S; int g;
    __device__ __forceinline__ EpiF1 z(int zz) const { return EpiF1{GT + (size_t)(zz >> 2) * 1024 * 2 * S, S, zz & 3}; }
    __device__ __forceinline__ void operator()(int row, int col, f32x4 a, f32x4 b) const {
        *(GAS u32x4*)(GT + (size_t)(g * 256 + (row & 255)) * (2 * S) + (row >> 8) * S + col) = pk8(a, b);
    }
};
struct EpiF2 {
    static constexpr bool PERM = true, CHAIN = false;
    gbf* AB; const gbf* P; int row0; int zrows;
    __device__ __forceinline__ EpiF2 z(int zz) const { return EpiF2{AB, P, row0 + zz * zrows, zrows}; }
    __device__ __forceinline__ void operator()(int row, int col, f32x4 a, f32x4 b) const {
        const size_t r = (size_t)(row0 + row);
        f32x4 ga, gb; unpk8(*(const GAS u32x4*)(P + r * PP + C_GFN + col), ga, gb);
        *(GAS u32x4*)(AB + r * ABW + 3072 + col) = pk8(a * ga, b * gb);
    }
};
struct EpiBranch {
    static constexpr bool PERM = true, CHAIN = false;
    gf32* MF; gbf* MB; const gbf* P; int i; int row0;
    __device__ __forceinline__ EpiBranch z(int) const { return *this; }
    __device__ __forceinline__ void operator()(int row, int col, f32x4 a, f32x4 b) const {
        const size_t r = (size_t)(row0 + row);
        f32x4 ga, gb; unpk8(*(const GAS u32x4*)(P + r * PP + C_MG + i * DM + col), ga, gb);
        gf32* m = MF + r * DM + col;
        f32x4 va = a * ga, vb = b * gb;
        if (i > 0) { va += *(const GAS f32x4*)m; vb += *(const GAS f32x4*)(m + 4); }
        if (i < 3) { *(GAS f32x4*)m = va; *(GAS f32x4*)(m + 4) = vb; }
        else *(GAS u32x4*)(MB + r * DM + col) = pk8(va, vb);
    }
};
struct EpiChain {
    static constexpr bool PERM = true, CHAIN = true;
    gbf* MB; const gbf* P; int row0;
    __device__ __forceinline__ EpiChain z(int) const { return *this; }
    __device__ __forceinline__ void chain(int row, int col, f32x4& a, f32x4& b, int zz) const {
        const size_t r = (size_t)(row0 + row);
        if (zz < 3) {
            f32x4 ga, gb, ha, hb; unpk8(__builtin_nontemporal_load((const GAS u32x4*)(P + mg_off(zz, (int)r, col))), ga, gb); unpk8(__builtin_nontemporal_load((const GAS u32x4*)(P + mg_off(zz + 1, (int)r, col))), ha, hb);
#pragma unroll
            for (int i = 0; i < 4; ++i) { a[i] *= ga[i] * __builtin_amdgcn_rcpf(ha[i]); b[i] *= gb[i] * __builtin_amdgcn_rcpf(hb[i]); }
        } else {
            f32x4 ga, gb; unpk8(__builtin_nontemporal_load((const GAS u32x4*)(P + mg_off(3, (int)r, col))), ga, gb);
            *(GAS u32x4*)(MB + r * KP2 + col) = pk8(a * ga, b * gb);
        }
    }
};
struct EpiOut {
    static constexpr bool PERM = true, CHAIN = false;
    gf32* Y; int row0;
    __device__ __forceinline__ EpiOut z(int) const { return *this; }
    __device__ __forceinline__ void operator()(int row, int col, f32x4 a, f32x4 b) const {
        gf32* p = Y + (size_t)(row0 + row) * DM + col; *(GAS f32x4*)p = a; *(GAS f32x4*)(p + 4) = b;
    }
};

struct EpiC2 {
    gbf* KM; gbf* VM; gbf* QM; gbf* GT; gbf* GTC; const gf32* RKV; const gf32* RQ; const gf32* rope; const gf32* SSQ;
    __device__ __forceinline__ void apply(const fg::UnitM& u, int row, int col, f32x4 a, f32x4 b) const {
        if (u.job == 0) {
            const int h = col >> 8, jj = col & 255; float s;
            if (SSQ != nullptr && row >= NLAT) { const f32x4 s0 = *(const GAS f32x4*)(SSQ + (size_t)(row - NLAT) * 8), s1 = *(const GAS f32x4*)(SSQ + (size_t)(row - NLAT) * 8 + 4);
                s = rsqrtf(((s0[0] + s0[1]) + (s0[2] + s0[3]) + (s1[0] + s1[1]) + (s1[2] + s1[3])) * (1.0f / 256.0f) + EPS); }
            else s = RKV[row];
            const size_t hr = hm_row(row, h, 8); gbf* p = (jj < 128) ? KM + hr * 192 + jj : VM + hr * 128 + (jj - 128);
            *(GAS u32x4*)p = pk8(a * s, b * s);
        } else if (u.job == 1) {
            const int h = col / 192, jj = col - h * 192; const float s = RQ[row] * QSCALE;
            a = a * s; b = b * s;
            if (jj >= 128 && row < NLAT) {
                const int t = row & (SEQ - 1), e = jj - 128, pos = (e < 32) ? (t >> 6) : (t & 63), f0 = e & 15; const bool second = (e & 16) != 0;
                const gf32* rp = rope + (pos * 16 + f0) * 2;
                const f32x4 cs0 = *(const GAS f32x4*)rp, cs1 = *(const GAS f32x4*)(rp + 4), cs2 = *(const GAS f32x4*)(rp + 8), cs3 = *(const GAS f32x4*)(rp + 12);
                const float cc[8] = {cs0[0], cs0[2], cs1[0], cs1[2], cs2[0], cs2[2], cs3[0], cs3[2]}, ss[8] = {cs0[1], cs0[3], cs1[1], cs1[3], cs2[1], cs2[3], cs3[1], cs3[3]};
#pragma unroll
                for (int i = 0; i < 4; ++i) { const float ya = __shfl_xor(a[i], 32), yb = __shfl_xor(b[i], 32);
                    a[i] = second ? (ya * ss[i] + a[i] * cc[i]) : (a[i] * cc[i] - ya * ss[i]);
                    b[i] = second ? (yb * ss[4 + i] + b[i] * cc[4 + i]) : (b[i] * cc[4 + i] - yb * ss[4 + i]); }
            }
            *(GAS u32x4*)(QM + hm_row(row, h, 8) * 192 + jj) = pk8(a, b);
        } else {
            const int S_ = (u.job == 2) ? SEQ : CTXL, ld_ = (u.job == 2) ? KP4 : 2 * CTXL; gbf* G_ = (u.job == 2) ? GT : GTC; const int bb = u.z >> 2, g = u.z & 3;
            *(GAS u32x4*)(G_ + (size_t)bb * 1024 * ld_ + (size_t)(g * 256 + (row & 255)) * ld_ + (row >> 8) * S_ + col) = pk8(a, b);
        }
    }
};
struct SchedC2 {
    const gbf* P; const gbf* WukvT; const gbf* WuqT; const gbf* DC; int nq_tiles, n3, G, c;
    __device__ __forceinline__ bool next(int i, fg::UnitM& u) const {
        int L = i * G + c; const int n0 = (NROW / 256) * 8, n1 = nq_tiles * 6, n2 = 16 * 2 * 8;
        if (L < n0) { u.job = 0; u.pm = L >> 3; u.pn = L & 7; u.z = 0; u.lda = PP; u.ldb = 256; u.nt = 4;
            u.A = (const GAS char*)(P + (size_t)u.pm * 256 * PP + C_CKV); u.B = (const GAS char*)(WukvT + (size_t)u.pn * 256 * 256); return true; }
        L -= n0;
        if (L < n1) { u.job = 1; u.pm = L / 6; u.pn = L % 6; u.z = 0; u.lda = PP; u.ldb = 512; u.nt = 8;
            u.A = (const GAS char*)(P + (size_t)u.pm * 256 * PP + C_QL); u.B = (const GAS char*)(WuqT + (size_t)u.pn * 256 * 512); return true; }
        L -= n1;
        if (L < n2) { u.job = 2; u.z = L >> 4; u.pm = (L >> 3) & 1; u.pn = L & 7; u.lda = 256; u.ldb = PP; u.nt = 4;
            u.A = (const GAS char*)(DC + (size_t)u.pm * 256 * 256); u.B = (const GAS char*)(P + ((size_t)(u.z >> 2) * SEQ + (size_t)u.pn * 256) * PP + C_FV + (u.z & 3) * 256); return true; }
        L -= n2;
        if (L < n3) { u.job = 3; u.z = L >> 1; u.pm = L & 1; u.pn = 0; u.lda = 256; u.ldb = PP; u.nt = 4;
            u.A = (const GAS char*)(DC + (size_t)u.pm * 256 * 256); u.B = (const GAS char*)(P + ((size_t)NLAT + (size_t)(u.z >> 2) * CTXL) * PP + C_FV + (u.z & 3) * 256); return true; }
        return false;
    }
};

struct TrItem { const gf32* W; gbf* WT; const gf32* ks; int N, ldt, k0, n0, nd0; };
constexpr int TR_IN = 32 * 634, TR_KV = 4 * 64, TR_Q = 8 * 48, TR_P = 16 * 64, TR_O = 32 * 64;
constexpr int TR_PER_L = TR_IN + TR_KV + TR_Q + 4 * TR_P + TR_O;
__device__ __forceinline__ TrItem tr_decode(int it) {
    gu8* ws = wsb();
    const int l = it / TR_PER_L; int r = it % TR_PER_L;
    const gf32* W; gbf* WT; const gf32* ks = nullptr; int K, N, ldt; bool remap = false;
    if (r < TR_IN) { W = pin(I_WIN) + (size_t)l * DM * N_IN; K = DM; N = N_IN; WT = (gbf*)(ws + WS_WIN) + (size_t)l * NP * KP2; ldt = KP2; remap = true; }
    else if ((r -= TR_IN) < TR_KV) { W = pin(I_WUKV) + (size_t)l * 256 * 2048; K = 256; N = 2048; WT = (gbf*)(ws + WS_WUKV) + (size_t)l * 2048 * 256; ldt = 256; ks = pin(I_GKV) + l * 256; }
    else if ((r -= TR_KV) < TR_Q) { W = pin(I_WUQ) + (size_t)l * 512 * 1536; K = 512; N = 1536; WT = (gbf*)(ws + WS_WUQ) + (size_t)l * 1536 * 512; ldt = 512; ks = pin(I_GQ) + l * 512; }
    else if ((r -= TR_Q) < 4 * TR_P) { const int b = r / TR_P; r = r % TR_P; W = pin(I_WPC + b) + (size_t)l * 1024 * 2048; K = 1024; N = 2048; WT = (gbf*)(ws + WS_WP) + ((size_t)l * 4 + b) * 2048 * KP1; ldt = KP1; }
    else { r -= 4 * TR_P; W = pin(I_WOUT) + (size_t)l * 2048 * 2048; K = 2048; N = 2048; WT = (gbf*)(ws + WS_WO) + (size_t)l * 2048 * KP2; ldt = KP2; }
    (void)K;
    const int nblk = N / 32, kb = r / nblk, nb = r % nblk, n0 = 32 * nb;
    return TrItem{W, WT, ks, N, ldt, 64 * kb, n0, (remap && n0 >= 320) ? n0 + 192 : n0};
}
__device__ __forceinline__ void tr_load(const TrItem& t, float (&v)[32], int lane) {
    const gf32* src = t.W + (size_t)(t.k0 + (lane >> 5)) * t.N + t.n0 + (lane & 31);
#pragma unroll
    for (int i = 0; i < 32; ++i) v[i] = __builtin_nontemporal_load(src + (size_t)(2 * i) * t.N);
}
__device__ __forceinline__ void tr_to_lds(const TrItem& t, const float (&v)[32], int lane, float* scr) {
    if (t.ks != nullptr) {
#pragma unroll
        for (int i = 0; i < 32; ++i) { const int kk = 2 * i + (lane >> 5); scr[kk * 33 + (lane & 31)] = v[i] * t.ks[t.k0 + kk]; }
    } else {
#pragma unroll
        for (int i = 0; i < 32; ++i) { const int kk = 2 * i + (lane >> 5); scr[kk * 33 + (lane & 31)] = v[i]; }
    }
    __builtin_amdgcn_fence(__ATOMIC_RELEASE, "wavefront"); asm volatile("s_waitcnt lgkmcnt(0)" ::: "memory");
}
__device__ __forceinline__ void tr_store(const TrItem& t, int lane, const float* scr) {
    const int c = lane & 7;
#pragma unroll
    for (int j = 0; j < 4; ++j) { const int n = (lane >> 3) + 8 * j; const float* s = scr + (8 * c) * 33 + n;
        u32x4 o; o.x = pk2(s[0 * 33], s[1 * 33]); o.y = pk2(s[2 * 33], s[3 * 33]); o.z = pk2(s[4 * 33], s[5 * 33]); o.w = pk2(s[6 * 33], s[7 * 33]);
        __builtin_nontemporal_store(o, (GAS u32x4*)(t.WT + (size_t)(t.nd0 + n) * t.ldt + t.k0 + 8 * c)); }
    asm volatile("s_waitcnt lgkmcnt(0)" ::: "memory");
}
__device__ __forceinline__ void weight_transposes(unsigned char* lds, int beg, int end, int gw, int ngw) {
    const int tid = tid_op(), lane = tid & 63, wid = tid >> 6;
    float* scr = (float*)lds + wid * (64 * 33);
    int it = beg + gw;
    if (it >= end) return;
    float v[32];
    TrItem cur = tr_decode(it);
    tr_load(cur, v, lane);
    while (true) {
        tr_to_lds(cur, v, lane, scr);
        const int nit = it + ngw; const bool more = nit < end;
        TrItem nx = cur;
        if (more) { nx = tr_decode(nit); tr_load(nx, v, lane); }
        tr_store(cur, lane, scr);
        if (!more) break;
        cur = nx; it = nit;
    }
}

__device__ __forceinline__ void phase0(const Params& p, unsigned char* lds, int gid, int G) {
    const int tid = tid_op(), lane = tid & 63, wid = tid >> 6;
    gu8* ws = wsb();
    {
        float* sv = (float*)lds;
        float* part = sv + 5 * 2048;
        bool have = false;
        for (int it = gid; it < 2 * 96; it += G) {
            if (!have) {
                for (int i = tid; i < 5 * 2048; i += NTHREADS) { const float v = (i < 4 * 2048) ? pin(I_C)[i] : pin(I_CCTX)[i - 4 * 2048]; sv[i] = siluf_(v); }
                have = true;
            }
            __syncthreads();
            const int l = it / 96, nb = it % 96;
            const gf32* W = pin(I_WADA) + (size_t)l * DM * 6144 + nb * 64 + lane;
            float a0 = 0.f, a1 = 0.f, a2 = 0.f, a3 = 0.f, a4 = 0.f;
#pragma unroll 8
            for (int k = wid * 256; k < wid * 256 + 256; ++k) {
                const float w = W[(size_t)k * 6144];
                a0 = fmaf(sv[k], w, a0); a1 = fmaf(sv[2048 + k], w, a1); a2 = fmaf(sv[4096 + k], w, a2); a3 = fmaf(sv[6144 + k], w, a3); a4 = fmaf(sv[8192 + k], w, a4);
            }
            part[(wid * 5 + 0) * 64 + lane] = a0; part[(wid * 5 + 1) * 64 + lane] = a1; part[(wid * 5 + 2) * 64 + lane] = a2; part[(wid * 5 + 3) * 64 + lane] = a3; part[(wid * 5 + 4) * 64 + lane] = a4;
            __syncthreads();
            if (tid < 320) {
                const int r = tid / 64, cidx = tid % 64; float s = 0.f;
#pragma unroll
                for (int w = 0; w < 8; ++w) s += part[(w * 5 + r) * 64 + cidx];
                const int n = nb * 64 + cidx;
                ((gf32*)(ws + WS_MOD))[((size_t)l * 5 + r) * 6144 + n] = s + pin(I_BADA)[(size_t)l * 6144 + n];
            }
        }
        __syncthreads();
    }
    {
        const long gt = (long)gid * NTHREADS + tid, NT = (long)G * NTHREADS;
        gf32* rope = (gf32*)(ws + WS_ROPE);
        for (long i = gt; i < 64 * 16; i += NT) { const int pos = (int)(i >> 4), f = (int)(i & 15); const float inv = exp2f(-(float)f * (13.287712379549449f / 16.0f)); const float ang = (float)pos * inv;
            rope[2 * i] = cosf(ang); rope[2 * i + 1] = sinf(ang); }
        gbf* DC = (gbf*)(ws + WS_DC);
        for (long i = gt; i < 512 * 256; i += NT) { const int m = (int)(i >> 8), k = (int)(i & 255); const int jdx = ((m & 255) * k) & 255; const float ang = (float)jdx * (6.283185307179586f / 256.0f);
            DC[i] = (bf16_t)f2bf((m < 256 ? cosf(ang) : sinf(ang)) * 0.0625f); }
        gbf* DN = (gbf*)(ws + WS_DN);
        for (long i = gt; i < (long)2048 * 4096; i += NT) { const int n = (int)(i >> 12), k = (int)(i & 4095); const int jdx = (n * (k & 2047)) & 2047; const float ang = (float)jdx * (6.283185307179586f / 2048.0f);
            DN[(size_t)n * KP4 + k] = (bf16_t)f2bf((k < 2048 ? cosf(ang) : -sinf(ang)) * 0.02209708691207961f); }
        gbf* DNC = (gbf*)(ws + WS_DNC);
        for (long i = gt; i < 256 * 512; i += NT) { const int n = (int)(i >> 9), k = (int)(i & 511); const int jdx = (n * (k & 255)) & 255; const float ang = (float)jdx * (6.283185307179586f / 256.0f);
            DNC[i] = (bf16_t)f2bf((k < 256 ? cosf(ang) : -sinf(ang)) * 0.0625f); }
        for (long i = gt; i < (long)2 * 192 * DM / 8; i += NT) { const int l = (int)(i / (192 * DM / 8)); const long r = i % (192 * DM / 8);
            *(GAS u32x4*)((gbf*)(ws + WS_WIN) + (size_t)l * NP * KP2 + (size_t)(320 + r / (DM / 8)) * KP2 + (r % (DM / 8)) * 8) = (u32x4){0u, 0u, 0u, 0u}; }
    }
    weight_transposes(lds, 0, (G == 256) ? TR_PER_L : 2 * TR_PER_L, gid * NWAVES + wid, G * NWAVES);
}

__device__ __forceinline__ void u_row(const f32x4 (&v)[8], float rstd, const gf32* gpre, const gf32* mod  , gbf* urow, int lane) {
#pragma unroll
    for (int j = 0; j < 8; ++j) { const int c = 4 * lane + 256 * j;
        const f32x4 g = *(const GAS f32x4*)(gpre + c), sh = *(const GAS f32x4*)(mod + c), sc = *(const GAS f32x4*)(mod + 2048 + c);
        const f32x4 o = v[j] * rstd * g * (sc + 1.0f) + sh;
        *(GAS u32x2*)(urow + c) = pk4(o); }
}
__device__ __forceinline__ void phase_uprep0(const Params& p, int gid, int G) {
    const int tid = tid_op(), lane = tid & 63, gw = gid * NWAVES + (tid >> 6), NGW = G * NWAVES;
    const gf32* mod0 = (const gf32*)(wsb() + WS_MOD);
    gbf* U = (gbf*)(wsb() + WS_U);
    for (int r = gw; r < NROW; r += NGW) {
        const gf32* xr = (r < NLAT) ? pin(I_X) + (size_t)r * DM : pin(I_CTX) + (size_t)(r - NLAT) * DM;
        const int mr = (r < NLAT) ? (r >> 11) : 4;
        f32x4 v[8]; float s = 0.f;
#pragma unroll
        for (int j = 0; j < 8; ++j) { v[j] = *(const GAS f32x4*)(xr + 4 * lane + 256 * j); s += v[j][0] * v[j][0] + v[j][1] * v[j][1] + v[j][2] * v[j][2] + v[j][3] * v[j][3]; }
        const float rstd = rsqrtf(wave_sum(s) * (1.0f / DM) + EPS);
        u_row(v, rstd, pin(I_GPRE), mod0 + (size_t)mr * 6144, U + (size_t)r * KP2, lane);
    }
}
__device__ __forceinline__ void phase_final(const Params& p, int l, int rbeg, int rend, int cu, int ncu) {
    const int tid = tid_op(), lane = tid & 63, gw = rbeg + cu * NWAVES + (tid >> 6), NGW = ncu * NWAVES;
    const gf32* mod = (const gf32*)(wsb() + WS_MOD) + (size_t)l * 5 * 6144;
    const gf32* Y = (const gf32*)(wsb() + WS_Y);
    gf32* XL = (gf32*)(wsb() + WS_XL);
    gbf* U = (gbf*)(wsb() + WS_U);
    const int nrows = rend;
    auto xrow = [&](int r) -> const gf32* { return (l == 0) ? ((r < NLAT) ? pin(I_X) + (size_t)r * DM : pin(I_CTX) + (size_t)(r - NLAT) * DM) : XL + (size_t)r * DM; };
    f32x4 y[8], x[8], yn[8], xn[8];
    if (gw < nrows) { const gf32* yr = Y + (size_t)gw * DM; const gf32* xr = xrow(gw);
#pragma unroll
        for (int j = 0; j < 8; ++j) { y[j] = *(const GAS f32x4*)(yr + 4 * lane + 256 * j); x[j] = *(const GAS f32x4*)(xr + 4 * lane + 256 * j); } }
    for (int r = gw; r < nrows; r += NGW) {
        const int rn = r + NGW;
        if (rn < nrows) { const gf32* yr = Y + (size_t)rn * DM; const gf32* xr = xrow(rn);
#pragma unroll
            for (int j = 0; j < 8; ++j) { yn[j] = *(const GAS f32x4*)(yr + 4 * lane + 256 * j); xn[j] = *(const GAS f32x4*)(xr + 4 * lane + 256 * j); } }
        const int mr = (r < NLAT) ? (r >> 11) : 4;
        gf32* orow = (l == 0) ? XL + (size_t)r * DM : pout() + (size_t)r * DM;
        float s = 0.f;
#pragma unroll
        for (int j = 0; j < 8; ++j) s += y[j][0] * y[j][0] + y[j][1] * y[j][1] + y[j][2] * y[j][2] + y[j][3] * y[j][3];
        const float rstd = rsqrtf(wave_sum(s) * (1.0f / DM) + EPS);
        float s2 = 0.f;
#pragma unroll
        for (int j = 0; j < 8; ++j) { const int c = 4 * lane + 256 * j;
            const f32x4 g = *(const GAS f32x4*)(pin(I_GPOST) + (size_t)l * DM + c), gt = *(const GAS f32x4*)(mod + (size_t)mr * 6144 + 4096 + c);
            const f32x4 o = x[j] + gt * (y[j] * rstd * g);
            *(GAS f32x4*)(orow + c) = o; y[j] = o; s2 += o[0] * o[0] + o[1] * o[1] + o[2] * o[2] + o[3] * o[3]; }
        if (l == 0) {
            const float rstd2 = rsqrtf(wave_sum(s2) * (1.0f / DM) + EPS);
            u_row(y, rstd2, pin(I_GPRE) + DM, mod + 5 * 6144 + (size_t)mr * 6144, U + (size_t)r * KP2, lane);
        }
#pragma unroll
        for (int j = 0; j < 8; ++j) { y[j] = yn[j]; x[j] = xn[j]; }
    }
}
__device__ __forceinline__ void c1_loadz(const gbf* pr, bool ok, int lane, f32x4 (&z)[4]) {
#pragma unroll
    for (int j = 0; j < 4; ++j) { const int c = 4 * lane + 256 * j;
        if (ok) z[j] = unpk4(*(const GAS u32x2*)(pr + C_CC + c)) * unpk4(*(const GAS u32x2*)(pr + C_CX + c)); else z[j] = (f32x4){0.f, 0.f, 0.f, 0.f}; }
}
__device__ __forceinline__ void phase_c1(const Params& p, int l, int nrows, int gid, int G) {
    const int tid = tid_op(), lane = tid & 63, gw = gid * NWAVES + (tid >> 6), NGW = G * NWAVES;
    const gbf* P = (const gbf*)(wsb() + WS_P);
    gbf* KM = (gbf*)(wsb() + WS_KM); gbf* AB = (gbf*)(wsb() + WS_AB);
    gf32* RKV = (gf32*)(wsb() + WS_RKV); gf32* RQ = (gf32*)(wsb() + WS_RQ);
    const gf32* rope = (const gf32*)(wsb() + WS_ROPE);
    const gf32* cw = pin(I_CONVW) + (size_t)l * 3 * 1024;
    const int chunk = (nrows + NGW - 1) / NGW, rbeg = gw * chunk, rend = min(rbeg + chunk, nrows);
    if (rbeg >= rend) return;
    f32x4 w0[4], w1[4], w2[4];
#pragma unroll
    for (int j = 0; j < 4; ++j) { const int c = 4 * lane + 256 * j; w0[j] = *(const GAS f32x4*)(cw + c); w1[j] = *(const GAS f32x4*)(cw + 1024 + c); w2[j] = *(const GAS f32x4*)(cw + 2048 + c); }
    auto seqpos = [](int r, int& t, int& slen) { if (r < NLAT) { t = r & (SEQ - 1); slen = SEQ; } else { t = (r - NLAT) & (CTXL - 1); slen = CTXL; } };
    f32x4 zp[4], zc[4], zn[4];
    { int t, slen; seqpos(rbeg, t, slen); const bool full0 = (rbeg < NLAT) || (l == 0);
      c1_loadz(P + (size_t)(rbeg - 1) * PP, full0 && t > 0, lane, zp); c1_loadz(P + (size_t)rbeg * PP, full0, lane, zc); (void)slen; }
    for (int r = rbeg; r < rend; ++r) {
        const gbf* pr = P + (size_t)r * PP;
        const bool full = (r < NLAT) || (l == 0);
        int t, slen; seqpos(r, t, slen);
        c1_loadz(pr + PP, (r + 1 < NROW) && ((r + 1 < NLAT) || (l == 0)), lane, zn);
        const float mp = (t > 0) ? 1.f : 0.f, mn = (t < slen - 1) ? 1.f : 0.f;
        const u32x2 ckv = *(const GAS u32x2*)(pr + C_CKV + 4 * lane);
        u32x2 q0 = {0u, 0u}, q1 = {0u, 0u}, cb[4], gc[4];
        if (full) { q0 = *(const GAS u32x2*)(pr + C_QL + 4 * lane); q1 = *(const GAS u32x2*)(pr + C_QL + 256 + 4 * lane);
#pragma unroll
            for (int j = 0; j < 4; ++j) { const int c = 4 * lane + 256 * j; cb[j] = *(const GAS u32x2*)(pr + C_CB + c); gc[j] = *(const GAS u32x2*)(pr + C_GCV + c); } }
        float x = bf2f(pr[C_KR + lane]);
        float rc = 1.f, rsn = 0.f;
        if (r < NLAT) { const int tt = r & (SEQ - 1), pos = (lane < 32) ? (tt >> 6) : (tt & 63), f = lane & 15; rc = rope[(pos * 16 + f) * 2]; rsn = rope[(pos * 16 + f) * 2 + 1]; }
        { const f32x4 v = unpk4(ckv); const float s = wave_sum(v[0] * v[0] + v[1] * v[1] + v[2] * v[2] + v[3] * v[3]);
          if (lane == 0) RKV[r] = rsqrtf(s * (1.0f / 256.0f) + EPS); }
        if (full) { const f32x4 v0 = unpk4(q0), v1 = unpk4(q1);
          const float s = wave_sum(v0[0] * v0[0] + v0[1] * v0[1] + v0[2] * v0[2] + v0[3] * v0[3] + v1[0] * v1[0] + v1[1] * v1[1] + v1[2] * v1[2] + v1[3] * v1[3]);
          if (lane == 0) RQ[r] = rsqrtf(s * (1.0f / 512.0f) + EPS); }
        {
          const float y = __shfl_xor(x, 16);
          x = (lane & 16) ? (y * rsn + x * rc) : (x * rc - y * rsn);
          const bf16_t o = (bf16_t)f2bf(x);
#pragma unroll
          for (int h = 0; h < 8; ++h) KM[hm_row(r, h, 8) * 192 + 128 + lane] = o; }
        if (full) {
#pragma unroll
          for (int j = 0; j < 4; ++j) { const int c = 4 * lane + 256 * j;
              const f32x4 o = (zp[j] * (w0[j] * mp) + zc[j] * w1[j] + zn[j] * (w2[j] * mn)) * unpk4(cb[j]) * unpk4(gc[j]);
              *(GAS u32x2*)(AB + (size_t)r * ABW + c) = pk4(o); } }
#pragma unroll
        for (int j = 0; j < 4; ++j) { zp[j] = zc[j]; zc[j] = zn[j]; }
    }
}

namespace fa {
typedef float f32x16 __attribute__((ext_vector_type(16)));
typedef short s16x4 __attribute__((ext_vector_type(4)));
constexpr float THRL = 8.0f;
__device__ __forceinline__ int crow(int r, int hi) { return (r & 3) + 8 * (r >> 2) + 4 * hi; }
__device__ __forceinline__ unsigned cvtpk(float lo, float hi) { unsigned r; asm volatile("v_cvt_pk_bf16_f32 %0, %1, %2" : "=v"(r) : "v"(lo), "v"(hi)); return r; }
template <int OFF> __device__ __forceinline__ s16x4 tr_read(int vb) { s16x4 r; asm volatile("ds_read_b64_tr_b16 %0, %1 offset:%2" : "=&v"(r) : "v"(vb), "i"(OFF) : "memory"); return r; }
__device__ __forceinline__ int v_rd_base(int lane) { return ((lane & 3) << 3) | (((lane >> 2) & 3) << 6) | (((lane >> 4) & 1) << 5) | (((lane >> 5) & 1) << 8); }
template <int NCB, int D0> __device__ __forceinline__ void pv_one(f32x16& od, int vb, bf16x8 pa0, bf16x8 pa1, bf16x8 pa2, bf16x8 pa3) {
    constexpr int KS = 2 * NCB * 512, HF = NCB * 512, B = D0 * 512;
    const s16x4 l0 = tr_read<B + 0 * KS>(vb), h0 = tr_read<B + 0 * KS + HF>(vb), l1 = tr_read<B + 1 * KS>(vb), h1 = tr_read<B + 1 * KS + HF>(vb);
    const s16x4 l2 = tr_read<B + 2 * KS>(vb), h2 = tr_read<B + 2 * KS + HF>(vb), l3 = tr_read<B + 3 * KS>(vb), h3 = tr_read<B + 3 * KS + HF>(vb);
    asm volatile("s_waitcnt lgkmcnt(0)" ::: "memory"); __builtin_amdgcn_sched_barrier(0);
#define FA_PK(L, H) (bf16x8){L[0], L[1], L[2], L[3], H[0], H[1], H[2], H[3]}
    od = __builtin_amdgcn_mfma_f32_32x32x16_bf16(pa0, FA_PK(l0, h0), od, 0, 0, 0);
    od = __builtin_amdgcn_mfma_f32_32x32x16_bf16(pa1, FA_PK(l1, h1), od, 0, 0, 0);
    od = __builtin_amdgcn_mfma_f32_32x32x16_bf16(pa2, FA_PK(l2, h2), od, 0, 0, 0);
    od = __builtin_amdgcn_mfma_f32_32x32x16_bf16(pa3, FA_PK(l3, h3), od, 0, 0, 0);
#undef FA_PK
}
struct Desc {
    const gbf* Q; int ldq;
    const gbf* K; int ldk;
    const gbf* V; int ldv;
    int row0a, nta, row0b, NT;
    const gbf* G; int ldg;
    gbf* O; int ldo;
    int r0, wr0; const gf32* rpb;
    int hsa, hsb;
};
template <int N> __device__ __forceinline__ void wait_bar() {
    if constexpr (N == 0) asm volatile("s_waitcnt vmcnt(0) lgkmcnt(0)\n\ts_barrier" ::: "memory");
    else if constexpr (N == 2) asm volatile("s_waitcnt vmcnt(2) lgkmcnt(0)\n\ts_barrier" ::: "memory");
    else if constexpr (N == 5) asm volatile("s_waitcnt vmcnt(5) lgkmcnt(0)\n\ts_barrier" ::: "memory");
    else static_assert(N == 0, "wait_bar count");
}
template <int N> __device__ __forceinline__ void wait_bar2() {
    if constexpr (N == 0) asm volatile("s_waitcnt vmcnt(0) lgkmcnt(0)\n\ts_barrier" ::: "memory");
    else if constexpr (N == 1) asm volatile("s_waitcnt vmcnt(1) lgkmcnt(0)\n\ts_barrier" ::: "memory");
    else if constexpr (N == 2) asm volatile("s_waitcnt vmcnt(2) lgkmcnt(0)\n\ts_barrier" ::: "memory");
    else if constexpr (N == 5) asm volatile("s_waitcnt vmcnt(5) lgkmcnt(0)\n\ts_barrier" ::: "memory");
    else static_assert(N == 0, "wait_bar2 count");
}
template <int MODE, unsigned L0 = 0xFFFFu, unsigned L1 = 0xFFFFu> __device__ __forceinline__ void partial_sm(f32x16& p0, f32x16& p1, float& m_reg, float& alpha) {
    if constexpr (MODE == 1) {
#pragma unroll
        for (int r = 0; r < 16; ++r) { p0[r] *= NASCALE; p1[r] *= NASCALE; }
    }
    float pmax = -3.0e38f;
#pragma unroll
    for (int r = 0; r < 16; ++r) if ((L0 >> r) & 1u) pmax = fmaxf(pmax, p0[r]);
#pragma unroll
    for (int r = 0; r < 16; ++r) if ((L1 >> r) & 1u) pmax = fmaxf(pmax, p1[r]);
    { auto rr = __builtin_amdgcn_permlane32_swap(__float_as_uint(pmax), __float_as_uint(pmax), false, false); pmax = fmaxf(__uint_as_float(rr[0]), __uint_as_float(rr[1])); }
    if (__builtin_expect(__all(pmax - m_reg <= THRL), 1)) alpha = 1.f;
    else { const float mn = fmaxf(m_reg, pmax); alpha = __builtin_amdgcn_exp2f(m_reg - mn); m_reg = mn; }
#pragma unroll
    for (int r = 0; r < 16; ++r) { if ((L0 >> r) & 1u) p0[r] = __builtin_amdgcn_exp2f(p0[r] - m_reg); else p0[r] = 0.f; if ((L1 >> r) & 1u) p1[r] -= m_reg; }
}
template <unsigned L0 = 0xFFFFu, unsigned L1 = 0xFFFFu>
__device__ __forceinline__ void finish_sm(f32x16& p0, f32x16& p1, float alpha, float& l_reg, bf16x8& pa0, bf16x8& pa1, bf16x8& pa2, bf16x8& pa3) {
#pragma unroll
    for (int r = 0; r < 16; ++r) { if ((L1 >> r) & 1u) p1[r] = __builtin_amdgcn_exp2f(p1[r]); else p1[r] = 0.f; }
    float ps = 0.f;
#pragma unroll
    for (int r = 0; r < 16; ++r) if ((L0 >> r) & 1u) ps += p0[r];
#pragma unroll
    for (int r = 0; r < 16; ++r) if ((L1 >> r) & 1u) ps += p1[r];
    { auto rr = __builtin_amdgcn_permlane32_swap(__float_as_uint(ps), __float_as_uint(ps), false, false); ps = __uint_as_float(rr[0]) + __uint_as_float(rr[1]); }
    l_reg = l_reg * alpha + ps;
#define FA_PK4(P, BASE, OUT) do { unsigned a0 = cvtpk(P[BASE + 0], P[BASE + 1]), a1 = cvtpk(P[BASE + 2], P[BASE + 3]); \
    unsigned b0_ = cvtpk(P[BASE + 4], P[BASE + 5]), b1_ = cvtpk(P[BASE + 6], P[BASE + 7]); \
    auto r0_ = __builtin_amdgcn_permlane32_swap(a0, b0_, false, false); auto r1_ = __builtin_amdgcn_permlane32_swap(a1, b1_, false, false); \
    u32x4 w_ = {r0_[0], r1_[0], r0_[1], r1_[1]}; OUT = __builtin_bit_cast(bf16x8, w_); } while (0)
    FA_PK4(p0, 0, pa0); FA_PK4(p0, 8, pa1); FA_PK4(p1, 0, pa2); FA_PK4(p1, 8, pa3);
#undef FA_PK4
}
template <unsigned L0, unsigned L1> __device__ __forceinline__ void bias_win(f32x16& p0, f32x16& p1, const LAS float* brow, int cs, int hi) {
#pragma unroll
    for (int r = 0; r < 16; ++r) { const int kc = crow(r, hi);
        if ((L0 >> r) & 1u) p0[r] = ((unsigned)(kc - cs) < 16u) ? p0[r] + brow[kc] : -30000.f;
        if ((L1 >> r) & 1u) p1[r] = ((unsigned)(kc + 32 - cs) < 16u) ? p1[r] + brow[kc + 32] : -30000.f; }
}
template <int N> __device__ __forceinline__ void wait_barn() { asm volatile("s_waitcnt vmcnt(%0) lgkmcnt(0)\n\ts_barrier" :: "n"(N) : "memory"); }
template <int DQK, int DV, int MODE, int S, int NHU = 1>
__device__ __forceinline__ void unit_pipe(LAS unsigned char* lds, const Desc& d) {
    constexpr int RB = DQK * 2, KB1 = 64 * RB, VB1 = 64 * DV * 2, KB = NHU * KB1, VB = NHU * VB1, SLOT = KB + VB, KP = KB / 8192, VP = VB / 8192, NCB = DV / 32, NK = DQK / 16, NPIECE = KP + VP;
    constexpr int DK = S - 1, DVV = S - 2, WSTEADY = DVV * NPIECE;
    static_assert(S >= 2 && WSTEADY < 64 && S * SLOT + 2048 + NHU * 1920 + 16 <= LDS_BYTES && (NHU == 1 || NHU == 4), "ring geometry");
    const int tid = tid_op(), wid = __builtin_amdgcn_readfirstlane(tid >> 6), lane = tid & 63, r32 = lane & 31, hi = lane >> 5;
    const int hl = (NHU > 1) ? (wid >> 1) : 0, wrow0 = (NHU > 1) ? (wid & 1) * 32 : wid * 32;
    LAS float* wsf = (LAS float*)(lds + S * SLOT) + wid * 64;
    LAS float* rpbs = (LAS float*)(lds + S * SLOT + 2048) + hl * 480;
    unsigned koff[KP], voff[VP], koffb[KP], voffb[VP];
#pragma unroll
    for (int i = 0; i < KP; ++i) { const int pp = (wid * KP + i) * 1024 + lane * 16, hh = pp / KB1, p = pp % KB1, row = p / RB, cs = (p % RB) >> 4, c = cs ^ ((row >> 1) & 7);
        koff[i] = (unsigned)((hh * d.hsa + row) * d.ldk + c * 8) * 2u; koffb[i] = (unsigned)(hh * (d.hsb - d.hsa) * d.ldk) * 2u; }
#pragma unroll
    for (int i = 0; i < VP; ++i) { const int pp = (wid * VP + i) * 1024 + lane * 16, hh = pp / VB1, p = pp % VB1, st = p >> 9, q = p & 511, kk = (st / NCB) * 8 + (q >> 6), c = (st % NCB) * 32 + ((q & 63) >> 1);
        const int k = (kk & ~0xC) | ((kk & 4) << 1) | ((kk & 8) >> 1); voff[i] = (unsigned)((hh * d.hsa + k) * d.ldv + c) * 2u; voffb[i] = (unsigned)(hh * (d.hsb - d.hsa) * d.ldv) * 2u; }
    int qr_row = 0, qc = 0, rs = 0, cs = 0;
    if constexpr (MODE == 2) {
        qr_row = d.r0 + ((NHU > 1) ? 0 : (wid >> 1)); qc = (wid & 1) * 32 + r32; rs = min(max(qr_row - 4, 0), 24); cs = min(max(qc - 8, 0), 48);
        for (int i = tid; i < NHU * 15 * 31; i += NTHREADS) ((LAS float*)(lds + S * SLOT + 2048))[(i / 465) * 480 + i % 465] = d.rpb[i] * LOG2E;
    }
#define FP_ACT(t) ((MODE != 2) || (t) >= d.nta || (d.wr0 + (t) >= rs && d.wr0 + (t) <= rs + 7))
#define FP_VAR(t) ((MODE == 2 && (t) < d.nta) ? 1 + (wid & 1) : 0)
#define FP_PSM(P0, P1, al, t, v) do { if ((v) == 0) partial_sm<MODE>(P0, P1, m_reg, al); \
        else { const LAS float* brow_ = rpbs + (d.wr0 + (t) - qr_row + 7) * 31 - qc + 15; \
               if ((v) == 1) { bias_win<0xFFFFu, 0x000Fu>(P0, P1, brow_, cs, hi); partial_sm<MODE, 0xFFFFu, 0x000Fu>(P0, P1, m_reg, al); } \
               else          { bias_win<0xF000u, 0xFFFFu>(P0, P1, brow_, cs, hi); partial_sm<MODE, 0xF000u, 0xFFFFu>(P0, P1, m_reg, al); } } } while (0)
#define FP_FSM(P0, P1, al, v) do { if ((v) == 0) finish_sm(P0, P1, al, l_reg, pa0, pa1, pa2, pa3); else if ((v) == 1) finish_sm<0xFFFFu, 0x000Fu>(P0, P1, al, l_reg, pa0, pa1, pa2, pa3); \
        else finish_sm<0xF000u, 0xFFFFu>(P0, P1, al, l_reg, pa0, pa1, pa2, pa3); } while (0)
#define FP_ROW(t) (((t) < d.nta) ? d.row0a + 64 * (t) : d.row0b + 64 * ((t) - d.nta))
#define FP_DMAK(t) do { const int t_ = (t); const GAS char* kb_ = (const GAS char*)(d.K + (size_t)FP_ROW(t_) * d.ldk); const int s_ = t_ % S; const unsigned sb_ = (t_ < d.nta) ? 0u : 1u; \
        _Pragma("unroll") for (int i_ = 0; i_ < KP; ++i_) __builtin_amdgcn_global_load_lds((const GAS unsigned*)(kb_ + (koff[i_] + sb_ * koffb[i_])), (LAS unsigned*)(lds + s_ * KB + (wid * KP + i_) * 1024), 16, 0, 0); } while (0)
#define FP_DMAV(t) do { const int t_ = (t); const GAS char* vb_ = (const GAS char*)(d.V + (size_t)FP_ROW(t_) * d.ldv); const int s_ = t_ % S; const unsigned sb_ = (t_ < d.nta) ? 0u : 1u; \
        _Pragma("unroll") for (int i_ = 0; i_ < VP; ++i_) __builtin_amdgcn_global_load_lds((const GAS unsigned*)(vb_ + (voff[i_] + sb_ * voffb[i_])), (LAS unsigned*)(lds + S * KB + s_ * VB + (wid * VP + i_) * 1024), 16, 0, 0); } while (0)
#pragma unroll
    for (int s = -DK; s < 0; ++s) { FP_DMAK(s + DK); if (s + DVV >= 0) FP_DMAV(s + DVV); }
    bf16x8 qr[NK];
    { const gbf* Qw = d.Q + (size_t)(hl * d.hsa + wrow0 + r32) * d.ldq + hi * 8;
#pragma unroll
      for (int d0 = 0; d0 < NK; ++d0) qr[d0] = *(const GAS bf16x8*)(Qw + d0 * 16); }
    float m_reg = -1e30f, l_reg = 0.f;
    f32x16 o[NCB];
#pragma unroll
    for (int i = 0; i < NCB; ++i) o[i] = f32x16{};
    const int vbase = (int)(unsigned)(size_t)(lds + S * KB + hl * VB1) + v_rd_base(lane);
    const int ksw = ((r32 >> 1) & 7);
    const int NT = d.NT;
#define FP_QKT(P0, P1, t) do { const LAS unsigned char* Ks_ = lds + ((t) % S) * KB + hl * KB1; P0 = f32x16{}; P1 = f32x16{}; \
        _Pragma("unroll") for (int d0 = 0; d0 < NK; ++d0) { const int cb_ = ((2 * d0 + hi) ^ ksw) << 4; \
            const bf16x8 b0_ = *(const LAS bf16x8*)(Ks_ + r32 * RB + cb_), b1_ = *(const LAS bf16x8*)(Ks_ + (32 + r32) * RB + cb_); \
            P0 = __builtin_amdgcn_mfma_f32_32x32x16_bf16(b0_, qr[d0], P0, 0, 0, 0); P1 = __builtin_amdgcn_mfma_f32_32x32x16_bf16(b1_, qr[d0], P1, 0, 0, 0); } } while (0)
#define FP_PV(t) do { const int vb_ = vbase + ((t) % S) * VB; pv_one<NCB, 0>(o[0], vb_, pa0, pa1, pa2, pa3); pv_one<NCB, 1>(o[1], vb_, pa0, pa1, pa2, pa3); \
        if constexpr (NCB == 4) { pv_one<NCB, 2>(o[2], vb_, pa0, pa1, pa2, pa3); pv_one<NCB, 3>(o[3], vb_, pa0, pa1, pa2, pa3); } } while (0)
#define FP_RESC(a) do { if (__any((a) < 1.f)) { if (hi == 0) wsf[r32] = (a); asm volatile("s_waitcnt lgkmcnt(0)" ::: "memory"); \
        _Pragma("unroll") for (int dd = 0; dd < NCB; ++dd) _Pragma("unroll") for (int r = 0; r < 16; ++r) o[dd][r] *= wsf[crow(r, hi)]; } } while (0)
#define FP_ENDWAIT(j) do { if ((j) + DK < NT) wait_barn<WSTEADY>(); else wait_barn<0>(); } while (0)
#define FP_STEP(C0, C1, alC, Pv0, Pv1, alP, j) do { \
        if ((j) + DK < NT) FP_DMAK((j) + DK); \
        if ((j) + DVV < NT) FP_DMAV((j) + DVV); \
        __builtin_amdgcn_sched_barrier(0); \
        const bool actC_ = FP_ACT(j); \
        if (actC_) { FP_QKT(C0, C1, j); } \
        FP_FSM(Pv0, Pv1, alP, varP); __builtin_amdgcn_sched_barrier(0); \
        if (actP) { FP_PV((j) - 1); } \
        const int varC_ = FP_VAR(j); \
        if (actC_) { FP_PSM(C0, C1, alC, j, varC_); FP_RESC(alC); } \
        else { _Pragma("unroll") for (int r = 0; r < 16; ++r) { C0[r] = 0.f; C1[r] = -30000.f; } alC = 1.f; }     \
        actP = actC_; varP = varC_; \
        FP_ENDWAIT(j); } while (0)
    f32x16 pA0, pA1, pB0, pB1; float alA = 1.f, alB = 1.f; bf16x8 pa0, pa1, pa2, pa3;
    wait_barn<WSTEADY>();
    if (DK < NT) FP_DMAK(DK);
    if (DVV < NT) FP_DMAV(DVV);
    bool actP = FP_ACT(0);
    int varP = FP_VAR(0);
    if (actP) { FP_QKT(pA0, pA1, 0); FP_PSM(pA0, pA1, alA, 0, varP); }
    else {
#pragma unroll
        for (int r = 0; r < 16; ++r) { pA0[r] = 0.f; pA1[r] = -30000.f; } }
    FP_ENDWAIT(0);
    for (int j = 1; j + 1 < NT; j += 2) {
        FP_STEP(pB0, pB1, alB, pA0, pA1, alA, j);
        FP_STEP(pA0, pA1, alA, pB0, pB1, alB, j + 1);
    }
    FP_STEP(pB0, pB1, alB, pA0, pA1, alA, NT - 1);
    FP_FSM(pB0, pB1, alB, varP); __builtin_amdgcn_sched_barrier(0);
    if (actP) { FP_PV(NT - 1); }
    if (hi == 0) wsf[32 + r32] = l_reg;
    wait_barn<0>();
    {
        constexpr int RS = DV + 8, CPR = DV / 8, NCHL = 32 * CPR / 64;
        LAS bf16_t* st = (LAS bf16_t*)(lds + wid * (32 * RS * 2));
        const gbf* Gw = d.G + (size_t)wrow0 * d.ldg + hl * DV; gbf* Ow = d.O + (size_t)wrow0 * d.ldo + hl * DV;
        u32x4 gv[NCHL];
#pragma unroll
        for (int i = 0; i < NCHL; ++i) { const int idx = i * 64 + lane, row = idx / CPR, cc = idx % CPR; gv[i] = *(const GAS u32x4*)(Gw + (size_t)row * d.ldg + cc * 8); }
#pragma unroll
        for (int r = 0; r < 16; ++r) { const float rl = __builtin_amdgcn_rcpf(wsf[32 + crow(r, hi)]);
#pragma unroll
            for (int dd = 0; dd < NCB; ++dd) st[crow(r, hi) * RS + dd * 32 + r32] = (bf16_t)f2bf(o[dd][r] * rl); }
        asm volatile("s_waitcnt lgkmcnt(0)" ::: "memory");
#pragma unroll
        for (int i = 0; i < NCHL; ++i) { const int idx = i * 64 + lane, row = idx / CPR, cc = idx % CPR;
            f32x4 va, vb, ga, gb; unpk8(*(const LAS u32x4*)(st + row * RS + cc * 8), va, vb); unpk8(gv[i], ga, gb);
            *(GAS u32x4*)(Ow + (size_t)row * d.ldo + cc * 8) = pk8(va * ga, vb * gb); }
    }
    asm volatile("s_waitcnt lgkmcnt(0)\n\ts_barrier" ::: "memory");
#undef FP_ROW
#undef FP_ACT
#undef FP_VAR
#undef FP_PSM
#undef FP_FSM
#undef FP_DMAK
#undef FP_DMAV
#undef FP_QKT
#undef FP_PV
#undef FP_RESC
#undef FP_ENDWAIT
#undef FP_STEP
}
}

__device__ __forceinline__ void phase_attn_fast(const Params& p, int l, unsigned char* lds_, int gid, int G) {
    LAS unsigned char* lds = (LAS unsigned char*)lds_;
    gu8* ws = wsb();
    const gbf* P = (const gbf*)(ws + WS_P); const gbf* KM = (const gbf*)(ws + WS_KM); const gbf* VM = (const gbf*)(ws + WS_VM); const gbf* QM = (const gbf*)(ws + WS_QM);
    const gbf* NK = (const gbf*)(ws + WS_NK); const gbf* NV = (const gbf*)(ws + WS_NV); const gbf* NQ = (const gbf*)(ws + WS_NQ);
    gbf* AB = (gbf*)(ws + WS_AB);
    const gf32* rpb = pin(I_RPB) + (size_t)l * 16 * 15 * 31;
    const int vcu = (G % 8 == 0) ? (gid % 8) * (G / 8) + gid / 8 : gid;
    const bool split = (l == 0 && G == 256); const int a = gid - 32;
    __syncthreads();
    if (split && gid < 32) { weight_transposes(lds_, TR_PER_L, 2 * TR_PER_L, gid * NWAVES + (tid_op() >> 6), 32 * NWAVES); __syncthreads(); return; }
    const int m_first = split ? (a % 8) * 28 + a / 8 : vcu, m_step = split ? (a < 32 ? 224 + a - m_first : 256) : G;
    for (int rep = 0; rep < (PROBE_DUP == 50 ? 2 : 1); ++rep)
    for (int u = m_first; u < NB * 8 * 8; u += m_step) { const int b = u >> 6, h = (u >> 3) & 7, qb = u & 7; const size_t q0 = (size_t)b * SEQ + qb * 256;
        const int lat0 = (b * 8 + h) * SEQ, ctx0 = NB * 8 * SEQ + (b * 8 + h) * CTXL;
        fa::Desc d{QM + (size_t)(lat0 + qb * 256) * 192, 192, KM, 192, VM, 128, ctx0, 4, lat0, 36, P + q0 * PP + C_GML + h * 128, PP, AB + q0 * ABW + 1024 + h * 128, ABW, 0, 0, nullptr, 0, 0};
        fa::unit_pipe<192, 128, 0, 3>(lds, d); }
    const bool upper = gid >= G / 2; const int nac = upper ? gid - G / 2 : gid, nacu = (G % 16 == 0) ? (nac % 8) * (G / 16) + nac / 8 : nac;
    const int xc = ((a - 32) % 8) * 16 + (a - 32) / 8;
    const int n_first = split ? (a < 32 ? 128 : a < 160 ? xc / 2 : 64 + (a - 160)) : nacu, n_step = split ? 128 : G / 2;
    const int n_lo = split ? (a < 160 ? (xc & 1) * 2 : 0) : (upper ? 0 : 3), n_hi = split ? (a < 160 ? (xc & 1) * 2 + 2 : 4) : (upper ? 3 : 4);
    for (int rep = 0; rep < (PROBE_DUP == 51 ? 2 : 1); ++rep)
    for (int u4 = n_first; u4 < NB * 16 * 2; u4 += n_step) for (int u = u4 * 4 + n_lo; u < u4 * 4 + n_hi; ++u) {
        const int b = u >> 7, h0 = ((u >> 5) & 3) * 4, r = u & 31, rs = min(max(r - 4, 0), 24); const size_t q0 = (size_t)b * SEQ + r * 64;
        const int lat0 = (b * 16 + h0) * SEQ, ctx0 = NB * 16 * SEQ + (b * 16 + h0) * CTXL;
        fa::Desc d{NQ + (size_t)(lat0 + r * 64) * 64, 64, NK, 64, NV, 64, lat0 + rs * 64, 8, ctx0, 12, P + q0 * PP + C_GNA + h0 * 64, PP, AB + q0 * ABW + 2048 + h0 * 64, ABW,
                   r, rs, rpb + h0 * 15 * 31, SEQ, CTXL};
        fa::unit_pipe<64, 64, 2, 2, 4>(lds, d); }
    if (l == 0) {
        const int x0 = split ? 192 : G / 2, x1 = split ? 192 : G / 2 + 32;
        for (int u = gid - x0; u >= 0 && u < NB * 8; u += G) { const int b = u >> 3, h = u & 7; const size_t q0 = (size_t)NLAT + b * CTXL; const int ctx0 = NB * 8 * SEQ + (b * 8 + h) * CTXL;
            fa::Desc d{QM + (size_t)ctx0 * 192, 192, KM, 192, VM, 128, ctx0, 4, 0, 4, P + q0 * PP + C_GML + h * 128, PP, AB + q0 * ABW + 1024 + h * 128, ABW, 0, 0, nullptr, 0, 0};
            fa::unit_pipe<192, 128, 0, 3>(lds, d); }
        for (int u = gid - x1; u >= 0 && u < NB * 16; u += G) { const int b = u >> 4, h = u & 15; const size_t q0 = (size_t)NLAT + b * CTXL; const int ctx0 = NB * 16 * SEQ + (b * 16 + h) * CTXL;
            fa::Desc d{NQ + (size_t)ctx0 * 64, 64, NK, 64, NV, 64, ctx0, 4, 0, 4, P + q0 * PP + C_GNA + h * 64, PP, AB + q0 * ABW + 2048 + h * 64, ABW, 0, 0, nullptr, 0, 0};
            fa::unit_pipe<64, 64, 0, 4>(lds, d); }
    }
    __syncthreads();
}


#define XB_TMO      128
#define XB_XCNT(j)  (256  + 64 * (j))
#define XB_XSUB(j)  (1280 + 64 * (j))
#define XB_XGEN(j)  (2304 + 64 * (j))
#define XB_TOP      3328
#define XB_TOPGEN   3392
#define XCD_BAR_WORDS 3456
#define XB_SPIN_CAP (1u << 18)
__device__ __forceinline__ unsigned xb_ld(unsigned* p)              { return __hip_atomic_load(p, __ATOMIC_RELAXED, __HIP_MEMORY_SCOPE_AGENT); }
__device__ __forceinline__ unsigned xb_add(unsigned* p, unsigned v) { return __hip_atomic_fetch_add(p, v, __ATOMIC_RELAXED, __HIP_MEMORY_SCOPE_AGENT); }
__device__ __forceinline__ unsigned xb_xcc_id() { return (unsigned)__builtin_amdgcn_s_getreg((3 << 11) | 20) & 0xFu; }
#define XB_SPIN(cond, bar) do { unsigned _sp = 0; while (cond) { __builtin_amdgcn_s_sleep(1); \
    if ((++_sp & 255u) == 0u) { if (xb_ld(&(bar)[XB_TMO])) break; if (_sp > XB_SPIN_CAP) { atomicAdd(&(bar)[XB_TMO], 1u); break; } } } } while (0)
struct XcdBarrier { unsigned* bar; unsigned x; volatile LAS unsigned* st; };
__device__ __forceinline__ XcdBarrier xcd_barrier_post(unsigned* bar, volatile LAS unsigned* st) {
    XcdBarrier b; b.bar = bar; b.x = xb_xcc_id(); b.st = st;
    if (threadIdx.x == 0) (void)xb_add(&bar[XB_XCNT(b.x)], 1u);
    return b;
}
__device__ __forceinline__ void xcd_barrier_complete(unsigned* bar, unsigned x, unsigned& nloc, unsigned& nx) {
    const unsigned G = gridDim.x * gridDim.y * gridDim.z;
    unsigned sum, cnt, mine, sp = 0u;
    for (;;) {
        sum = 0u; cnt = 0u; mine = 0u;
#pragma unroll
        for (unsigned j = 0; j < 16; ++j) { const unsigned c = xb_ld(&bar[XB_XCNT(j)]); sum += c; cnt += (c > 0u) ? 1u : 0u; mine = (j == x) ? c : mine; }
        if (sum == G) break;
        __builtin_amdgcn_s_sleep(1);
        if ((++sp & 255u) == 0u) { if (xb_ld(&bar[XB_TMO])) break; if (sp > XB_SPIN_CAP) { atomicAdd(&bar[XB_TMO], 1u); break; } }
    }
    nloc = mine > 0u ? mine : 1u; nx = cnt > 0u ? cnt : 1u;
}
__device__ __forceinline__ void xcd_barrier(const XcdBarrier& b) {
    asm volatile("s_waitcnt vmcnt(0)" ::: "memory");
    __syncthreads();
    if (threadIdx.x == 0) {
        unsigned* bar = b.bar;
        __builtin_amdgcn_s_waitcnt(0);
        unsigned nloc = b.st[0], nx = b.st[1];
        if (nloc == 0u) { xcd_barrier_complete(bar, b.x, nloc, nx); b.st[0] = nloc; b.st[1] = nx; }
        const unsigned old = xb_add(&bar[XB_XSUB(b.x)], 1u);
        const unsigned gen = old / nloc;
        if (old + 1u == (gen + 1u) * nloc) {
            __builtin_amdgcn_fence(__ATOMIC_RELEASE, "agent");
            asm volatile("s_waitcnt vmcnt(0)" ::: "memory");
            const unsigned og = xb_add(&bar[XB_TOP], 1u);
            const unsigned tg = og / nx;
            if (og + 1u == (tg + 1u) * nx) xb_add(&bar[XB_TOPGEN], 1u);
            else XB_SPIN(xb_ld(&bar[XB_TOPGEN]) == tg, bar);
            __builtin_amdgcn_fence(__ATOMIC_ACQUIRE, "agent");
            xb_add(&bar[XB_XGEN(b.x)], 1u);
            asm volatile("s_waitcnt vmcnt(0)" ::: "memory");
        } else {
            XB_SPIN(xb_ld(&bar[XB_XGEN(b.x)]) == gen, bar);
            __builtin_amdgcn_fence(__ATOMIC_ACQUIRE, "agent");
            asm volatile("s_waitcnt vmcnt(0)" ::: "memory");
        }
    }
    __syncthreads();
}

#define WSB(off) (wsb() + (off))
__global__ void __launch_bounds__(NTHREADS, 2) fwd_megakernel(Params p) {
    extern __shared__ __attribute__((aligned(16))) unsigned char lds[];
    cg::grid_group grid = cg::this_grid();
    const int gid_ = blockIdx.x, G_ = gridDim.x;
    auto sop = [](int v) { asm volatile("" : "+s"(v)); return v; };
#define gid sop(gid_)
#define G sop(G_)

    { volatile LAS unsigned* st0 = (volatile LAS unsigned*)((LAS unsigned char*)lds + LDS_BYTES - 16); if (threadIdx.x < 4) st0[threadIdx.x] = 0u; __syncthreads(); }
    (void)xcd_barrier_post((unsigned*)(wsb() + WS_BAR), (volatile LAS unsigned*)((LAS unsigned char*)lds + LDS_BYTES - 16));
    if (wsb() == nullptr) grid.sync();
#define GSYNC() xcd_barrier(XcdBarrier{(unsigned*)(wsb() + WS_BAR), xb_xcc_id(), (volatile LAS unsigned*)((LAS unsigned char*)lds + LDS_BYTES - 16)})
    for (int rep = 0; rep < (PROBE_DUP == 0 ? 2 : 1); ++rep) { phase0(p, lds, gid, G); GSYNC(); }

    for (int rep = 0; rep < (PROBE_DUP == 1 ? 2 : 1); ++rep) { phase_uprep0(p, gid, G); GSYNC(); }
    for (int l = 0; l < DEPTH; ++l) {
        const int nq = (l == 0) ? NROW : NLAT;
        for (int rep = 0; rep < ((PROBE_DUP == 2 || PROBE_DUP == 3) ? 2 : 1); ++rep) {
            const gbf* WinT = (const gbf*)WSB(WS_WIN) + (size_t)l * NP * KP2; gbf* U = (gbf*)WSB(WS_U); gbf* P = (gbf*)WSB(WS_P);
            const EpiInProj E{P, 0, (gbf*)WSB(WS_NK), (gbf*)WSB(WS_NV), (gbf*)WSB(WS_NQ), (gbf*)WSB(WS_MG)};
            if (l == 0 && G == 256) {
                __syncthreads();
                { fg::SchedIn0 S{U, WinT, G, gid, 0, 11}; fg::gemm((LAS unsigned char*)lds, KP2, KP2, DM, S, E); }
                __syncthreads();
                GSYNC();
                if (gid < 64) { fg::SchedIn0 S{U, WinT, G, gid, 11, 12}; fg::gemm((LAS unsigned char*)lds, KP2, KP2, DM, S, E); __syncthreads(); }
                else phase_c1(p, l, NROW, gid - 64, G - 64);
                GSYNC();
            } else {
                gemm_run(lds, GemmJob{U, KP2, WinT, KP2, nq, NP, DM}, E, gid, G);
                GSYNC();
                if (l == 0) phase_c1(p, l, NROW, gid, G);
                else if (gid < 40) gemm_run(lds, GemmJob{(const gbf*)WSB(WS_U) + (size_t)NLAT * KP2, KP2, (const gbf*)WSB(WS_WIN) + (size_t)l * NP * KP2, KP2, NCTX, KVC_P, DM},
                                            EpiInProjC1{(gbf*)WSB(WS_P), (gbf*)WSB(WS_NK), (gbf*)WSB(WS_KM), (gf32*)WSB(WS_SSQ)}, gid, 40);
                else phase_c1(p, l, NLAT, gid - 40, G - 40);
                GSYNC();
            }
        }
        for (int rep = 0; rep < (PROBE_DUP == 4 ? 2 : 1); ++rep) {
            __syncthreads();
            { SchedC2 S{(const gbf*)WSB(WS_P), (const gbf*)WSB(WS_WUKV) + (size_t)l * 2048 * 256, (const gbf*)WSB(WS_WUQ) + (size_t)l * 1536 * 512, (const gbf*)WSB(WS_DC), nq / 256, l == 0 ? 32 : 0, G, gid};
              EpiC2 E{(gbf*)WSB(WS_KM), (gbf*)WSB(WS_VM), (gbf*)WSB(WS_QM), (gbf*)WSB(WS_GT), (gbf*)WSB(WS_GTC), (const gf32*)WSB(WS_RKV), (const gf32*)WSB(WS_RQ), (const gf32*)WSB(WS_ROPE), l == 1 ? (const gf32*)WSB(WS_SSQ) : (const gf32*)nullptr};
              fg::gemm_multi((LAS unsigned char*)lds, S, E); }
            __syncthreads();
            GSYNC();
        }
        for (int rep = 0; rep < (PROBE_DUP == 5 ? 2 : 1); ++rep) {
        phase_attn_fast(p, l, lds, gid, G);
        for (int rep2 = 0; rep2 < (PROBE_DUP == 52 ? 2 : 1); ++rep2)
        gemm_fast_z(lds, MapF2{(const gbf*)WSB(WS_DN), (const gbf*)WSB(WS_GT), KP4}, KP4, KP4, 2 * SEQ, SEQ / 256, 4, NB, EpiF2{(gbf*)WSB(WS_AB), (const gbf*)WSB(WS_P), 0, SEQ}, (l == 0 && G == 256) ? ((gid >= 64 && gid < 192) ? gid - 64 : -1) : (gid < G / 2 ? gid : -1), G / 2);
        if (l == 0) gemm_fast_z(lds, MapF2{(const gbf*)WSB(WS_DNC), (const gbf*)WSB(WS_GTC), 2 * CTXL}, 2 * CTXL, 2 * CTXL, 2 * CTXL, 1, 4, NB, EpiF2{(gbf*)WSB(WS_AB), (const gbf*)WSB(WS_P), NLAT, CTXL}, gid - (G == 256 ? 224 : G / 2 + 96), G);
        GSYNC();
        }
        const gbf* WpT = (const gbf*)WSB(WS_WP) + (size_t)l * 4 * 2048 * KP1; const gbf* WoT = (const gbf*)WSB(WS_WO) + (size_t)l * 2048 * KP2;
        const int NC = G / 8;
        for (int rep = 0; rep < (PROBE_DUP == 6 ? 2 : 1); ++rep) {
          __syncthreads();
          { fg::SchedBranch S{(const gbf*)WSB(WS_AB), WpT, NLAT / 256, DM / 256, G, gid, 0};
            fg::gemm((LAS unsigned char*)lds, ABW, KP1, 1024, S, EpiChain{(gbf*)WSB(WS_MB), (const gbf*)WSB(WS_MG), 0}); }
          __syncthreads();
          GSYNC();
        }
        for (int rep = 0; rep < (PROBE_DUP == 7 ? 2 : 1); ++rep) {
          if (l == 0) {
            __syncthreads();
            if (gid < NC) { fg::SchedBranch S{(const gbf*)WSB(WS_AB), WpT, NCTX / 256, DM / 256, NC, gid, NLAT / 256};
                            fg::gemm((LAS unsigned char*)lds, ABW, KP1, 1024, S, EpiChain{(gbf*)WSB(WS_MB), (const gbf*)WSB(WS_MG), NLAT}); }
            else { fg::Sched<fg::MapPlain> S{fg::MapPlain{(const gbf*)WSB(WS_MB), KP2, WoT, KP2}, NLAT / 256, DM / 256, 1, G - NC, gid - NC};
                   fg::gemm((LAS unsigned char*)lds, KP2, KP2, DM, S, EpiOut{(gf32*)WSB(WS_Y), 0}); }
            __syncthreads();
          } else gemm_run(lds, GemmJob{(const gbf*)WSB(WS_MB), KP2, WoT, KP2, NLAT, DM, DM}, EpiOut{(gf32*)WSB(WS_Y), 0}, gid, G);
          GSYNC();
        }
        for (int rep = 0; rep < (PROBE_DUP == 8 ? 2 : 1); ++rep) {
          if (l == 0) {
            if (gid < NC) gemm_run(lds, GemmJob{(const gbf*)WSB(WS_MB) + (size_t)NLAT * KP2, KP2, WoT, KP2, NCTX, DM, DM}, EpiOut{(gf32*)WSB(WS_Y), NLAT}, gid, NC);
            else phase_final(p, l, 0, NLAT, gid - NC, G - NC);
            GSYNC();
            phase_final(p, l, NLAT, NROW, gid, G);
            GSYNC();
          } else {
            phase_final(p, l, 0, NLAT, gid, G);
            if (rep + 1 < (PROBE_DUP == 8 ? 2 : 1)) GSYNC();
          }
        }
    }
}
#undef gid
#undef G

extern "C" void kernel_launch(void* const* d_in, const int* in_sizes, int n_in, void* d_out, int out_size, void* d_ws, size_t ws_size, hipStream_t stream) {
    static int grid_blocks = 0;
    if (grid_blocks == 0) {
        if (n_in != 20 || out_size != NLAT * DM || ws_size < WS_END) { fprintf(stderr, "kernel_launch: unexpected shapes (n_in %d out %d ws %zu, need ws >= %zu)\n", n_in, out_size, ws_size, (size_t)WS_END); grid_blocks = -1; return; }
        int dev = 0, cus = 0, per_cu = 0;
        hipGetDevice(&dev);
        hipDeviceGetAttribute(&cus, hipDeviceAttributeMultiprocessorCount, dev);
        if (hipFuncSetAttribute((const void*)fwd_megakernel, hipFuncAttributeMaxDynamicSharedMemorySize, LDS_BYTES) != hipSuccess) { fprintf(stderr, "kernel_launch: hipFuncSetAttribute failed\n"); grid_blocks = -1; return; }
        if (hipOccupancyMaxActiveBlocksPerMultiprocessor(&per_cu, (const void*)fwd_megakernel, NTHREADS, LDS_BYTES) != hipSuccess || per_cu < 1) { fprintf(stderr, "kernel_launch: occupancy query failed (%d)\n", per_cu); grid_blocks = -1; return; }
        grid_blocks = cus;
        fprintf(stderr, "kernel_launch: cus %d per_cu %d grid %d\n", cus, per_cu, grid_blocks);
    }
    if (grid_blocks < 0) return;
    if (hipMemsetAsync((char*)d_ws + WS_BAR, 0, 16384, stream) != hipSuccess) { fprintf(stderr, "kernel_launch: hipMemsetAsync of the barrier words failed\n"); return; }
    Params p{};
    for (int i = 0; i < 20; ++i) p.in[i] = (const gf32*)d_in[i];
    p.out = (gf32*)d_out; p.ws = (gu8*)d_ws;
    void* args[] = {&p};
    hipError_t e = hipLaunchCooperativeKernel((const void*)fwd_megakernel, dim3(grid_blocks), dim3(NTHREADS), args, LDS_BYTES, stream);
    if (e != hipSuccess) fprintf(stderr, "kernel_launch: cooperative launch failed: %s (grid %d)\n", hipGetErrorString(e), grid_blocks);
}
```

```cpp
#include <hip/hip_runtime.h>
#include <hip/hip_cooperative_groups.h>
#include <cstdio>
#include <cstdint>
namespace cg = cooperative_groups;
#ifndef PROBE_DUP
#define PROBE_DUP -1
#endif

#define GAS __attribute__((address_space(1)))
typedef unsigned short bf16_t;
typedef GAS bf16_t gbf;
typedef GAS float gf32;
typedef GAS unsigned char gu8;
typedef float f32x4 __attribute__((ext_vector_type(4)));
typedef unsigned u32x4 __attribute__((ext_vector_type(4)));
typedef unsigned u32x2 __attribute__((ext_vector_type(2)));

constexpr int DM = 2048, NB = 4, SEQ = 2048, CTXL = 256, DEPTH = 2;
constexpr int NLAT = NB * SEQ, NCTX = NB * CTXL, NROW = NLAT + NCTX;
constexpr int N_IN = 20288, NP = 20480;
constexpr int PP = 12288 + 64;
constexpr int KP2 = DM + 64;
constexpr int KP1 = 1024 + 64;
constexpr int KP4 = 4096 + 64;
constexpr int C_CKV = 0, C_KR = 256, C_NAK = 512, C_NAV = 1536, C_QL = 2560, C_NAQ = 3072, C_CB = 4096, C_CC = 5120, C_CX = 6144, C_FV = 7168,
              C_GCV = 8192, C_GML = 9216, C_GNA = 10240, C_GFN = 11264, C_MG = 12288;
constexpr int KVC_P = 2560;
constexpr int KMW = 1536, VMW = 1024, QMW = 1536, ABW = 4160;
constexpr float EPS = 1e-6f;
constexpr float LOG2E = 1.4426950408889634f;
constexpr float QSCALE = 0.07216878364870322f * LOG2E;
constexpr float NASCALE = 0.125f * LOG2E;
constexpr int NTHREADS = 512, NWAVES = 8;
constexpr int LDS_BYTES = 147456;

constexpr size_t al256(size_t x) { return (x + 255) / 256 * 256; }
constexpr size_t WS_WIN = 0;
constexpr size_t WS_WUKV = WS_WIN + al256((size_t)2 * NP * KP2 * 2);
constexpr size_t WS_WUQ = WS_WUKV + al256((size_t)2 * 2048 * 256 * 2);
constexpr size_t WS_WP = WS_WUQ + al256((size_t)2 * 1536 * 512 * 2);
constexpr size_t WS_WO = WS_WP + al256((size_t)2 * 4 * 2048 * KP1 * 2);
constexpr size_t WS_MOD = WS_WO + al256((size_t)2 * 2048 * KP2 * 2);
constexpr size_t WS_ROPE = WS_MOD + al256((size_t)2 * 5 * 6144 * 4);
constexpr size_t WS_DC = WS_ROPE + al256((size_t)64 * 16 * 2 * 4);
constexpr size_t WS_DN = WS_DC + al256((size_t)512 * 256 * 2);
constexpr size_t WS_DNC = WS_DN + al256((size_t)2048 * KP4 * 2);
constexpr size_t WS_U = WS_DNC + al256((size_t)256 * 512 * 2);
constexpr size_t WS_P = WS_U + al256((size_t)NROW * KP2 * 2);
constexpr size_t WS_KM = WS_P + al256((size_t)NROW * PP * 2);
constexpr size_t WS_VM = WS_KM + al256((size_t)NROW * KMW * 2);
constexpr size_t WS_QM = WS_VM + al256((size_t)NROW * VMW * 2);
constexpr size_t WS_AB = WS_QM + al256((size_t)NROW * QMW * 2);
constexpr size_t WS_GT = WS_AB + al256((size_t)NROW * ABW * 2);
constexpr size_t WS_GTC = WS_GT + al256((size_t)4 * 1024 * KP4 * 2);
constexpr size_t WS_MF = WS_GTC + al256((size_t)4 * 1024 * 512 * 2);
constexpr size_t WS_MB = WS_MF + al256((size_t)NROW * DM * 4);
constexpr size_t WS_Y = WS_MB + al256((size_t)NROW * KP2 * 2);
constexpr size_t WS_RKV = WS_Y + al256((size_t)NROW * DM * 4);
constexpr size_t WS_RQ = WS_RKV + al256((size_t)NROW * 4);
constexpr size_t WS_XL = WS_RQ + al256((size_t)NROW * 4);
constexpr size_t WS_NK = WS_XL + al256((size_t)NROW * DM * 4);
constexpr size_t WS_NV = WS_NK + al256((size_t)NROW * 1024 * 2);
constexpr size_t WS_NQ = WS_NV + al256((size_t)NROW * 1024 * 2);
constexpr size_t WS_MG = WS_NQ + al256((size_t)NROW * 1024 * 2);
constexpr size_t WS_SSQ = WS_MG + al256((size_t)4 * NROW * DM * 2);
constexpr size_t WS_BAR = WS_SSQ + al256((size_t)NCTX * 8 * 4);
constexpr size_t WS_END = WS_BAR + 16384;

struct Params { const gf32* in[20]; gf32* out; gu8* ws; };
enum { I_X = 0, I_C, I_CTX, I_CCTX, I_GPRE, I_GPOST, I_WADA, I_BADA, I_WIN, I_GQ, I_GKV, I_WUQ, I_WUKV, I_CONVW, I_RPB, I_WPC, I_WPM, I_WPN, I_WPF, I_WOUT };

__device__ __forceinline__ size_t hm_row(int r, int h, int NH) {
    return r < NLAT ? (size_t)(((r >> 11) * NH + h) * SEQ + (r & (SEQ - 1))) : (size_t)NB * NH * SEQ + (size_t)((((r - NLAT) >> 8) * NH + h) * CTXL + ((r - NLAT) & (CTXL - 1)));
}

__device__ __forceinline__ size_t mg_off(int z, int r, int c) { return ((((size_t)z * (NROW / 256) + (r >> 8)) * (DM / 256) + (c >> 8)) * 256 + (r & 255)) * 256 + (c & 255); }

__device__ __forceinline__ unsigned f2bf(float f) { unsigned u = __builtin_bit_cast(unsigned, f); return (u + 0x7fffu + ((u >> 16) & 1u)) >> 16; }
typedef float f32x2_t __attribute__((ext_vector_type(2))); typedef __bf16 bf16x2_t __attribute__((ext_vector_type(2)));
__device__ __forceinline__ unsigned pk2(float lo, float hi) { f32x2_t v = {lo, hi}; bf16x2_t b = __builtin_convertvector(v, bf16x2_t); return __builtin_bit_cast(unsigned, b); }
__device__ __forceinline__ float bf2f(unsigned short b) { return __builtin_bit_cast(float, (unsigned)b << 16); }
__device__ __forceinline__ float bflo(unsigned w) { return __builtin_bit_cast(float, w << 16); }
__device__ __forceinline__ float bfhi(unsigned w) { return __builtin_bit_cast(float, w & 0xffff0000u); }
__device__ __forceinline__ u32x2 pk4(f32x4 v) { u32x2 r; r.x = pk2(v[0], v[1]); r.y = pk2(v[2], v[3]); return r; }
__device__ __forceinline__ u32x4 pk8(f32x4 a, f32x4 b) { u32x4 r; r.x = pk2(a[0], a[1]); r.y = pk2(a[2], a[3]); r.z = pk2(b[0], b[1]); r.w = pk2(b[2], b[3]); return r; }
__device__ __forceinline__ void unpk8(u32x4 w, f32x4& a, f32x4& b) { a = (f32x4){bflo(w.x), bfhi(w.x), bflo(w.y), bfhi(w.y)}; b = (f32x4){bflo(w.z), bfhi(w.z), bflo(w.w), bfhi(w.w)}; }
__device__ __forceinline__ f32x4 unpk4(u32x2 w) { return (f32x4){bflo(w.x), bfhi(w.x), bflo(w.y), bfhi(w.y)}; }
__device__ __forceinline__ float sigmoidf_(float x) { return __builtin_amdgcn_rcpf(1.0f + __builtin_amdgcn_exp2f(x * -LOG2E)); }
__device__ __forceinline__ float siluf_(float x) { return x * __builtin_amdgcn_rcpf(1.0f + __builtin_amdgcn_exp2f(x * -LOG2E)); }
__device__ __forceinline__ float wave_sum(float v) {
#pragma unroll
    for (int o = 1; o < 64; o <<= 1) v += __shfl_xor(v, o);
    return v;
}
__device__ __forceinline__ float wave_max(float v) {
#pragma unroll
    for (int o = 1; o < 64; o <<= 1) v = fmaxf(v, __shfl_xor(v, o));
    return v;
}

typedef __attribute__((address_space(4))) const unsigned char* kargp_t;
__device__ __forceinline__ kargp_t karg_op() { kargp_t k = (kargp_t)__builtin_amdgcn_kernarg_segment_ptr(); asm volatile("" : "+s"(k)); return k; }
__device__ __forceinline__ const gf32* pin(int i) { return *(const gf32* const __attribute__((address_space(4)))*)(karg_op() + 8 * i); }
__device__ __forceinline__ gf32* pout() { return *(gf32* const __attribute__((address_space(4)))*)(karg_op() + 8 * 20); }
__device__ __forceinline__ gu8* wsb() { return *(gu8* const __attribute__((address_space(4)))*)(karg_op() + 8 * 21); }
__device__ __forceinline__ int tid_op() { int t = threadIdx.x; asm volatile("" : "+v"(t)); return t; }

struct GemmJob { const gbf* A; int lda; const gbf* Bt; int ldb; int M, N, K; };

#define LAS __attribute__((address_space(3)))
typedef short bf16x8 __attribute__((ext_vector_type(8)));
namespace fg {
constexpr int BM = 256, BK = 64, HALF = 128, HTB = HALF * BK * 2, STAGE_BYTES = 8 * HTB, NXCD = 8, WGM = 4;
__device__ __forceinline__ int lds_byte(int r, int c) { const int st = (r >> 4) * 2 + (c >> 5), rr = r & 15, cc = c & 31, ob = rr * 64 + cc * 2; return st * 1024 + (ob ^ (((ob >> 9) & 1) << 5)); }
__device__ __forceinline__ void stage_rc(int b, int& R, int& C) { const int st = b / 1024, sb = b % 1024, swz = sb ^ (((sb >> 9) & 1) << 5); R = (st >> 1) * 16 + swz / 64; C = (st & 1) * 32 + (swz % 64) / 2; }
__device__ __forceinline__ int perm32(int rho) { const int n = rho >> 4, i = rho & 15; return 8 * (i >> 2) + 4 * n + (i & 3); }
struct Unit { const GAS char* A; const GAS char* B; int pm, pn, z; };
template <class Map> struct Sched {
    Map map; int nM, nN, nz, G, c;
    __device__ __forceinline__ bool next(int i, Unit& u) const {
        const int per = nM * nN, nwg = per * nz; const long L = (long)i * G + c; if (L >= nwg) return false;
        int wgid = (int)L; { const int q = nwg / NXCD, r = nwg % NXCD, xcd = wgid % NXCD, off = wgid / NXCD; wgid = (xcd < r ? xcd * (q + 1) : r * (q + 1) + (xcd - r) * q) + off; }
        const int z = wgid / per, w = wgid % per;
        const int nig = WGM * nN, gidx = w / nig, fm = gidx * WGM, gsz = (nM - fm) < WGM ? (nM - fm) : WGM;
        u.pm = fm + ((w % nig) % gsz); u.pn = (w % nig) / gsz; u.z = z; u.A = (const GAS char*)map.a(z, u.pm); u.B = (const GAS char*)map.b(z, u.pn); return true;
    }
};
template <class Epi, class S_>
__device__ __forceinline__ void gemm(LAS unsigned char* lds, int lda, int ldb, int K, const S_& S, const Epi& E) {
    const int tid = tid_op(), wid = __builtin_amdgcn_readfirstlane(tid >> 6), lane = tid & 63, wr = wid >> 2, wc = wid & 3, fr = lane & 15, fq = lane >> 4;
    int Kop = K; asm volatile("" : "+s"(Kop));
    const int nt = Kop / BK;
    unsigned voffA[2], voffB[2];
#pragma unroll
    for (int i = 0; i < 2; ++i) { int R, C; stage_rc(tid * 16 + i * 8192, R, C); const int Rb = Epi::PERM ? ((R & ~31) + perm32(R & 31)) : R;
        voffA[i] = (unsigned)(R * lda + C) * 2u; voffB[i] = (unsigned)(Rb * ldb + C) * 2u; }
    const size_t kstep = (size_t)(BK * 2);
    const size_t hstepA = (size_t)HALF * lda * 2, hstepB = (size_t)HALF * ldb * 2;
    const unsigned ldsw = (unsigned)wid * 1024u;
    const int aoff = lds_byte(wr * 64 + fr, fq * 8), boff = lds_byte(wc * 32 + fr, fq * 8);
#define FG_SA(b, h) (((b) * 2 + (h)) * HTB)
#define FG_SB(b, h) ((4 + (b) * 2 + (h)) * HTB)
#define FG_STAGE(bufoff, gbase, voff) do { _Pragma("unroll") for (int _i = 0; _i < 2; ++_i) \
        __builtin_amdgcn_global_load_lds((const GAS unsigned*)((const GAS char*)(gbase) + (voff)[_i]), (LAS unsigned*)(lds + (bufoff) + ldsw + _i * 8192), 16, 0, 0); } while (0)
#define FG_LDA(dst, b, h) do { _Pragma("unroll") for (int m = 0; m < 4; ++m) _Pragma("unroll") for (int k = 0; k < 2; ++k) dst[m][k] = *(const LAS bf16x8*)(lds + FG_SA(b, h) + aoff + m * 2048 + k * 1024); } while (0)
#define FG_LDB(dst, b, h) do { _Pragma("unroll") for (int n = 0; n < 2; ++n) _Pragma("unroll") for (int k = 0; k < 2; ++k) dst[n][k] = *(const LAS bf16x8*)(lds + FG_SB(b, h) + boff + n * 2048 + k * 1024); } while (0)
#define FG_MMA(ai, bj, At, Bt) do { __builtin_amdgcn_s_setprio(1); _Pragma("unroll") for (int m = 0; m < 4; ++m) _Pragma("unroll") for (int n = 0; n < 2; ++n) _Pragma("unroll") for (int k = 0; k < 2; ++k) \
        acc[ai][bj][m][n] = __builtin_amdgcn_mfma_f32_16x16x32_bf16(Bt[n][k], At[m][k], acc[ai][bj][m][n], 0, 0, 0); __builtin_amdgcn_s_setprio(0); } while (0)
#define FG_WAIT_V(n) asm volatile("s_waitcnt vmcnt(" #n ")" ::: "memory")
#define FG_WAIT_L(n) asm volatile("s_waitcnt lgkmcnt(" #n ")" ::: "memory")
#define FG_BAR __builtin_amdgcn_s_barrier()
#define FG_SCHED __builtin_amdgcn_sched_barrier(0)
    Unit cur, nxt; int ui = 0;
    if (!S.next(0, cur)) return;
    f32x4 acc[2][2][4][2];
#pragma unroll
    for (int a = 0; a < 2; ++a)
#pragma unroll
        for (int b = 0; b < 2; ++b)
#pragma unroll
            for (int m = 0; m < 4; ++m)
#pragma unroll
                for (int n = 0; n < 2; ++n) acc[a][b][m][n] = (f32x4){0.f, 0.f, 0.f, 0.f};
    bf16x8 At[4][2], B0[2][2], B1[2][2];
    const GAS char* cA = cur.A; const GAS char* cB = cur.B;
    FG_STAGE(FG_SB(0, 0), cB, voffB); FG_STAGE(FG_SB(0, 1), cB + hstepB, voffB); FG_STAGE(FG_SA(0, 0), cA, voffA); FG_STAGE(FG_SA(0, 1), cA + hstepA, voffA);
    if (wr == 1) FG_BAR;
    FG_WAIT_V(2); FG_BAR;
    FG_STAGE(FG_SB(1, 0), cB + kstep, voffB); FG_STAGE(FG_SA(1, 0), cA + kstep, voffA); FG_STAGE(FG_SB(1, 1), cB + hstepB + kstep, voffB);
    FG_WAIT_V(6); FG_BAR;
    for (;;) {
        const bool has_next = S.next(ui + 1, nxt);
        const GAS char* nA = has_next ? nxt.A : cA; const GAS char* nB = has_next ? nxt.B : cB;
        for (int t = 0; t < nt; t += 2) {
            const bool last = (t == nt - 2);
            const GAS char* a1 = cA + (size_t)(t + 1) * kstep;
            const GAS char* a2 = last ? nA : cA + (size_t)(t + 2) * kstep; const GAS char* b2 = last ? nB : cB + (size_t)(t + 2) * kstep;
            const GAS char* a3 = a2 + kstep; const GAS char* b3 = b2 + kstep;
            FG_LDB(B0, 0, 0); FG_LDB(B1, 0, 1); FG_SCHED; FG_LDA(At, 0, 0); FG_STAGE(FG_SA(1, 1), a1 + hstepA, voffA);
            FG_WAIT_V(8); FG_WAIT_L(0); FG_BAR; FG_MMA(0, 0, At, B0); FG_MMA(0, 1, At, B1); FG_BAR; FG_SCHED;
            FG_LDA(At, 0, 1); FG_STAGE(FG_SB(0, 0), b2, voffB); FG_STAGE(FG_SB(0, 1), b2 + hstepB, voffB); FG_STAGE(FG_SA(0, 0), a2, voffA);
            FG_WAIT_V(8); FG_WAIT_L(0); FG_BAR; FG_MMA(1, 0, At, B0); FG_MMA(1, 1, At, B1); FG_BAR; FG_SCHED;
            FG_LDB(B0, 1, 0); FG_LDB(B1, 1, 1); FG_SCHED; FG_LDA(At, 1, 0); FG_STAGE(FG_SA(0, 1), a2 + hstepA, voffA);
            FG_WAIT_V(8); FG_WAIT_L(0); FG_BAR; FG_MMA(0, 0, At, B0); FG_MMA(0, 1, At, B1); FG_BAR; FG_SCHED;
            FG_LDA(At, 1, 1); FG_STAGE(FG_SB(1, 0), b3, voffB); FG_STAGE(FG_SB(1, 1), b3 + hstepB, voffB); FG_STAGE(FG_SA(1, 0), a3, voffA);
            FG_WAIT_V(8); FG_WAIT_L(0); FG_BAR; FG_MMA(1, 0, At, B0); FG_MMA(1, 1, At, B1); FG_BAR; FG_SCHED;
        }
        if (wr == 0) FG_BAR;
        bool keep_acc = false;
        {
            const auto Ez = E.z(cur.z);
            if constexpr (Epi::CHAIN) keep_acc = (cur.z < 3);
#pragma unroll
            for (int ai = 0; ai < 2; ++ai)
#pragma unroll
                for (int m = 0; m < 4; ++m)
#pragma unroll
                    for (int bj = 0; bj < 2; ++bj) {
                        const int row_ = cur.pm * BM + ai * HALF + wr * 64 + m * 16 + fr, col_ = cur.pn * BM + bj * HALF + wc * 32 + (Epi::PERM ? 8 : 4) * fq;
                        if constexpr (Epi::CHAIN) Ez.chain(row_, col_, acc[ai][bj][m][0], acc[ai][bj][m][1], cur.z);
                        else Ez(row_, col_, acc[ai][bj][m][0], acc[ai][bj][m][1]);
                        if (bj == 1 && (m & 1)) asm volatile("" ::: "memory");
                    }
        }
        if (!has_next) break;
        if (!keep_acc) {
#pragma unroll
        for (int a = 0; a < 2; ++a)
#pragma unroll
            for (int b = 0; b < 2; ++b)
#pragma unroll
                for (int m = 0; m < 4; ++m)
#pragma unroll
                    for (int n = 0; n < 2; ++n) acc[a][b][m][n] = (f32x4){0.f, 0.f, 0.f, 0.f};
        }
        cur = nxt; cA = nA; cB = nB; ++ui;
        if (wr == 1) FG_BAR;
    }
    FG_WAIT_V(0);
    FG_BAR;
#undef FG_SA
#undef FG_SB
#undef FG_STAGE
#undef FG_LDA
#undef FG_LDB
#undef FG_MMA
#undef FG_WAIT_V
#undef FG_WAIT_L
#undef FG_BAR
#undef FG_SCHED
}

struct UnitM { const GAS char* A; const GAS char* B; int lda, ldb, nt, pm, pn, z, job; };
template <class EpiM, class SM>
__device__ __forceinline__ void gemm_multi(LAS unsigned char* lds, const SM& S, const EpiM& E) {
    const int tid = tid_op(), wid = __builtin_amdgcn_readfirstlane(tid >> 6), lane = tid & 63, wr = wid >> 2, wc = wid & 3, fr = lane & 15, fq = lane >> 4;
    int sR[2], sRb[2], sC[2];
#pragma unroll
    for (int i = 0; i < 2; ++i) { stage_rc(tid * 16 + i * 8192, sR[i], sC[i]); sRb[i] = (sR[i] & ~31) + perm32(sR[i] & 31); }
    const size_t kstep = (size_t)(BK * 2);
    const unsigned ldsw = (unsigned)wid * 1024u;
    const int aoff = lds_byte(wr * 64 + fr, fq * 8), boff = lds_byte(wc * 32 + fr, fq * 8);
#define FG_SA(b, h) (((b) * 2 + (h)) * HTB)
#define FG_SB(b, h) ((4 + (b) * 2 + (h)) * HTB)
#define FG_STAGE(bufoff, gbase, voff) do { _Pragma("unroll") for (int _i = 0; _i < 2; ++_i) \
        __builtin_amdgcn_global_load_lds((const GAS unsigned*)((const GAS char*)(gbase) + (voff)[_i]), (LAS unsigned*)(lds + (bufoff) + ldsw + _i * 8192), 16, 0, 0); } while (0)
#define FG_LDA(dst, b, h) do { _Pragma("unroll") for (int m = 0; m < 4; ++m) _Pragma("unroll") for (int k = 0; k < 2; ++k) dst[m][k] = *(const LAS bf16x8*)(lds + FG_SA(b, h) + aoff + m * 2048 + k * 1024); } while (0)
#define FG_LDB(dst, b, h) do { _Pragma("unroll") for (int n = 0; n < 2; ++n) _Pragma("unroll") for (int k = 0; k < 2; ++k) dst[n][k] = *(const LAS bf16x8*)(lds + FG_SB(b, h) + boff + n * 2048 + k * 1024); } while (0)
#define FG_MMA(ai, bj, At, Bt) do { __builtin_amdgcn_s_setprio(1); _Pragma("unroll") for (int m = 0; m < 4; ++m) _Pragma("unroll") for (int n = 0; n < 2; ++n) _Pragma("unroll") for (int k = 0; k < 2; ++k) \
        acc[ai][bj][m][n] = __builtin_amdgcn_mfma_f32_16x16x32_bf16(Bt[n][k], At[m][k], acc[ai][bj][m][n], 0, 0, 0); __builtin_amdgcn_s_setprio(0); } while (0)
#define FG_WAIT_V(n) asm volatile("s_waitcnt vmcnt(" #n ")" ::: "memory")
#define FG_WAIT_L(n) asm volatile("s_waitcnt lgkmcnt(" #n ")" ::: "memory")
#define FG_BAR __builtin_amdgcn_s_barrier()
#define FG_SCHED __builtin_amdgcn_sched_barrier(0)
#define FG_OFFS(u, vA, vB, hA, hB) do { _Pragma("unroll") for (int _i = 0; _i < 2; ++_i) { vA[_i] = (unsigned)(sR[_i] * (u).lda + sC[_i]) * 2u; vB[_i] = (unsigned)(sRb[_i] * (u).ldb + sC[_i]) * 2u; } \
        hA = (size_t)HALF * (u).lda * 2; hB = (size_t)HALF * (u).ldb * 2; } while (0)
    UnitM cur, nxt; int ui = 0;
    if (!S.next(0, cur)) return;
    unsigned vAc[2], vBc[2], vAn[2], vBn[2]; size_t hAc, hBc, hAn, hBn;
    FG_OFFS(cur, vAc, vBc, hAc, hBc);
    f32x4 acc[2][2][4][2];
#pragma unroll
    for (int a = 0; a < 2; ++a)
#pragma unroll
        for (int b = 0; b < 2; ++b)
#pragma unroll
            for (int m = 0; m < 4; ++m)
#pragma unroll
                for (int n = 0; n < 2; ++n) acc[a][b][m][n] = (f32x4){0.f, 0.f, 0.f, 0.f};
    bf16x8 At[4][2], B0[2][2], B1[2][2];
    const GAS char* cA = cur.A; const GAS char* cB = cur.B;
    FG_STAGE(FG_SB(0, 0), cB, vBc); FG_STAGE(FG_SB(0, 1), cB + hBc, vBc); FG_STAGE(FG_SA(0, 0), cA, vAc); FG_STAGE(FG_SA(0, 1), cA + hAc, vAc);
    if (wr == 1) FG_BAR;
    FG_WAIT_V(2); FG_BAR;
    FG_STAGE(FG_SB(1, 0), cB + kstep, vBc); FG_STAGE(FG_SA(1, 0), cA + kstep, vAc); FG_STAGE(FG_SB(1, 1), cB + hBc + kstep, vBc);
    FG_WAIT_V(6); FG_BAR;
    for (;;) {
        const bool has_next = S.next(ui + 1, nxt);
        if (!has_next) nxt = cur;
        FG_OFFS(nxt, vAn, vBn, hAn, hBn);
        const GAS char* nA = nxt.A; const GAS char* nB = nxt.B;
        const int nt = cur.nt;
        for (int t = 0; t < nt; t += 2) {
            const bool last = (t == nt - 2);
            const GAS char* a1 = cA + (size_t)(t + 1) * kstep;
            const GAS char* a2 = last ? nA : cA + (size_t)(t + 2) * kstep; const GAS char* b2 = last ? nB : cB + (size_t)(t + 2) * kstep;
            const GAS char* a3 = a2 + kstep; const GAS char* b3 = b2 + kstep;
            unsigned vA2[2], vB2[2];
#pragma unroll
            for (int _i = 0; _i < 2; ++_i) { vA2[_i] = last ? vAn[_i] : vAc[_i]; vB2[_i] = last ? vBn[_i] : vBc[_i]; }
            const size_t hA2 = last ? hAn : hAc, hB2 = last ? hBn : hBc;
            FG_LDB(B0, 0, 0); FG_LDB(B1, 0, 1); FG_SCHED; FG_LDA(At, 0, 0); FG_STAGE(FG_SA(1, 1), a1 + hAc, vAc);
            FG_WAIT_V(8); FG_WAIT_L(0); FG_BAR; FG_MMA(0, 0, At, B0); FG_MMA(0, 1, At, B1); FG_BAR; FG_SCHED;
            FG_LDA(At, 0, 1); FG_STAGE(FG_SB(0, 0), b2, vB2); FG_STAGE(FG_SB(0, 1), b2 + hB2, vB2); FG_STAGE(FG_SA(0, 0), a2, vA2);
            FG_WAIT_V(8); FG_WAIT_L(0); FG_BAR; FG_MMA(1, 0, At, B0); FG_MMA(1, 1, At, B1); FG_BAR; FG_SCHED;
            FG_LDB(B0, 1, 0); FG_LDB(B1, 1, 1); FG_SCHED; FG_LDA(At, 1, 0); FG_STAGE(FG_SA(0, 1), a2 + hA2, vA2);
            FG_WAIT_V(8); FG_WAIT_L(0); FG_BAR; FG_MMA(0, 0, At, B0); FG_MMA(0, 1, At, B1); FG_BAR; FG_SCHED;
            FG_LDA(At, 1, 1); FG_STAGE(FG_SB(1, 0), b3, vB2); FG_STAGE(FG_SB(1, 1), b3 + hB2, vB2); FG_STAGE(FG_SA(1, 0), a3, vA2);
            FG_WAIT_V(8); FG_WAIT_L(0); FG_BAR; FG_MMA(1, 0, At, B0); FG_MMA(1, 1, At, B1); FG_BAR; FG_SCHED;
        }
        if (wr == 0) FG_BAR;
#pragma unroll
        for (int ai = 0; ai < 2; ++ai)
#pragma unroll
            for (int m = 0; m < 4; ++m)
#pragma unroll
                for (int bj = 0; bj < 2; ++bj) {
                    E.apply(cur, cur.pm * BM + ai * HALF + wr * 64 + m * 16 + fr, cur.pn * BM + bj * HALF + wc * 32 + 8 * fq, acc[ai][bj][m][0], acc[ai][bj][m][1]);
                    if (bj == 1 && (m & 1)) asm volatile("" ::: "memory");
                }
        if (!has_next) break;
#pragma unroll
        for (int a = 0; a < 2; ++a)
#pragma unroll
            for (int b = 0; b < 2; ++b)
#pragma unroll
                for (int m = 0; m < 4; ++m)
#pragma unroll
                    for (int n = 0; n < 2; ++n) acc[a][b][m][n] = (f32x4){0.f, 0.f, 0.f, 0.f};
        cur = nxt; cA = nA; cB = nB; ++ui;
#pragma unroll
        for (int _i = 0; _i < 2; ++_i) { vAc[_i] = vAn[_i]; vBc[_i] = vBn[_i]; }
        hAc = hAn; hBc = hBn;
        if (wr == 1) FG_BAR;
    }
    FG_WAIT_V(0);
    FG_BAR;
#undef FG_SA
#undef FG_SB
#undef FG_STAGE
#undef FG_LDA
#undef FG_LDB
#undef FG_MMA
#undef FG_WAIT_V
#undef FG_WAIT_L
#undef FG_BAR
#undef FG_SCHED
#undef FG_OFFS
}
struct SchedBranch { const gbf* AB; const gbf* WpT; int nM, nN, G, c, pm0;
    __device__ __forceinline__ bool next(int i, Unit& u) const {
        const int nwg = nM * nN; const long L = (long)(i >> 2) * G + c; if (L >= nwg) return false;
        int wgid = (int)L; { const int q = nwg / NXCD, r = nwg % NXCD, xcd = wgid % NXCD, off = wgid / NXCD; wgid = (xcd < r ? xcd * (q + 1) : r * (q + 1) + (xcd - r) * q) + off; }
        const int nig = WGM * nN, gidx = wgid / nig, fm = gidx * WGM, gsz = (nM - fm) < WGM ? (nM - fm) : WGM;
        u.pm = fm + ((wgid % nig) % gsz); u.pn = (wgid % nig) / gsz; u.z = i & 3;
        u.A = (const GAS char*)(AB + (size_t)(pm0 + u.pm) * BM * ABW + u.z * 1024); u.B = (const GAS char*)(WpT + ((size_t)u.z * 2048 + (size_t)u.pn * BM) * KP1); return true;
    }
};
struct SchedIn0 { const gbf* U; const gbf* WinT; int G, c, i0, i1;
    __device__ __forceinline__ bool next(int i, Unit& u) const {
        const int ii = i + i0; if (ii >= i1) return false;
        const int L = ii * G + c; if (L >= 36 * 80) return false;
        const int xcd = L & 7, off = L >> 3; int t, nNc, pn0;
        if (off < 216) { t = xcd * 216 + off; nNc = 48; pn0 = 0; } else { t = xcd * 144 + (off - 216); nNc = 32; pn0 = 48; }
        const int nig = WGM * nNc, gidx = t / nig, fm = gidx * WGM, gsz = (36 - fm) < WGM ? (36 - fm) : WGM;
        u.pm = fm + ((t % nig) % gsz); u.pn = pn0 + (t % nig) / gsz; u.z = 0;
        u.A = (const GAS char*)(U + (size_t)u.pm * BM * KP2); u.B = (const GAS char*)(WinT + (size_t)u.pn * BM * KP2); return true;
    }
};
struct MapPlain { const gbf* A; int lda; const gbf* Bt; int ldb;
    __device__ __forceinline__ const gbf* a(int, int pm) const { return A + (size_t)pm * BM * lda; }
    __device__ __forceinline__ const gbf* b(int, int pn) const { return Bt + (size_t)pn * BM * ldb; } };
}

template <class Epi>
__device__ __forceinline__ void gemm_fast_plain(unsigned char* lds, const GemmJob j, const Epi& E, int gid, int G) {
    __syncthreads();
    fg::Sched<fg::MapPlain> S{fg::MapPlain{j.A, j.lda, j.Bt, j.ldb}, j.M / 256, j.N / 256, 1, G, gid};
    fg::gemm((LAS unsigned char*)lds, j.lda, j.ldb, j.K, S, E);
    __syncthreads();
}

struct MapF1 { const gbf* DC; const gbf* Pfv; int zrows;
    __device__ __forceinline__ const gbf* a(int, int pm) const { return DC + (size_t)pm * 256 * 256; }
    __device__ __forceinline__ const gbf* b(int z, int pn) const { return Pfv + ((size_t)(z >> 2) * zrows + (size_t)pn * 256) * PP + (z & 3) * 256; } };
struct MapF2 { const gbf* DN; const gbf* GT; int ld;
    __device__ __forceinline__ const gbf* a(int, int pm) const { return DN + (size_t)pm * 256 * ld; }
    __device__ __forceinline__ const gbf* b(int z, int pn) const { return GT + ((size_t)z * 1024 + (size_t)pn * 256) * ld; } };
template <class Map, class Epi>
__device__ __forceinline__ void gemm_fast_z(unsigned char* lds, const Map& map, int lda, int ldb, int K, int nM, int nN, int nz, const Epi& E, int c, int Gs) {
    __syncthreads();
    if (c >= 0) { fg::Sched<Map> S{map, nM, nN, nz, Gs, c}; fg::gemm((LAS unsigned char*)lds, lda, ldb, K, S, E); }
    __syncthreads();
}

template <class Epi>
__device__ __forceinline__ void gemm_run(unsigned char* lds, const GemmJob j, const Epi& E, int first, int stride) {
    gemm_fast_plain(lds, j, E, first, stride);
}

struct EpiInProj {
    static constexpr bool PERM = true, CHAIN = false;
    gbf* P; int row0; gbf* NK; gbf* NV; gbf* NQ; gbf* MG;
    __device__ __forceinline__ EpiInProj z(int) const { return *this; }
    __device__ __forceinline__ void operator()(int row, int col, f32x4 a, f32x4 b) const {
        if (col >= C_MG) {
#pragma unroll
            for (int i = 0; i < 4; ++i) { a[i] = sigmoidf_(fminf(fmaxf(a[i], -30.f), 30.f)); b[i] = sigmoidf_(fminf(fmaxf(b[i], -30.f), 30.f)); }
        } else if (col >= C_GCV) {
#pragma unroll
            for (int i = 0; i < 4; ++i) { a[i] = siluf_(a[i]); b[i] = siluf_(b[i]); }
        } else if (col >= C_NAQ && col < C_CB) { a = a * NASCALE; b = b * NASCALE; }
        const int r = row0 + row;
        if (col >= C_MG) { const int cc = col - C_MG; __builtin_nontemporal_store(pk8(a, b), (GAS u32x4*)(MG + mg_off(cc >> 11, r, cc & 2047))); }
        else if (col >= C_NAK && col < C_CB && !(col >= C_QL && col < C_NAQ)) {
            const int sel = (col < C_NAV) ? 0 : (col < C_QL) ? 1 : 2, cc = (col < C_NAV) ? col - C_NAK : (col < C_QL) ? col - C_NAV : col - C_NAQ;
            __builtin_nontemporal_store(pk8(a, b), (GAS u32x4*)(NK + (size_t)sel * ((WS_NV - WS_NK) / 2) + hm_row(r, cc >> 6, 16) * 64 + (cc & 63)));
        } else __builtin_nontemporal_store(pk8(a, b), (GAS u32x4*)(P + (size_t)r * PP + col));
    }
};
struct EpiInProjC1 {
    static constexpr bool PERM = true, CHAIN = false;
    gbf* P; gbf* NK; gbf* KM; gf32* SSQ;
    __device__ __forceinline__ EpiInProjC1 z(int) const { return *this; }
    __device__ __forceinline__ void operator()(int row, int col, f32x4 a, f32x4 b) const {
        const int r = NLAT + row;
        if (col < 256) {
            *(GAS u32x4*)(P + (size_t)r * PP + col) = pk8(a, b);
            float s = a[0] * a[0] + a[1] * a[1] + a[2] * a[2] + a[3] * a[3] + b[0] * b[0] + b[1] * b[1] + b[2] * b[2] + b[3] * b[3];
            s += __shfl_xor(s, 16); s += __shfl_xor(s, 32);
            if ((col & 31) == 0) SSQ[(size_t)row * 8 + (col >> 5)] = s;
        } else if (col < 512) {
            if (col < 320) { const u32x4 v = pk8(a, b);
#pragma unroll
                for (int h = 0; h < 8; ++h) *(GAS u32x4*)(KM + hm_row(r, h, 8) * 192 + 128 + (col - 256)) = v; }
        } else {
            const int sel = (col < C_NAV) ? 0 : 1, cc = (col < C_NAV) ? col - C_NAK : col - C_NAV;
            *(GAS u32x4*)(NK + (size_t)sel * ((WS_NV - WS_NK) / 2) + hm_row(r, cc >> 6, 16) * 64 + (cc & 63)) = pk8(a, b);
        }
    }
};
struct EpiKvUp {
    static constexpr bool PERM = true, CHAIN = false;
    gbf* KM; gbf* VM; const gf32* rstd; int row0;
    __device__ __forceinline__ EpiKvUp z(int) const { return *this; }
    __device__ __forceinline__ void operator()(int row, int col, f32x4 a, f32x4 b) const {
        const int r = row0 + row, h = col >> 8, jj = col & 255; const float s = rstd[r];
        const size_t hr = hm_row(r, h, 8); gbf* p = (jj < 128) ? KM + hr * 192 + jj : VM + hr * 128 + (jj - 128);
        *(GAS u32x4*)p = pk8(a * s, b * s);
    }
};
struct EpiQUp {
    static constexpr bool PERM = false, CHAIN = false;
    gbf* QM; const gf32* rstd; const gf32* rope; int row0;
    __device__ __forceinline__ EpiQUp z(int) const { return *this; }
    __device__ __forceinline__ void operator()(int row, int col, f32x4 a, f32x4 b) const {
        const int r = row0 + row, h = col / 192, jj = col - h * 192; const float s = rstd[r] * QSCALE;
        a = a * s; b = b * s;
        if (jj >= 128 && r < NLAT) {
            const int t = r & (SEQ - 1), e = jj - 128, pos = (e < 32) ? (t >> 6) : (t & 63), f0 = e & 15;
            const gf32* rp = rope + (pos * 16 + f0) * 2;
#pragma unroll
            for (int i = 0; i < 4; ++i) { const float c = rp[2 * i], sn = rp[2 * i + 1]; const float x = a[i], y = b[i]; a[i] = x * c - y * sn; b[i] = x * sn + y * c; }
        }
        gbf* p = QM + hm_row(r, h, 8) * 192 + jj;
        *(GAS u32x2*)p = pk4(a); *(GAS u32x2*)(p + 16) = pk4(b);
    }
};
struct EpiF1 {
    static constexpr bool PERM = true, CHAIN = false;
    gbf* GT; int S; int g;
    __device__ __forceinline__ EpiF1 z(int zz) const { return EpiF1{GT + (size_t)(zz >> 2) * 1024 * 2 * S, S, zz & 3}; }
    __device__ __forceinline__ void operator()(int row, int col, f32x4 a, f32x4 b) const {
        *(GAS u32x4*)(GT + (size_t)(g * 256 + (row & 255)) * (2 * S) + (row >> 8) * S + col) = pk8(a, b);
    }
};
struct EpiF2 {
    static constexpr bool PERM = true, CHAIN = false;
    gbf* AB; const gbf* P; int row0; int zrows;
    __device__ __forceinline__ EpiF2 z(int zz) const { return EpiF2{AB, P, row0 + zz * zrows, zrows}; }
    __device__ __forceinline__ void operator()(int row, int col, f32x4 a, f32x4 b) const {
        const size_t r = (size_t)(row0 + row);
        f32x4 ga, gb; unpk8(*(const GAS u32x4*)(P + r * PP + C_GFN + col), ga, gb);
        *(GAS u32x4*)(AB + r * ABW + 3072 + col) = pk8(a * ga, b * gb);
    }
};
struct EpiF2M {
    static constexpr bool PERM = true, CHAIN = false;
    gbf* AB; const gbf* P; int row0; int zrows;
    __device__ __forceinline__ EpiF2M z(int zz) const { return EpiF2M{AB, P, row0 + zz * zrows, zrows}; }
    __device__ __forceinline__ void operator()(int row, int col, f32x4 a, f32x4 b) const {
        const size_t r = (size_t)(row0 + row);
        f32x4 ga, gb; unpk8(*(const GAS u32x4*)(P + r * PP + C_GFN + col), ga, gb);
        *(GAS u32x4*)(AB + r * ABW + 3072 + col) = pk8(a * ga, b * gb);
        if (row != 0) {
            const size_t rm = (size_t)(row0 + SEQ - row); const int gbase = col & ~255, c = col & 255;
            const int cA = gbase + 248 - c, cB = gbase + ((256 - c) & 255);
            f32x4 xa, xb, ya, yb; unpk8(*(const GAS u32x4*)(P + rm * PP + C_GFN + cA), xa, xb); unpk8(*(const GAS u32x4*)(P + rm * PP + C_GFN + cB), ya, yb);
            gbf* o = AB + rm * ABW + 3072;
            *(GAS unsigned short*)(o + cA + 1) = (unsigned short)f2bf(b[3] * xa[1]);
            *(GAS unsigned*)(o + cA + 2) = pk2(b[2] * xa[2], b[1] * xa[3]);
            *(GAS unsigned*)(o + cA + 4) = pk2(b[0] * xb[0], a[3] * xb[1]);
            *(GAS unsigned*)(o + cA + 6) = pk2(a[2] * xb[2], a[1] * xb[3]);
            *(GAS unsigned short*)(o + cB) = (unsigned short)f2bf(a[0] * ya[0]);
            (void)yb;
        }
    }
};
struct EpiBranch {
    static constexpr bool PERM = true, CHAIN = false;
    gf32* MF; gbf* MB; const gbf* P; int i; int row0;
    __device__ __forceinline__ EpiBranch z(int) const { return *this; }
    __device__ __forceinline__ void operator()(int row, int col, f32x4 a, f32x4 b) const {
        const size_t r = (size_t)(row0 + row);
        f32x4 ga, gb; unpk8(*(const GAS u32x4*)(P + r * PP + C_MG + i * DM + col), ga, gb);
        gf32* m = MF + r * DM + col;
        f32x4 va = a * ga, vb = b * gb;
        if (i > 0) { va += *(const GAS f32x4*)m; vb += *(const GAS f32x4*)(m + 4); }
        if (i < 3) { *(GAS f32x4*)m = va; *(GAS f32x4*)(m + 4) = vb; }
        else *(GAS u32x4*)(MB + r * DM + col) = pk8(va, vb);
    }
};
struct EpiChain {
    static constexpr bool PERM = true, CHAIN = true;
    gbf* MB; const gbf* P; int row0;
    __device__ __forceinline__ EpiChain z(int) const { return *this; }
    __device__ __forceinline__ void chain(int row, int col, f32x4& a, f32x4& b, int zz) const {
        const size_t r = (size_t)(row0 + row);
        if (zz < 3) {
            f32x4 ga, gb, ha, hb; unpk8(__builtin_nontemporal_load((const GAS u32x4*)(P + mg_off(zz, (int)r, col))), ga, gb); unpk8(__builtin_nontemporal_load((const GAS u32x4*)(P + mg_off(zz + 1, (int)r, col))), ha, hb);
#pragma unroll
            for (int i = 0; i < 4; ++i) { a[i] *= ga[i] * __builtin_amdgcn_rcpf(ha[i]); b[i] *= gb[i] * __builtin_amdgcn_rcpf(hb[i]); }
        } else {
            f32x4 ga, gb; unpk8(__builtin_nontemporal_load((const GAS u32x4*)(P + mg_off(3, (int)r, col))), ga, gb);
            *(GAS u32x4*)(MB + r * KP2 + col) = pk8(a * ga, b * gb);
        }
    }
};
struct EpiOut {
    static constexpr bool PERM = true, CHAIN = false;
    gf32* Y; int row0;
    __device__ __forceinline__ EpiOut z(int) const { return *this; }
    __device__ __forceinline__ void operator()(int row, int col, f32x4 a, f32x4 b) const {
        gf32* p = Y + (size_t)(row0 + row) * DM + col; *(GAS f32x4*)p = a; *(GAS f32x4*)(p + 4) = b;
    }
};

struct EpiC2 {
    gbf* KM; gbf* VM; gbf* QM; gbf* GT; gbf* GTC; const gf32* RKV; const gf32* RQ; const gf32* rope; const gf32* SSQ;
    __device__ __forceinline__ void apply(const fg::UnitM& u, int row, int col, f32x4 a, f32x4 b) const {
        if (u.job == 0) {
            const int h = col >> 8, jj = col & 255; float s;
            if (SSQ != nullptr && row >= NLAT) { const f32x4 s0 = *(const GAS f32x4*)(SSQ + (size_t)(row - NLAT) * 8), s1 = *(const GAS f32x4*)(SSQ + (size_t)(row - NLAT) * 8 + 4);
                s = rsqrtf(((s0[0] + s0[1]) + (s0[2] + s0[3]) + (s1[0] + s1[1]) + (s1[2] + s1[3])) * (1.0f / 256.0f) + EPS); }
            else s = RKV[row];
            const size_t hr = hm_row(row, h, 8); gbf* p = (jj < 128) ? KM + hr * 192 + jj : VM + hr * 128 + (jj - 128);
            *(GAS u32x4*)p = pk8(a * s, b * s);
        } else if (u.job == 1) {
            const int h = col / 192, jj = col - h * 192; const float s = RQ[row] * QSCALE;
            a = a * s; b = b * s;
            if (jj >= 128 && row < NLAT) {
                const int t = row & (SEQ - 1), e = jj - 128, pos = (e < 32) ? (t >> 6) : (t & 63), f0 = e & 15; const bool second = (e & 16) != 0;
                const gf32* rp = rope + (pos * 16 + f0) * 2;
                const f32x4 cs0 = *(const GAS f32x4*)rp, cs1 = *(const GAS f32x4*)(rp + 4), cs2 = *(const GAS f32x4*)(rp + 8), cs3 = *(const GAS f32x4*)(rp + 12);
                const float cc[8] = {cs0[0], cs0[2], cs1[0], cs1[2], cs2[0], cs2[2], cs3[0], cs3[2]}, ss[8] = {cs0[1], cs0[3], cs1[1], cs1[3], cs2[1], cs2[3], cs3[1], cs3[3]};
#pragma unroll
                for (int i = 0; i < 4; ++i) { const float ya = __shfl_xor(a[i], 32), yb = __shfl_xor(b[i], 32);
                    a[i] = second ? (ya * ss[i] + a[i] * cc[i]) : (a[i] * cc[i] - ya * ss[i]);
                    b[i] = second ? (yb * ss[4 + i] + b[i] * cc[4 + i]) : (b[i] * cc[4 + i] - yb * ss[4 + i]); }
            }
            *(GAS u32x4*)(QM + hm_row(row, h, 8) * 192 + jj) = pk8(a, b);
        } else {
            const int S_ = (u.job == 2) ? SEQ : CTXL, ld_ = (u.job == 2) ? KP4 : 2 * CTXL; gbf* G_ = (u.job == 2) ? GT : GTC; const int bb = u.z >> 2, g = u.z & 3;
            *(GAS u32x4*)(G_ + (size_t)bb * 1024 * ld_ + (size_t)(g * 256 + (row & 255)) * ld_ + (row >> 8) * S_ + col) = pk8(a, b);
        }
    }
};
struct SchedC2 {
    const gbf* P; const gbf* WukvT; const gbf* WuqT; const gbf* DC; int nq_tiles, n3, G, c;
    __device__ __forceinline__ bool next(int i, fg::UnitM& u) const {
        int L = i * G + c; const int n0 = (NROW / 256) * 8, n1 = nq_tiles * 6, n2 = 16 * 2 * 8;
        if (L < n0) { u.job = 0; u.pm = L >> 3; u.pn = L & 7; u.z = 0; u.lda = PP; u.ldb = 256; u.nt = 4;
            u.A = (const GAS char*)(P + (size_t)u.pm * 256 * PP + C_CKV); u.B = (const GAS char*)(WukvT + (size_t)u.pn * 256 * 256); return true; }
        L -= n0;
        if (L < n1) { u.job = 1; u.pm = L / 6; u.pn = L % 6; u.z = 0; u.lda = PP; u.ldb = 512; u.nt = 8;
            u.A = (const GAS char*)(P + (size_t)u.pm * 256 * PP + C_QL); u.B = (const GAS char*)(WuqT + (size_t)u.pn * 256 * 512); return true; }
        L -= n1;
        if (L < n2) { u.job = 2; u.z = L >> 4; u.pm = (L >> 3) & 1; u.pn = L & 7; u.lda = 256; u.ldb = PP; u.nt = 4;
            u.A = (const GAS char*)(DC + (size_t)u.pm * 256 * 256); u.B = (const GAS char*)(P + ((size_t)(u.z >> 2) * SEQ + (size_t)u.pn * 256) * PP + C_FV + (u.z & 3) * 256); return true; }
        L -= n2;
        if (L < n3) { u.job = 3; u.z = L >> 1; u.pm = L & 1; u.pn = 0; u.lda = 256; u.ldb = PP; u.nt = 4;
            u.A = (const GAS char*)(DC + (size_t)u.pm * 256 * 256); u.B = (const GAS char*)(P + ((size_t)NLAT + (size_t)(u.z >> 2) * CTXL) * PP + C_FV + (u.z & 3) * 256); return true; }
        return false;
    }
};

struct TrItem { const gf32* W; gbf* WT; const gf32* ks; int N, ldt, k0, n0, nd0; };
constexpr int TR_IN = 32 * 634, TR_KV = 4 * 64, TR_Q = 8 * 48, TR_P = 16 * 64, TR_O = 32 * 64;
constexpr int TR_PER_L = TR_IN + TR_KV + TR_Q + 4 * TR_P + TR_O;
__device__ __forceinline__ TrItem tr_decode(int it) {
    gu8* ws = wsb();
    const int l = it / TR_PER_L; int r = it % TR_PER_L;
    const gf32* W; gbf* WT; const gf32* ks = nullptr; int K, N, ldt; bool remap = false;
    if (r < TR_IN) { W = pin(I_WIN) + (size_t)l * DM * N_IN; K = DM; N = N_IN; WT = (gbf*)(ws + WS_WIN) + (size_t)l * NP * KP2; ldt = KP2; remap = true; }
    else if ((r -= TR_IN) < TR_KV) { W = pin(I_WUKV) + (size_t)l * 256 * 2048; K = 256; N = 2048; WT = (gbf*)(ws + WS_WUKV) + (size_t)l * 2048 * 256; ldt = 256; ks = pin(I_GKV) + l * 256; }
    else if ((r -= TR_KV) < TR_Q) { W = pin(I_WUQ) + (size_t)l * 512 * 1536; K = 512; N = 1536; WT = (gbf*)(ws + WS_WUQ) + (size_t)l * 1536 * 512; ldt = 512; ks = pin(I_GQ) + l * 512; }
    else if ((r -= TR_Q) < 4 * TR_P) { const int b = r / TR_P; r = r % TR_P; W = pin(I_WPC + b) + (size_t)l * 1024 * 2048; K = 1024; N = 2048; WT = (gbf*)(ws + WS_WP) + ((size_t)l * 4 + b) * 2048 * KP1; ldt = KP1; }
    else { r -= 4 * TR_P; W = pin(I_WOUT) + (size_t)l * 2048 * 2048; K = 2048; N = 2048; WT = (gbf*)(ws + WS_WO) + (size_t)l * 2048 * KP2; ldt = KP2; }
    (void)K;
    const int nblk = N / 32, kb = r / nblk, nb = r % nblk, n0 = 32 * nb;
    return TrItem{W, WT, ks, N, ldt, 64 * kb, n0, (remap && n0 >= 320) ? n0 + 192 : n0};
}
__device__ __forceinline__ void tr_load(const TrItem& t, float (&v)[32], int lane) {
    const gf32* src = t.W + (size_t)(t.k0 + (lane >> 5)) * t.N + t.n0 + (lane & 31);
#pragma unroll
    for (int i = 0; i < 32; ++i) v[i] = __builtin_nontemporal_load(src + (size_t)(2 * i) * t.N);
}
__device__ __forceinline__ void tr_to_lds(const TrItem& t, const float (&v)[32], int lane, float* scr) {
    if (t.ks != nullptr) {
#pragma unroll
        for (int i = 0; i < 32; ++i) { const int kk = 2 * i + (lane >> 5); scr[kk * 33 + (lane & 31)] = v[i] * t.ks[t.k0 + kk]; }
    } else {
#pragma unroll
        for (int i = 0; i < 32; ++i) { const int kk = 2 * i + (lane >> 5); scr[kk * 33 + (lane & 31)] = v[i]; }
    }
    __builtin_amdgcn_fence(__ATOMIC_RELEASE, "wavefront"); asm volatile("s_waitcnt lgkmcnt(0)" ::: "memory");
}
__device__ __forceinline__ void tr_store(const TrItem& t, int lane, const float* scr) {
    const int c = lane & 7;
#pragma unroll
    for (int j = 0; j < 4; ++j) { const int n = (lane >> 3) + 8 * j; const float* s = scr + (8 * c) * 33 + n;
        u32x4 o; o.x = pk2(s[0 * 33], s[1 * 33]); o.y = pk2(s[2 * 33], s[3 * 33]); o.z = pk2(s[4 * 33], s[5 * 33]); o.w = pk2(s[6 * 33], s[7 * 33]);
        __builtin_nontemporal_store(o, (GAS u32x4*)(t.WT + (size_t)(t.nd0 + n) * t.ldt + t.k0 + 8 * c)); }
    asm volatile("s_waitcnt lgkmcnt(0)" ::: "memory");
}
__device__ __forceinline__ void weight_transposes(unsigned char* lds, int beg, int end, int gw, int ngw) {
    const int tid = tid_op(), lane = tid & 63, wid = tid >> 6;
    float* scr = (float*)lds + wid * (64 * 33);
    int it = beg + gw;
    if (it >= end) return;
    float v[32];
    TrItem cur = tr_decode(it);
    tr_load(cur, v, lane);
    while (true) {
        tr_to_lds(cur, v, lane, scr);
        const int nit = it + ngw; const bool more = nit < end;
        TrItem nx = cur;
        if (more) { nx = tr_decode(nit); tr_load(nx, v, lane); }
        tr_store(cur, lane, scr);
        if (!more) break;
        cur = nx; it = nit;
    }
}

__device__ __forceinline__ void phase0(const Params& p, unsigned char* lds, int gid, int G) {
    const int tid = tid_op(), lane = tid & 63, wid = tid >> 6;
    gu8* ws = wsb();
    {
        float* sv = (float*)lds;
        float* part = sv + 5 * 2048;
        bool have = false;
        for (int it = gid; it < 2 * 96; it += G) {
            if (!have) {
                for (int i = tid; i < 5 * 2048; i += NTHREADS) { const float v = (i < 4 * 2048) ? pin(I_C)[i] : pin(I_CCTX)[i - 4 * 2048]; sv[i] = siluf_(v); }
                have = true;
            }
            __syncthreads();
            const int l = it / 96, nb = it % 96;
            const gf32* W = pin(I_WADA) + (size_t)l * DM * 6144 + nb * 64 + lane;
            float a0 = 0.f, a1 = 0.f, a2 = 0.f, a3 = 0.f, a4 = 0.f;
#pragma unroll 8
            for (int k = wid * 256; k < wid * 256 + 256; ++k) {
                const float w = W[(size_t)k * 6144];
                a0 = fmaf(sv[k], w, a0); a1 = fmaf(sv[2048 + k], w, a1); a2 = fmaf(sv[4096 + k], w, a2); a3 = fmaf(sv[6144 + k], w, a3); a4 = fmaf(sv[8192 + k], w, a4);
            }
            part[(wid * 5 + 0) * 64 + lane] = a0; part[(wid * 5 + 1) * 64 + lane] = a1; part[(wid * 5 + 2) * 64 + lane] = a2; part[(wid * 5 + 3) * 64 + lane] = a3; part[(wid * 5 + 4) * 64 + lane] = a4;
            __syncthreads();
            if (tid < 320) {
                const int r = tid / 64, cidx = tid % 64; float s = 0.f;
#pragma unroll
                for (int w = 0; w < 8; ++w) s += part[(w * 5 + r) * 64 + cidx];
                const int n = nb * 64 + cidx;
                ((gf32*)(ws + WS_MOD))[((size_t)l * 5 + r) * 6144 + n] = s + pin(I_BADA)[(size_t)l * 6144 + n];
            }
        }
        __syncthreads();
    }
    {
        const long gt = (long)gid * NTHREADS + tid, NT = (long)G * NTHREADS;
        gf32* rope = (gf32*)(ws + WS_ROPE);
        for (long i = gt; i < 64 * 16; i += NT) { const int pos = (int)(i >> 4), f = (int)(i & 15); const float inv = exp2f(-(float)f * (13.287712379549449f / 16.0f)); const float ang = (float)pos * inv;
            rope[2 * i] = cosf(ang); rope[2 * i + 1] = sinf(ang); }
        gbf* DC = (gbf*)(ws + WS_DC);
        for (long i = gt; i < 512 * 256; i += NT) { const int m = (int)(i >> 8), k = (int)(i & 255); const int jdx = ((m & 255) * k) & 255; const float ang = (float)jdx * (6.283185307179586f / 256.0f);
            DC[i] = (bf16_t)f2bf((m < 256 ? cosf(ang) : sinf(ang)) * 0.0625f); }
        gbf* DN = (gbf*)(ws + WS_DN);
        for (long i = gt; i < (long)2048 * 4096; i += NT) { const int n = (int)(i >> 12), k = (int)(i & 4095); const int jdx = (n * (k & 2047)) & 2047; const float ang = (float)jdx * (6.283185307179586f / 2048.0f);
            DN[(size_t)n * KP4 + k] = (bf16_t)f2bf((k < 2048 ? cosf(ang) : -sinf(ang)) * 0.02209708691207961f); }
        gbf* DNC = (gbf*)(ws + WS_DNC);
        for (long i = gt; i < 256 * 512; i += NT) { const int n = (int)(i >> 9), k = (int)(i & 511); const int jdx = (n * (k & 255)) & 255; const float ang = (float)jdx * (6.283185307179586f / 256.0f);
            DNC[i] = (bf16_t)f2bf((k < 256 ? cosf(ang) : -sinf(ang)) * 0.0625f); }
        for (long i = gt; i < (long)2 * 192 * DM / 8; i += NT) { const int l = (int)(i / (192 * DM / 8)); const long r = i % (192 * DM / 8);
            *(GAS u32x4*)((gbf*)(ws + WS_WIN) + (size_t)l * NP * KP2 + (size_t)(320 + r / (DM / 8)) * KP2 + (r % (DM / 8)) * 8) = (u32x4){0u, 0u, 0u, 0u}; }
    }
    weight_transposes(lds, 0, (G == 256) ? TR_PER_L : 2 * TR_PER_L, gid * NWAVES + wid, G * NWAVES);
}

__device__ __forceinline__ void u_row(const f32x4 (&v)[8], float rstd, const gf32* gpre, const gf32* mod  , gbf* urow, int lane) {
#pragma unroll
    for (int j = 0; j < 8; ++j) { const int c = 4 * lane + 256 * j;
        const f32x4 g = *(const GAS f32x4*)(gpre + c), sh = *(const GAS f32x4*)(mod + c), sc = *(const GAS f32x4*)(mod + 2048 + c);
        const f32x4 o = v[j] * rstd * g * (sc + 1.0f) + sh;
        *(GAS u32x2*)(urow + c) = pk4(o); }
}
__device__ __forceinline__ void phase_uprep0(const Params& p, int gid, int G) {
    const int tid = tid_op(), lane = tid & 63, gw = gid * NWAVES + (tid >> 6), NGW = G * NWAVES;
    const gf32* mod0 = (const gf32*)(wsb() + WS_MOD);
    gbf* U = (gbf*)(wsb() + WS_U);
    for (int r = gw; r < NROW; r += NGW) {
        const gf32* xr = (r < NLAT) ? pin(I_X) + (size_t)r * DM : pin(I_CTX) + (size_t)(r - NLAT) * DM;
        const int mr = (r < NLAT) ? (r >> 11) : 4;
        f32x4 v[8]; float s = 0.f;
#pragma unroll
        for (int j = 0; j < 8; ++j) { v[j] = *(const GAS f32x4*)(xr + 4 * lane + 256 * j); s += v[j][0] * v[j][0] + v[j][1] * v[j][1] + v[j][2] * v[j][2] + v[j][3] * v[j][3]; }
        const float rstd = rsqrtf(wave_sum(s) * (1.0f / DM) + EPS);
        u_row(v, rstd, pin(I_GPRE), mod0 + (size_t)mr * 6144, U + (size_t)r * KP2, lane);
    }
}
__device__ __forceinline__ void phase_final(const Params& p, int l, int rbeg, int rend, int cu, int ncu) {
    const int tid = tid_op(), lane = tid & 63, gw = rbeg + cu * NWAVES + (tid >> 6), NGW = ncu * NWAVES;
    const gf32* mod = (const gf32*)(wsb() + WS_MOD) + (size_t)l * 5 * 6144;
    const gf32* Y = (const gf32*)(wsb() + WS_Y);
    gf32* XL = (gf32*)(wsb() + WS_XL);
    gbf* U = (gbf*)(wsb() + WS_U);
    const int nrows = rend;
    auto xrow = [&](int r) -> const gf32* { return (l == 0) ? ((r < NLAT) ? pin(I_X) + (size_t)r * DM : pin(I_CTX) + (size_t)(r - NLAT) * DM) : XL + (size_t)r * DM; };
    f32x4 y[8], x[8], yn[8], xn[8];
    if (gw < nrows) { const gf32* yr = Y + (size_t)gw * DM; const gf32* xr = xrow(gw);
#pragma unroll
        for (int j = 0; j < 8; ++j) { y[j] = *(const GAS f32x4*)(yr + 4 * lane + 256 * j); x[j] = *(const GAS f32x4*)(xr + 4 * lane + 256 * j); } }
    for (int r = gw; r < nrows; r += NGW) {
        const int rn = r + NGW;
        if (rn < nrows) { const gf32* yr = Y + (size_t)rn * DM; const gf32* xr = xrow(rn);
#pragma unroll
            for (int j = 0; j < 8; ++j) { yn[j] = *(const GAS f32x4*)(yr + 4 * lane + 256 * j); xn[j] = *(const GAS f32x4*)(xr + 4 * lane + 256 * j); } }
        const int mr = (r < NLAT) ? (r >> 11) : 4;
        gf32* orow = (l == 0) ? XL + (size_t)r * DM : pout() + (size_t)r * DM;
        float s = 0.f;
#pragma unroll
        for (int j = 0; j < 8; ++j) s += y[j][0] * y[j][0] + y[j][1] * y[j][1] + y[j][2] * y[j][2] + y[j][3] * y[j][3];
        const float rstd = rsqrtf(wave_sum(s) * (1.0f / DM) + EPS);
        float s2 = 0.f;
#pragma unroll
        for (int j = 0; j < 8; ++j) { const int c = 4 * lane + 256 * j;
            const f32x4 g = *(const GAS f32x4*)(pin(I_GPOST) + (size_t)l * DM + c), gt = *(const GAS f32x4*)(mod + (size_t)mr * 6144 + 4096 + c);
            const f32x4 o = x[j] + gt * (y[j] * rstd * g);
            *(GAS f32x4*)(orow + c) = o; y[j] = o; s2 += o[0] * o[0] + o[1] * o[1] + o[2] * o[2] + o[3] * o[3]; }
        if (l == 0) {
            const float rstd2 = rsqrtf(wave_sum(s2) * (1.0f / DM) + EPS);
            u_row(y, rstd2, pin(I_GPRE) + DM, mod + 5 * 6144 + (size_t)mr * 6144, U + (size_t)r * KP2, lane);
        }
#pragma unroll
        for (int j = 0; j < 8; ++j) { y[j] = yn[j]; x[j] = xn[j]; }
    }
}
__device__ __forceinline__ void c1_loadz(const gbf* pr, bool ok, int lane, f32x4 (&z)[4]) {
#pragma unroll
    for (int j = 0; j < 4; ++j) { const int c = 4 * lane + 256 * j;
        if (ok) z[j] = unpk4(*(const GAS u32x2*)(pr + C_CC + c)) * unpk4(*(const GAS u32x2*)(pr + C_CX + c)); else z[j] = (f32x4){0.f, 0.f, 0.f, 0.f}; }
}
__device__ __forceinline__ void phase_c1(const Params& p, int l, int nrows, int gid, int G) {
    const int tid = tid_op(), lane = tid & 63, gw = gid * NWAVES + (tid >> 6), NGW = G * NWAVES;
    const gbf* P = (const gbf*)(wsb() + WS_P);
    gbf* KM = (gbf*)(wsb() + WS_KM); gbf* AB = (gbf*)(wsb() + WS_AB);
    gf32* RKV = (gf32*)(wsb() + WS_RKV); gf32* RQ = (gf32*)(wsb() + WS_RQ);
    const gf32* rope = (const gf32*)(wsb() + WS_ROPE);
    const gf32* cw = pin(I_CONVW) + (size_t)l * 3 * 1024;
    const int chunk = (nrows + NGW - 1) / NGW, rbeg = gw * chunk, rend = min(rbeg + chunk, nrows);
    if (rbeg >= rend) return;
    f32x4 w0[4], w1[4], w2[4];
#pragma unroll
    for (int j = 0; j < 4; ++j) { const int c = 4 * lane + 256 * j; w0[j] = *(const GAS f32x4*)(cw + c); w1[j] = *(const GAS f32x4*)(cw + 1024 + c); w2[j] = *(const GAS f32x4*)(cw + 2048 + c); }
    auto seqpos = [](int r, int& t, int& slen) { if (r < NLAT) { t = r & (SEQ - 1); slen = SEQ; } else { t = (r - NLAT) & (CTXL - 1); slen = CTXL; } };
    f32x4 zp[4], zc[4], zn[4];
    { int t, slen; seqpos(rbeg, t, slen); const bool full0 = (rbeg < NLAT) || (l == 0);
      c1_loadz(P + (size_t)(rbeg - 1) * PP, full0 && t > 0, lane, zp); c1_loadz(P + (size_t)rbeg * PP, full0, lane, zc); (void)slen; }
    for (int r = rbeg; r < rend; ++r) {
        const gbf* pr = P + (size_t)r * PP;
        const bool full = (r < NLAT) || (l == 0);
        int t, slen; seqpos(r, t, slen);
        c1_loadz(pr + PP, (r + 1 < NROW) && ((r + 1 < NLAT) || (l == 0)), lane, zn);
        const float mp = (t > 0) ? 1.f : 0.f, mn = (t < slen - 1) ? 1.f : 0.f;
        const u32x2 ckv = *(const GAS u32x2*)(pr + C_CKV + 4 * lane);
        u32x2 q0 = {0u, 0u}, q1 = {0u, 0u}, cb[4], gc[4];
        if (full) { q0 = *(const GAS u32x2*)(pr + C_QL + 4 * lane); q1 = *(const GAS u32x2*)(pr + C_QL + 256 + 4 * lane);
#pragma unroll
            for (int j = 0; j < 4; ++j) { const int c = 4 * lane + 256 * j; cb[j] = *(const GAS u32x2*)(pr + C_CB + c); gc[j] = *(const GAS u32x2*)(pr + C_GCV + c); } }
        float x = bf2f(pr[C_KR + lane]);
        float rc = 1.f, rsn = 0.f;
        if (r < NLAT) { const int tt = r & (SEQ - 1), pos = (lane < 32) ? (tt >> 6) : (tt & 63), f = lane & 15; rc = rope[(pos * 16 + f) * 2]; rsn = rope[(pos * 16 + f) * 2 + 1]; }
        { const f32x4 v = unpk4(ckv); const float s = wave_sum(v[0] * v[0] + v[1] * v[1] + v[2] * v[2] + v[3] * v[3]);
          if (lane == 0) RKV[r] = rsqrtf(s * (1.0f / 256.0f) + EPS); }
        if (full) { const f32x4 v0 = unpk4(q0), v1 = unpk4(q1);
          const float s = wave_sum(v0[0] * v0[0] + v0[1] * v0[1] + v0[2] * v0[2] + v0[3] * v0[3] + v1[0] * v1[0] + v1[1] * v1[1] + v1[2] * v1[2] + v1[3] * v1[3]);
          if (lane == 0) RQ[r] = rsqrtf(s * (1.0f / 512.0f) + EPS); }
        {
          const float y = __shfl_xor(x, 16);
          x = (lane & 16) ? (y * rsn + x * rc) : (x * rc - y * rsn);
          const bf16_t o = (bf16_t)f2bf(x);
#pragma unroll
          for (int h = 0; h < 8; ++h) KM[hm_row(r, h, 8) * 192 + 128 + lane] = o; }
        if (full) {
#pragma unroll
          for (int j = 0; j < 4; ++j) { const int c = 4 * lane + 256 * j;
              const f32x4 o = (zp[j] * (w0[j] * mp) + zc[j] * w1[j] + zn[j] * (w2[j] * mn)) * unpk4(cb[j]) * unpk4(gc[j]);
              *(GAS u32x2*)(AB + (size_t)r * ABW + c) = pk4(o); } }
#pragma unroll
        for (int j = 0; j < 4; ++j) { zp[j] = zc[j]; zc[j] = zn[j]; }
    }
}

namespace fa {
typedef float f32x16 __attribute__((ext_vector_type(16)));
typedef short s16x4 __attribute__((ext_vector_type(4)));
constexpr float THRL = 8.0f;
__device__ __forceinline__ int crow(int r, int hi) { return (r & 3) + 8 * (r >> 2) + 4 * hi; }
__device__ __forceinline__ unsigned cvtpk(float lo, float hi) { unsigned r; asm volatile("v_cvt_pk_bf16_f32 %0, %1, %2" : "=v"(r) : "v"(lo), "v"(hi)); return r; }
template <int OFF> __device__ __forceinline__ s16x4 tr_read(int vb) { s16x4 r; asm volatile("ds_read_b64_tr_b16 %0, %1 offset:%2" : "=&v"(r) : "v"(vb), "i"(OFF) : "memory"); return r; }
__device__ __forceinline__ int v_rd_base(int lane) { return ((lane & 3) << 3) | (((lane >> 2) & 3) << 6) | (((lane >> 4) & 1) << 5) | (((lane >> 5) & 1) << 8); }
template <int NCB, int D0> __device__ __forceinline__ void pv_one(f32x16& od, int vb, bf16x8 pa0, bf16x8 pa1, bf16x8 pa2, bf16x8 pa3) {
    constexpr int KS = 2 * NCB * 512, HF = NCB * 512, B = D0 * 512;
    const s16x4 l0 = tr_read<B + 0 * KS>(vb), h0 = tr_read<B + 0 * KS + HF>(vb), l1 = tr_read<B + 1 * KS>(vb), h1 = tr_read<B + 1 * KS + HF>(vb);
    const s16x4 l2 = tr_read<B + 2 * KS>(vb), h2 = tr_read<B + 2 * KS + HF>(vb), l3 = tr_read<B + 3 * KS>(vb), h3 = tr_read<B + 3 * KS + HF>(vb);
    asm volatile("s_waitcnt lgkmcnt(0)" ::: "memory"); __builtin_amdgcn_sched_barrier(0);
#define FA_PK(L, H) (bf16x8){L[0], L[1], L[2], L[3], H[0], H[1], H[2], H[3]}
    od = __builtin_amdgcn_mfma_f32_32x32x16_bf16(pa0, FA_PK(l0, h0), od, 0, 0, 0);
    od = __builtin_amdgcn_mfma_f32_32x32x16_bf16(pa1, FA_PK(l1, h1), od, 0, 0, 0);
    od = __builtin_amdgcn_mfma_f32_32x32x16_bf16(pa2, FA_PK(l2, h2), od, 0, 0, 0);
    od = __builtin_amdgcn_mfma_f32_32x32x16_bf16(pa3, FA_PK(l3, h3), od, 0, 0, 0);
#undef FA_PK
}
struct Desc {
    const gbf* Q; int ldq;
    const gbf* K; int ldk;
    const gbf* V; int ldv;
    int row0a, nta, row0b, NT;
    const gbf* G; int ldg;
    gbf* O; int ldo;
    int r0, wr0; const gf32* rpb;
    int hsa, hsb;
};
template <int N> __device__ __forceinline__ void wait_bar() {
    if constexpr (N == 0) asm volatile("s_waitcnt vmcnt(0) lgkmcnt(0)\n\ts_barrier" ::: "memory");
    else if constexpr (N == 2) asm volatile("s_waitcnt vmcnt(2) lgkmcnt(0)\n\ts_barrier" ::: "memory");
    else if constexpr (N == 5) asm volatile("s_waitcnt vmcnt(5) lgkmcnt(0)\n\ts_barrier" ::: "memory");
    else static_assert(N == 0, "wait_bar count");
}
template <int N> __device__ __forceinline__ void wait_bar2() {
    if constexpr (N == 0) asm volatile("s_waitcnt vmcnt(0) lgkmcnt(0)\n\ts_barrier" ::: "memory");
    else if constexpr (N == 1) asm volatile("s_waitcnt vmcnt(1) lgkmcnt(0)\n\ts_barrier" ::: "memory");
    else if constexpr (N == 2) asm volatile("s_waitcnt vmcnt(2) lgkmcnt(0)\n\ts_barrier" ::: "memory");
    else if constexpr (N == 5) asm volatile("s_waitcnt vmcnt(5) lgkmcnt(0)\n\ts_barrier" ::: "memory");
    else static_assert(N == 0, "wait_bar2 count");
}
template <int MODE, unsigned L0 = 0xFFFFu, unsigned L1 = 0xFFFFu> __device__ __forceinline__ void partial_sm(f32x16& p0, f32x16& p1, float& m_reg, float& alpha) {
    if constexpr (MODE == 1) {
#pragma unroll
        for (int r = 0; r < 16; ++r) { p0[r] *= NASCALE; p1[r] *= NASCALE; }
    }
    float pmax = -3.0e38f;
#pragma unroll
    for (int r = 0; r < 16; ++r) if ((L0 >> r) & 1u) pmax = fmaxf(pmax, p0[r]);
#pragma unroll
    for (int r = 0; r < 16; ++r) if ((L1 >> r) & 1u) pmax = fmaxf(pmax, p1[r]);
    { auto rr = __builtin_amdgcn_permlane32_swap(__float_as_uint(pmax), __float_as_uint(pmax), false, false); pmax = fmaxf(__uint_as_float(rr[0]), __uint_as_float(rr[1])); }
    if (__builtin_expect(__all(pmax - m_reg <= THRL), 1)) alpha = 1.f;
    else { const float mn = fmaxf(m_reg, pmax); alpha = __builtin_amdgcn_exp2f(m_reg - mn); m_reg = mn; }
#pragma unroll
    for (int r = 0; r < 16; ++r) { if ((L0 >> r) & 1u) p0[r] = __builtin_amdgcn_exp2f(p0[r] - m_reg); else p0[r] = 0.f; if ((L1 >> r) & 1u) p1[r] -= m_reg; }
}
template <unsigned L0 = 0xFFFFu, unsigned L1 = 0xFFFFu>
__device__ __forceinline__ void finish_sm(f32x16& p0, f32x16& p1, float alpha, float& l_reg, bf16x8& pa0, bf16x8& pa1, bf16x8& pa2, bf16x8& pa3) {
#pragma unroll
    for (int r = 0; r < 16; ++r) { if ((L1 >> r) & 1u) p1[r] = __builtin_amdgcn_exp2f(p1[r]); else p1[r] = 0.f; }
    float ps = 0.f;
#pragma unroll
    for (int r = 0; r < 16; ++r) if ((L0 >> r) & 1u) ps += p0[r];
#pragma unroll
    for (int r = 0; r < 16; ++r) if ((L1 >> r) & 1u) ps += p1[r];
    { auto rr = __builtin_amdgcn_permlane32_swap(__float_as_uint(ps), __float_as_uint(ps), false, false); ps = __uint_as_float(rr[0]) + __uint_as_float(rr[1]); }
    l_reg = l_reg * alpha + ps;
#define FA_PK4(P, BASE, OUT) do { unsigned a0 = cvtpk(P[BASE + 0], P[BASE + 1]), a1 = cvtpk(P[BASE + 2], P[BASE + 3]); \
    unsigned b0_ = cvtpk(P[BASE + 4], P[BASE + 5]), b1_ = cvtpk(P[BASE + 6], P[BASE + 7]); \
    auto r0_ = __builtin_amdgcn_permlane32_swap(a0, b0_, false, false); auto r1_ = __builtin_amdgcn_permlane32_swap(a1, b1_, false, false); \
    u32x4 w_ = {r0_[0], r1_[0], r0_[1], r1_[1]}; OUT = __builtin_bit_cast(bf16x8, w_); } while (0)
    FA_PK4(p0, 0, pa0); FA_PK4(p0, 8, pa1); FA_PK4(p1, 0, pa2); FA_PK4(p1, 8, pa3);
#undef FA_PK4
}
template <unsigned L0, unsigned L1> __device__ __forceinline__ void bias_win(f32x16& p0, f32x16& p1, const LAS float* brow, int cs, int hi) {
#pragma unroll
    for (int r = 0; r < 16; ++r) { const int kc = crow(r, hi);
        if ((L0 >> r) & 1u) p0[r] = ((unsigned)(kc - cs) < 16u) ? p0[r] + brow[kc] : -30000.f;
        if ((L1 >> r) & 1u) p1[r] = ((unsigned)(kc + 32 - cs) < 16u) ? p1[r] + brow[kc + 32] : -30000.f; }
}
template <int N> __device__ __forceinline__ void wait_barn() { asm volatile("s_waitcnt vmcnt(%0) lgkmcnt(0)\n\ts_barrier" :: "n"(N) : "memory"); }
template <int DQK, int DV, int MODE, int S, int NHU = 1>
__device__ __forceinline__ void unit_pipe(LAS unsigned char* lds, const Desc& d) {
    constexpr int RB = DQK * 2, KB1 = 64 * RB, VB1 = 64 * DV * 2, KB = NHU * KB1, VB = NHU * VB1, SLOT = KB + VB, KP = KB / 8192, VP = VB / 8192, NCB = DV / 32, NK = DQK / 16, NPIECE = KP + VP;
    constexpr int DK = S - 1, DVV = S - 2, WSTEADY = DVV * NPIECE;
    static_assert(S >= 2 && WSTEADY < 64 && S * SLOT + 2048 + NHU * 1920 + 16 <= LDS_BYTES && (NHU == 1 || NHU == 4), "ring geometry");
    const int tid = tid_op(), wid = __builtin_amdgcn_readfirstlane(tid >> 6), lane = tid & 63, r32 = lane & 31, hi = lane >> 5;
    const int hl = (NHU > 1) ? (wid >> 1) : 0, wrow0 = (NHU > 1) ? (wid & 1) * 32 : wid * 32;
    LAS float* wsf = (LAS float*)(lds + S * SLOT) + wid * 64;
    LAS float* rpbs = (LAS float*)(lds + S * SLOT + 2048) + hl * 480;
    unsigned koff[KP], voff[VP], koffb[KP], voffb[VP];
#pragma unroll
    for (int i = 0; i < KP; ++i) { const int pp = (wid * KP + i) * 1024 + lane * 16, hh = pp / KB1, p = pp % KB1, row = p / RB, cs = (p % RB) >> 4, c = cs ^ ((row >> 1) & 7);
        koff[i] = (unsigned)((hh * d.hsa + row) * d.ldk + c * 8) * 2u; koffb[i] = (unsigned)(hh * (d.hsb - d.hsa) * d.ldk) * 2u; }
#pragma unroll
    for (int i = 0; i < VP; ++i) { const int pp = (wid * VP + i) * 1024 + lane * 16, hh = pp / VB1, p = pp % VB1, st = p >> 9, q = p & 511, kk = (st / NCB) * 8 + (q >> 6), c = (st % NCB) * 32 + ((q & 63) >> 1);
        const int k = (kk & ~0xC) | ((kk & 4) << 1) | ((kk & 8) >> 1); voff[i] = (unsigned)((hh * d.hsa + k) * d.ldv + c) * 2u; voffb[i] = (unsigned)(hh * (d.hsb - d.hsa) * d.ldv) * 2u; }
    int qr_row = 0, qc = 0, rs = 0, cs = 0;
    if constexpr (MODE == 2) {
        qr_row = d.r0 + ((NHU > 1) ? 0 : (wid >> 1)); qc = (wid & 1) * 32 + r32; rs = min(max(qr_row - 4, 0), 24); cs = min(max(qc - 8, 0), 48);
        for (int i = tid; i < NHU * 15 * 31; i += NTHREADS) ((LAS float*)(lds + S * SLOT + 2048))[(i / 465) * 480 + i % 465] = d.rpb[i] * LOG2E;
    }
#define FP_ACT(t) ((MODE != 2) || (t) >= d.nta || (d.wr0 + (t) >= rs && d.wr0 + (t) <= rs + 7))
#define FP_VAR(t) ((MODE == 2 && (t) < d.nta) ? 1 + (wid & 1) : 0)
#define FP_PSM(P0, P1, al, t, v) do { if ((v) == 0) partial_sm<MODE>(P0, P1, m_reg, al); \
        else { const LAS float* brow_ = rpbs + (d.wr0 + (t) - qr_row + 7) * 31 - qc + 15; \
               if ((v) == 1) { bias_win<0xFFFFu, 0x000Fu>(P0, P1, brow_, cs, hi); partial_sm<MODE, 0xFFFFu, 0x000Fu>(P0, P1, m_reg, al); } \
               else          { bias_win<0xF000u, 0xFFFFu>(P0, P1, brow_, cs, hi); partial_sm<MODE, 0xF000u, 0xFFFFu>(P0, P1, m_reg, al); } } } while (0)
#define FP_FSM(P0, P1, al, v) do { if ((v) == 0) finish_sm(P0, P1, al, l_reg, pa0, pa1, pa2, pa3); else if ((v) == 1) finish_sm<0xFFFFu, 0x000Fu>(P0, P1, al, l_reg, pa0, pa1, pa2, pa3); \
        else finish_sm<0xF000u, 0xFFFFu>(P0, P1, al, l_reg, pa0, pa1, pa2, pa3); } while (0)
#define FP_ROW(t) (((t) < d.nta) ? d.row0a + 64 * (t) : d.row0b + 64 * ((t) - d.nta))
#define FP_DMAK(t) do { const int t_ = (t); const GAS char* kb_ = (const GAS char*)(d.K + (size_t)FP_ROW(t_) * d.ldk); const int s_ = t_ % S; const unsigned sb_ = (t_ < d.nta) ? 0u : 1u; \
        _Pragma("unroll") for (int i_ = 0; i_ < KP; ++i_) __builtin_amdgcn_global_load_lds((const GAS unsigned*)(kb_ + (koff[i_] + sb_ * koffb[i_])), (LAS unsigned*)(lds + s_ * KB + (wid * KP + i_) * 1024), 16, 0, 0); } while (0)
#define FP_DMAV(t) do { const int t_ = (t); const GAS char* vb_ = (const GAS char*)(d.V + (size_t)FP_ROW(t_) * d.ldv); const int s_ = t_ % S; const unsigned sb_ = (t_ < d.nta) ? 0u : 1u; \
        _Pragma("unroll") for (int i_ = 0; i_ < VP; ++i_) __builtin_amdgcn_global_load_lds((const GAS unsigned*)(vb_ + (voff[i_] + sb_ * voffb[i_])), (LAS unsigned*)(lds + S * KB + s_ * VB + (wid * VP + i_) * 1024), 16, 0, 0); } while (0)
#pragma unroll
    for (int s = -DK; s < 0; ++s) { FP_DMAK(s + DK); if (s + DVV >= 0) FP_DMAV(s + DVV); }
    bf16x8 qr[NK];
    { const gbf* Qw = d.Q + (size_t)(hl * d.hsa + wrow0 + r32) * d.ldq + hi * 8;
#pragma unroll
      for (int d0 = 0; d0 < NK; ++d0) qr[d0] = *(const GAS bf16x8*)(Qw + d0 * 16); }
    float m_reg = -1e30f, l_reg = 0.f;
    f32x16 o[NCB];
#pragma unroll
    for (int i = 0; i < NCB; ++i) o[i] = f32x16{};
    const int vbase = (int)(unsigned)(size_t)(lds + S * KB + hl * VB1) + v_rd_base(lane);
    const int ksw = ((r32 >> 1) & 7);
    const int NT = d.NT;
#define FP_QKT(P0, P1, t) do { const LAS unsigned char* Ks_ = lds + ((t) % S) * KB + hl * KB1; P0 = f32x16{}; P1 = f32x16{}; \
        _Pragma("unroll") for (int d0 = 0; d0 < NK; ++d0) { const int cb_ = ((2 * d0 + hi) ^ ksw) << 4; \
            const bf16x8 b0_ = *(const LAS bf16x8*)(Ks_ + r32 * RB + cb_), b1_ = *(const LAS bf16x8*)(Ks_ + (32 + r32) * RB + cb_); \
            P0 = __builtin_amdgcn_mfma_f32_32x32x16_bf16(b0_, qr[d0], P0, 0, 0, 0); P1 = __builtin_amdgcn_mfma_f32_32x32x16_bf16(b1_, qr[d0], P1, 0, 0, 0); } } while (0)
#define FP_PV(t) do { const int vb_ = vbase + ((t) % S) * VB; pv_one<NCB, 0>(o[0], vb_, pa0, pa1, pa2, pa3); pv_one<NCB, 1>(o[1], vb_, pa0, pa1, pa2, pa3); \
        if constexpr (NCB == 4) { pv_one<NCB, 2>(o[2], vb_, pa0, pa1, pa2, pa3); pv_one<NCB, 3>(o[3], vb_, pa0, pa1, pa2, pa3); } } while (0)
#define FP_RESC(a) do { if (__any((a) < 1.f)) { if (hi == 0) wsf[r32] = (a); asm volatile("s_waitcnt lgkmcnt(0)" ::: "memory"); \
        _Pragma("unroll") for (int dd = 0; dd < NCB; ++dd) _Pragma("unroll") for (int r = 0; r < 16; ++r) o[dd][r] *= wsf[crow(r, hi)]; } } while (0)
#define FP_ENDWAIT(j) do { if ((j) + DK < NT) wait_barn<WSTEADY>(); else wait_barn<0>(); } while (0)
#define FP_STEP(C0, C1, alC, Pv0, Pv1, alP, j) do { \
        if ((j) + DK < NT) FP_DMAK((j) + DK); \
        if ((j) + DVV < NT) FP_DMAV((j) + DVV); \
        __builtin_amdgcn_sched_barrier(0); \
        const bool actC_ = FP_ACT(j); \
        if (actC_) { FP_QKT(C0, C1, j); } \
        FP_FSM(Pv0, Pv1, alP, varP); __builtin_amdgcn_sched_barrier(0); \
        if (actP) { FP_PV((j) - 1); } \
        const int varC_ = FP_VAR(j); \
        if (actC_) { FP_PSM(C0, C1, alC, j, varC_); FP_RESC(alC); } \
        else { _Pragma("unroll") for (int r = 0; r < 16; ++r) { C0[r] = 0.f; C1[r] = -30000.f; } alC = 1.f; }     \
        actP = actC_; varP = varC_; \
        FP_ENDWAIT(j); } while (0)
    f32x16 pA0, pA1, pB0, pB1; float alA = 1.f, alB = 1.f; bf16x8 pa0, pa1, pa2, pa3;
    wait_barn<WSTEADY>();
    if (DK < NT) FP_DMAK(DK);
    if (DVV < NT) FP_DMAV(DVV);
    bool actP = FP_ACT(0);
    int varP = FP_VAR(0);
    if (actP) { FP_QKT(pA0, pA1, 0); FP_PSM(pA0, pA1, alA, 0, varP); }
    else {
#pragma unroll
        for (int r = 0; r < 16; ++r) { pA0[r] = 0.f; pA1[r] = -30000.f; } }
    FP_ENDWAIT(0);
    for (int j = 1; j + 1 < NT; j += 2) {
        FP_STEP(pB0, pB1, alB, pA0, pA1, alA, j);
        FP_STEP(pA0, pA1, alA, pB0, pB1, alB, j + 1);
    }
    FP_STEP(pB0, pB1, alB, pA0, pA1, alA, NT - 1);
    FP_FSM(pB0, pB1, alB, varP); __builtin_amdgcn_sched_barrier(0);
    if (actP) { FP_PV(NT - 1); }
    if (hi == 0) wsf[32 + r32] = l_reg;
    wait_barn<0>();
    {
        constexpr int RS = DV + 8, CPR = DV / 8, NCHL = 32 * CPR / 64;
        LAS bf16_t* st = (LAS bf16_t*)(lds + wid * (32 * RS * 2));
        const gbf* Gw = d.G + (size_t)wrow0 * d.ldg + hl * DV; gbf* Ow = d.O + (size_t)wrow0 * d.ldo + hl * DV;
        u32x4 gv[NCHL];
#pragma unroll
        for (int i = 0; i < NCHL; ++i) { const int idx = i * 64 + lane, row = idx / CPR, cc = idx % CPR; gv[i] = *(const GAS u32x4*)(Gw + (size_t)row * d.ldg + cc * 8); }
#pragma unroll
        for (int r = 0; r < 16; ++r) { const float rl = __builtin_amdgcn_rcpf(wsf[32 + crow(r, hi)]);
#pragma unroll
            for (int dd = 0; dd < NCB; ++dd) st[crow(r, hi) * RS + dd * 32 + r32] = (bf16_t)f2bf(o[dd][r] * rl); }
        asm volatile("s_waitcnt lgkmcnt(0)" ::: "memory");
#pragma unroll
        for (int i = 0; i < NCHL; ++i) { const int idx = i * 64 + lane, row = idx / CPR, cc = idx % CPR;
            f32x4 va, vb, ga, gb; unpk8(*(const LAS u32x4*)(st + row * RS + cc * 8), va, vb); unpk8(gv[i], ga, gb);
            *(GAS u32x4*)(Ow + (size_t)row * d.ldo + cc * 8) = pk8(va * ga, vb * gb); }
    }
    asm volatile("s_waitcnt lgkmcnt(0)\n\ts_barrier" ::: "memory");
#undef FP_ROW
#undef FP_ACT
#undef FP_VAR
#undef FP_PSM
#undef FP_FSM
#undef FP_DMAK
#undef FP_DMAV
#undef FP_QKT
#undef FP_PV
#undef FP_RESC
#undef FP_ENDWAIT
#undef FP_STEP
}
}

__device__ __forceinline__ void phase_attn_fast(const Params& p, int l, unsigned char* lds_, int gid, int G) {
    LAS unsigned char* lds = (LAS unsigned char*)lds_;
    gu8* ws = wsb();
    const gbf* P = (const gbf*)(ws + WS_P); const gbf* KM = (const gbf*)(ws + WS_KM); const gbf* VM = (const gbf*)(ws + WS_VM); const gbf* QM = (const gbf*)(ws + WS_QM);
    const gbf* NK = (const gbf*)(ws + WS_NK); const gbf* NV = (const gbf*)(ws + WS_NV); const gbf* NQ = (const gbf*)(ws + WS_NQ);
    gbf* AB = (gbf*)(ws + WS_AB);
    const gf32* rpb = pin(I_RPB) + (size_t)l * 16 * 15 * 31;
    const int vcu = (G % 8 == 0) ? (gid % 8) * (G / 8) + gid / 8 : gid;
    const bool split = (l == 0 && G == 256); const int a = gid - 32;
    __syncthreads();
    if (split && gid < 32) { weight_transposes(lds_, TR_PER_L, 2 * TR_PER_L, gid * NWAVES + (tid_op() >> 6), 32 * NWAVES); __syncthreads(); return; }
    {
        const int tid = tid_op(), lane = tid & 63, off = split ? 32 : 0;
        const gbf* GT = (const gbf*)(ws + WS_GT);
        for (int t = (gid - off) * NWAVES + (tid >> 6); t < NB * 1024; t += (G - off) * NWAVES) {
            const int b = t >> 10, ch = t & 1023; const gbf* gr = GT + ((size_t)b * 1024 + ch) * KP4;
            float acc = 0.f;
#pragma unroll
            for (int jj = 0; jj < 4; ++jj) { f32x4 va, vb; unpk8(*(const GAS u32x4*)(gr + lane * 8 + 512 * jj), va, vb); acc += (va[0] - va[1]) + (va[2] - va[3]) + (vb[0] - vb[1]) + (vb[2] - vb[3]); }
            acc = wave_sum(acc) * 0.02209708691207961f;
            if (lane == 0) { const size_t r = (size_t)b * SEQ + SEQ / 2; const float g = bf2f(P[r * PP + C_GFN + ch]); AB[r * ABW + 3072 + ch] = (bf16_t)f2bf(acc * g); }
        }
    }
    const int m_first = split ? (a % 8) * 28 + a / 8 : vcu, m_step = split ? (a < 32 ? 224 + a - m_first : 256) : G;
    for (int rep = 0; rep < (PROBE_DUP == 50 ? 2 : 1); ++rep)
    for (int u = m_first; u < NB * 8 * 8; u += m_step) { const int b = u >> 6, h = (u >> 3) & 7, qb = u & 7; const size_t q0 = (size_t)b * SEQ + qb * 256;
        const int lat0 = (b * 8 + h) * SEQ, ctx0 = NB * 8 * SEQ + (b * 8 + h) * CTXL;
        fa::Desc d{QM + (size_t)(lat0 + qb * 256) * 192, 192, KM, 192, VM, 128, ctx0, 4, lat0, 36, P + q0 * PP + C_GML + h * 128, PP, AB + q0 * ABW + 1024 + h * 128, ABW, 0, 0, nullptr, 0, 0};
        fa::unit_pipe<192, 128, 0, 3>(lds, d); }
    int na_b, na_e, na_st;
    if (G != 256) { na_b = gid; na_e = NB * 16 * 8; na_st = G; }
    else if (split) { na_b = (a >= 96) ? (a - 96) * 4 : 0; na_e = (a >= 96) ? na_b + 4 : 0; na_st = 1; }
    else { na_b = gid < 64 ? 0 : gid < 192 ? (gid - 64) * 3 : 384 + (gid - 192) * 2; na_e = gid < 64 ? 0 : gid < 192 ? na_b + 3 : na_b + 2; na_st = 1; }
    for (int rep = 0; rep < (PROBE_DUP == 51 ? 2 : 1); ++rep)
    for (int u = na_b; u < na_e; u += na_st) {
        const int b = u >> 7, h0 = ((u >> 5) & 3) * 4, r = u & 31, rs = min(max(r - 4, 0), 24); const size_t q0 = (size_t)b * SEQ + r * 64;
        const int lat0 = (b * 16 + h0) * SEQ, ctx0 = NB * 16 * SEQ + (b * 16 + h0) * CTXL;
        fa::Desc d{NQ + (size_t)(lat0 + r * 64) * 64, 64, NK, 64, NV, 64, lat0 + rs * 64, 8, ctx0, 12, P + q0 * PP + C_GNA + h0 * 64, PP, AB + q0 * ABW + 2048 + h0 * 64, ABW,
                   r, rs, rpb + h0 * 15 * 31, SEQ, CTXL};
        fa::unit_pipe<64, 64, 2, 2, 4>(lds, d); }
    if (l == 0) {
        const int x0 = split ? 64 : G / 2, x1 = split ? 64 : G / 2 + 32;
        for (int u = gid - x0; u >= 0 && u < NB * 8; u += G) { const int b = u >> 3, h = u & 7; const size_t q0 = (size_t)NLAT + b * CTXL; const int ctx0 = NB * 8 * SEQ + (b * 8 + h) * CTXL;
            fa::Desc d{QM + (size_t)ctx0 * 192, 192, KM, 192, VM, 128, ctx0, 4, 0, 4, P + q0 * PP + C_GML + h * 128, PP, AB + q0 * ABW + 1024 + h * 128, ABW, 0, 0, nullptr, 0, 0};
            fa::unit_pipe<192, 128, 0, 3>(lds, d); }
        for (int u = gid - x1; u >= 0 && u < NB * 16; u += G) { const int b = u >> 4, h = u & 15; const size_t q0 = (size_t)NLAT + b * CTXL; const int ctx0 = NB * 16 * SEQ + (b * 16 + h) * CTXL;
            fa::Desc d{NQ + (size_t)ctx0 * 64, 64, NK, 64, NV, 64, ctx0, 4, 0, 4, P + q0 * PP + C_GNA + h * 64, PP, AB + q0 * ABW + 2048 + h * 64, ABW, 0, 0, nullptr, 0, 0};
            fa::unit_pipe<64, 64, 0, 4>(lds, d); }
    }
    __syncthreads();
}


#define XB_TMO      128
#define XB_XCNT(j)  (256  + 64 * (j))
#define XB_XSUB(j)  (1280 + 64 * (j))
#define XB_XGEN(j)  (2304 + 64 * (j))
#define XB_TOP      3328
#define XB_TOPGEN   3392
#define XCD_BAR_WORDS 3456
#define XB_SPIN_CAP (1u << 18)
__device__ __forceinline__ unsigned xb_ld(unsigned* p)              { return __hip_atomic_load(p, __ATOMIC_RELAXED, __HIP_MEMORY_SCOPE_AGENT); }
__device__ __forceinline__ unsigned xb_add(unsigned* p, unsigned v) { return __hip_atomic_fetch_add(p, v, __ATOMIC_RELAXED, __HIP_MEMORY_SCOPE_AGENT); }
__device__ __forceinline__ unsigned xb_xcc_id() { return (unsigned)__builtin_amdgcn_s_getreg((3 << 11) | 20) & 0xFu; }
#define XB_SPIN(cond, bar) do { unsigned _sp = 0; while (cond) { __builtin_amdgcn_s_sleep(1); \
    if ((++_sp & 255u) == 0u) { if (xb_ld(&(bar)[XB_TMO])) break; if (_sp > XB_SPIN_CAP) { atomicAdd(&(bar)[XB_TMO], 1u); break; } } } } while (0)
struct XcdBarrier { unsigned* bar; unsigned x; volatile LAS unsigned* st; };
__device__ __forceinline__ XcdBarrier xcd_barrier_post(unsigned* bar, volatile LAS unsigned* st) {
    XcdBarrier b; b.bar = bar; b.x = xb_xcc_id(); b.st = st;
    if (threadIdx.x == 0) (void)xb_add(&bar[XB_XCNT(b.x)], 1u);
    return b;
}
__device__ __forceinline__ void xcd_barrier_complete(unsigned* bar, unsigned x, unsigned& nloc, unsigned& nx) {
    const unsigned G = gridDim.x * gridDim.y * gridDim.z;
    unsigned sum, cnt, mine, sp = 0u;
    for (;;) {
        sum = 0u; cnt = 0u; mine = 0u;
#pragma unroll
        for (unsigned j = 0; j < 16; ++j) { const unsigned c = xb_ld(&bar[XB_XCNT(j)]); sum += c; cnt += (c > 0u) ? 1u : 0u; mine = (j == x) ? c : mine; }
        if (sum == G) break;
        __builtin_amdgcn_s_sleep(1);
        if ((++sp & 255u) == 0u) { if (xb_ld(&bar[XB_TMO])) break; if (sp > XB_SPIN_CAP) { atomicAdd(&bar[XB_TMO], 1u); break; } }
    }
    nloc = mine > 0u ? mine : 1u; nx = cnt > 0u ? cnt : 1u;
}
__device__ __forceinline__ void xcd_barrier(const XcdBarrier& b) {
    asm volatile("s_waitcnt vmcnt(0)" ::: "memory");
    __syncthreads();
    if (threadIdx.x == 0) {
        unsigned* bar = b.bar;
        __builtin_amdgcn_s_waitcnt(0);
        unsigned nloc = b.st[0], nx = b.st[1];
        if (nloc == 0u) { xcd_barrier_complete(bar, b.x, nloc, nx); b.st[0] = nloc; b.st[1] = nx; }
        const unsigned old = xb_add(&bar[XB_XSUB(b.x)], 1u);
        const unsigned gen = old / nloc;
        if (old + 1u == (gen + 1u) * nloc) {
            __builtin_amdgcn_fence(__ATOMIC_RELEASE, "agent");
            asm volatile("s_waitcnt vmcnt(0)" ::: "memory");
            const unsigned og = xb_add(&bar[XB_TOP], 1u);
            const unsigned tg = og / nx;
            if (og + 1u == (tg + 1u) * nx) xb_add(&bar[XB_TOPGEN], 1u);
            else XB_SPIN(xb_ld(&bar[XB_TOPGEN]) == tg, bar);
            __builtin_amdgcn_fence(__ATOMIC_ACQUIRE, "agent");
            xb_add(&bar[XB_XGEN(b.x)], 1u);
            asm volatile("s_waitcnt vmcnt(0)" ::: "memory");
        } else {
            XB_SPIN(xb_ld(&bar[XB_XGEN(b.x)]) == gen, bar);
            __builtin_amdgcn_fence(__ATOMIC_ACQUIRE, "agent");
            asm volatile("s_waitcnt vmcnt(0)" ::: "memory");
        }
    }
    __syncthreads();
}

#define WSB(off) (wsb() + (off))
__global__ void __launch_bounds__(NTHREADS, 2) fwd_megakernel(Params p) {
    extern __shared__ __attribute__((aligned(16))) unsigned char lds[];
    cg::grid_group grid = cg::this_grid();
    const int gid_ = blockIdx.x, G_ = gridDim.x;
    auto sop = [](int v) { asm volatile("" : "+s"(v)); return v; };
#define gid sop(gid_)
#define G sop(G_)

    { volatile LAS unsigned* st0 = (volatile LAS unsigned*)((LAS unsigned char*)lds + LDS_BYTES - 16); if (threadIdx.x < 4) st0[threadIdx.x] = 0u; __syncthreads(); }
    (void)xcd_barrier_post((unsigned*)(wsb() + WS_BAR), (volatile LAS unsigned*)((LAS unsigned char*)lds + LDS_BYTES - 16));
    if (wsb() == nullptr) grid.sync();
#define GSYNC() xcd_barrier(XcdBarrier{(unsigned*)(wsb() + WS_BAR), xb_xcc_id(), (volatile LAS unsigned*)((LAS unsigned char*)lds + LDS_BYTES - 16)})
    for (int rep = 0; rep < (PROBE_DUP == 0 ? 2 : 1); ++rep) { phase0(p, lds, gid, G); GSYNC(); }

    for (int rep = 0; rep < (PROBE_DUP == 1 ? 2 : 1); ++rep) { phase_uprep0(p, gid, G); GSYNC(); }
    for (int l = 0; l < DEPTH; ++l) {
        const int nq = (l == 0) ? NROW : NLAT;
        for (int rep = 0; rep < ((PROBE_DUP == 2 || PROBE_DUP == 3) ? 2 : 1); ++rep) {
            const gbf* WinT = (const gbf*)WSB(WS_WIN) + (size_t)l * NP * KP2; gbf* U = (gbf*)WSB(WS_U); gbf* P = (gbf*)WSB(WS_P);
            const EpiInProj E{P, 0, (gbf*)WSB(WS_NK), (gbf*)WSB(WS_NV), (gbf*)WSB(WS_NQ), (gbf*)WSB(WS_MG)};
            if (l == 0 && G == 256) {
                __syncthreads();
                { fg::SchedIn0 S{U, WinT, G, gid, 0, 11}; fg::gemm((LAS unsigned char*)lds, KP2, KP2, DM, S, E); }
                __syncthreads();
                GSYNC();
                if (gid < 64) { fg::SchedIn0 S{U, WinT, G, gid, 11, 12}; fg::gemm((LAS unsigned char*)lds, KP2, KP2, DM, S, E); __syncthreads(); }
                else phase_c1(p, l, NROW, gid - 64, G - 64);
                GSYNC();
            } else {
                gemm_run(lds, GemmJob{U, KP2, WinT, KP2, nq, NP, DM}, E, gid, G);
                GSYNC();
                if (l == 0) phase_c1(p, l, NROW, gid, G);
                else if (gid < 40) gemm_run(lds, GemmJob{(const gbf*)WSB(WS_U) + (size_t)NLAT * KP2, KP2, (const gbf*)WSB(WS_WIN) + (size_t)l * NP * KP2, KP2, NCTX, KVC_P, DM},
                                            EpiInProjC1{(gbf*)WSB(WS_P), (gbf*)WSB(WS_NK), (gbf*)WSB(WS_KM), (gf32*)WSB(WS_SSQ)}, gid, 40);
                else phase_c1(p, l, NLAT, gid - 40, G - 40);
                GSYNC();
            }
        }
        for (int rep = 0; rep < (PROBE_DUP == 4 ? 2 : 1); ++rep) {
            __syncthreads();
            { SchedC2 S{(const gbf*)WSB(WS_P), (const gbf*)WSB(WS_WUKV) + (size_t)l * 2048 * 256, (const gbf*)WSB(WS_WUQ) + (size_t)l * 1536 * 512, (const gbf*)WSB(WS_DC), nq / 256, l == 0 ? 32 : 0, G, gid};
              EpiC2 E{(gbf*)WSB(WS_KM), (gbf*)WSB(WS_VM), (gbf*)WSB(WS_QM), (gbf*)WSB(WS_GT), (gbf*)WSB(WS_GTC), (const gf32*)WSB(WS_RKV), (const gf32*)WSB(WS_RQ), (const gf32*)WSB(WS_ROPE), l == 1 ? (const gf32*)WSB(WS_SSQ) : (const gf32*)nullptr};
              fg::gemm_multi((LAS unsigned char*)lds, S, E); }
            __syncthreads();
            GSYNC();
        }
        for (int rep = 0; rep < (PROBE_DUP == 5 ? 2 : 1); ++rep) {
        phase_attn_fast(p, l, lds, gid, G);
        for (int rep2 = 0; rep2 < (PROBE_DUP == 52 ? 2 : 1); ++rep2)
        gemm_fast_z(lds, MapF2{(const gbf*)WSB(WS_DN), (const gbf*)WSB(WS_GT), KP4}, KP4, KP4, 2 * SEQ, SEQ / 512, 4, NB, EpiF2M{(gbf*)WSB(WS_AB), (const gbf*)WSB(WS_P), 0, SEQ},
                    (G != 256) ? (gid < 64 ? gid : -1) : (l == 0) ? ((gid >= 64 && gid < 128) ? gid - 64 : -1) : (gid < 64 ? gid : -1), 64);
        if (l == 0) gemm_fast_z(lds, MapF2{(const gbf*)WSB(WS_DNC), (const gbf*)WSB(WS_GTC), 2 * CTXL}, 2 * CTXL, 2 * CTXL, 2 * CTXL, 1, 4, NB, EpiF2{(gbf*)WSB(WS_AB), (const gbf*)WSB(WS_P), NLAT, CTXL}, gid - (G == 256 ? 96 : G / 2 + 96), G);
        GSYNC();
        }
        const gbf* WpT = (const gbf*)WSB(WS_WP) + (size_t)l * 4 * 2048 * KP1; const gbf* WoT = (const gbf*)WSB(WS_WO) + (size_t)l * 2048 * KP2;
        const int NC = G / 8;
        for (int rep = 0; rep < (PROBE_DUP == 6 ? 2 : 1); ++rep) {
          __syncthreads();
          { fg::SchedBranch S{(const gbf*)WSB(WS_AB), WpT, NLAT / 256, DM / 256, G, gid, 0};
            fg::gemm((LAS unsigned char*)lds, ABW, KP1, 1024, S, EpiChain{(gbf*)WSB(WS_MB), (const gbf*)WSB(WS_MG), 0}); }
          __syncthreads();
          GSYNC();
        }
        for (int rep = 0; rep < (PROBE_DUP == 7 ? 2 : 1); ++rep) {
          if (l == 0) {
            __syncthreads();
            if (gid < NC) { fg::SchedBranch S{(const gbf*)WSB(WS_AB), WpT, NCTX / 256, DM / 256, NC, gid, NLAT / 256};
                            fg::gemm((LAS unsigned char*)lds, ABW, KP1, 1024, S, EpiChain{(gbf*)WSB(WS_MB), (const gbf*)WSB(WS_MG), NLAT}); }
            else { fg::Sched<fg::MapPlain> S{fg::MapPlain{(const gbf*)WSB(WS_MB), KP2, WoT, KP2}, NLAT / 256, DM / 256, 1, G - NC, gid - NC};
                   fg::gemm((LAS unsigned char*)lds, KP2, KP2, DM, S, EpiOut{(gf32*)WSB(WS_Y), 0}); }
            __syncthreads();
          } else gemm_run(lds, GemmJob{(const gbf*)WSB(WS_MB), KP2, WoT, KP2, NLAT, DM, DM}, EpiOut{(gf32*)WSB(WS_Y), 0}, gid, G);
          GSYNC();
        }
        for (int rep = 0; rep < (PROBE_DUP == 8 ? 2 : 1); ++rep) {
          if (l == 0) {
            if (gid < NC) gemm_run(lds, GemmJob{(const gbf*)WSB(WS_MB) + (size_t)NLAT * KP2, KP2, WoT, KP2, NCTX, DM, DM}, EpiOut{(gf32*)WSB(WS_Y), NLAT}, gid, NC);
            else phase_final(p, l, 0, NLAT, gid - NC, G - NC);
            GSYNC();
            phase_final(p, l, NLAT, NROW, gid, G);
            GSYNC();
          } else {
            phase_final(p, l, 0, NLAT, gid, G);
            if (rep + 1 < (PROBE_DUP == 8 ? 2 : 1)) GSYNC();
          }
        }
    }
}
#undef gid
#undef G

extern "C" void kernel_launch(void* const* d_in, const int* in_sizes, int n_in, void* d_out, int out_size, void* d_ws, size_t ws_size, hipStream_t stream) {
    static int grid_blocks = 0;
    if (grid_blocks == 0) {
        if (n_in != 20 || out_size != NLAT * DM || ws_size < WS_END) { fprintf(stderr, "kernel_launch: unexpected shapes (n_in %d out %d ws %zu, need ws >= %zu)\n", n_in, out_size, ws_size, (size_t)WS_END); grid_blocks = -1; return; }
        int dev = 0, cus = 0, per_cu = 0;
        hipGetDevice(&dev);
        hipDeviceGetAttribute(&cus, hipDeviceAttributeMultiprocessorCount, dev);
        if (hipFuncSetAttribute((const void*)fwd_megakernel, hipFuncAttributeMaxDynamicSharedMemorySize, LDS_BYTES) != hipSuccess) { fprintf(stderr, "kernel_launch: hipFuncSetAttribute failed\n"); grid_blocks = -1; return; }
        if (hipOccupancyMaxActiveBlocksPerMultiprocessor(&per_cu, (const void*)fwd_megakernel, NTHREADS, LDS_BYTES) != hipSuccess || per_cu < 1) { fprintf(stderr, "kernel_launch: occupancy query failed (%d)\n", per_cu); grid_blocks = -1; return; }
        grid_blocks = cus;
        fprintf(stderr, "kernel_launch: cus %d per_cu %d grid %d\n", cus, per_cu, grid_blocks);
    }
    if (grid_blocks < 0) return;
    if (hipMemsetAsync((char*)d_ws + WS_BAR, 0, 16384, stream) != hipSuccess) { fprintf(stderr, "kernel_launch: hipMemsetAsync of the barrier words failed\n"); return; }
    Params p{};
    for (int i = 0; i < 20; ++i) p.in[i] = (const gf32*)d_in[i];
    p.out = (gf32*)d_out; p.ws = (gu8*)d_ws;
    void* args[] = {&p};
    hipError_t e = hipLaunchCooperativeKernel((const void*)fwd_megakernel, dim3(grid_blocks), dim3(NTHREADS), args, LDS_BYTES, stream);
    if (e != hipSuccess) fprintf(stderr, "kernel_launch: cooperative launch failed: %s (grid %d)\n", hipGetErrorString(e), grid_blocks);
}
```

```cpp
#include <hip/hip_runtime.h>
#include <hip/hip_cooperative_groups.h>
#include <cstdio>
#include <cstdint>
namespace cg = cooperative_groups;
#ifndef PROBE_DUP
#define PROBE_DUP -1
#endif

#define GAS __attribute__((address_space(1)))
typedef unsigned short bf16_t;
typedef GAS bf16_t gbf;
typedef GAS float gf32;
typedef GAS unsigned char gu8;
typedef float f32x4 __attribute__((ext_vector_type(4)));
typedef unsigned u32x4 __attribute__((ext_vector_type(4)));
typedef unsigned u32x2 __attribute__((ext_vector_type(2)));

constexpr int DM = 2048, NB = 4, SEQ = 2048, CTXL = 256, DEPTH = 2;
constexpr int NLAT = NB * SEQ, NCTX = NB * CTXL, NROW = NLAT + NCTX;
constexpr int N_IN = 20288, NP = 20480;
constexpr int PP = 12288 + 64;
constexpr int KP2 = DM + 64;
constexpr int KP1 = 1024 + 64;
constexpr int KP4 = 4096 + 64;
constexpr int C_CKV = 0, C_KR = 256, C_NAK = 512, C_NAV = 1536, C_QL = 2560, C_NAQ = 3072, C_CB = 4096, C_CC = 5120, C_CX = 6144, C_FV = 7168,
              C_GCV = 8192, C_GML = 9216, C_GNA = 10240, C_GFN = 11264, C_MG = 12288;
constexpr int KVC_P = 2560;
constexpr int KMW = 1536, VMW = 1024, QMW = 1536, ABW = 4160;
constexpr float EPS = 1e-6f;
constexpr float LOG2E = 1.4426950408889634f;
constexpr float QSCALE = 0.07216878364870322f * LOG2E;
constexpr float NASCALE = 0.125f * LOG2E;
constexpr int NTHREADS = 512, NWAVES = 8;
constexpr int LDS_BYTES = 147456;

constexpr size_t al256(size_t x) { return (x + 255) / 256 * 256; }
constexpr size_t WS_WIN = 0;
constexpr size_t WS_WUKV = WS_WIN + al256((size_t)2 * NP * KP2 * 2);
constexpr size_t WS_WUQ = WS_WUKV + al256((size_t)2 * 2048 * 256 * 2);
constexpr size_t WS_WP = WS_WUQ + al256((size_t)2 * 1536 * 512 * 2);
constexpr size_t WS_WO = WS_WP + al256((size_t)2 * 4 * 2048 * KP1 * 2);
constexpr size_t WS_MOD = WS_WO + al256((size_t)2 * 2048 * KP2 * 2);
constexpr size_t WS_ROPE = WS_MOD + al256((size_t)2 * 5 * 6144 * 4);
constexpr size_t WS_DC = WS_ROPE + al256((size_t)64 * 16 * 2 * 4);
constexpr size_t WS_DN = WS_DC + al256((size_t)512 * 256 * 2);
constexpr size_t WS_DNC = WS_DN + al256((size_t)2048 * KP4 * 2);
constexpr size_t WS_U = WS_DNC + al256((size_t)256 * 512 * 2);
constexpr size_t WS_P = WS_U + al256((size_t)NROW * KP2 * 2);
constexpr size_t WS_KM = WS_P + al256((size_t)NROW * PP * 2);
constexpr size_t WS_VM = WS_KM + al256((size_t)NROW * KMW * 2);
constexpr size_t WS_QM = WS_VM + al256((size_t)NROW * VMW * 2);
constexpr size_t WS_AB = WS_QM + al256((size_t)NROW * QMW * 2);
constexpr size_t WS_GT = WS_AB + al256((size_t)NROW * ABW * 2);
constexpr size_t WS_GTC = WS_GT + al256((size_t)4 * 1024 * KP4 * 2);
constexpr size_t WS_MF = WS_GTC + al256((size_t)4 * 1024 * 512 * 2);
constexpr size_t WS_MB = WS_MF + al256((size_t)NROW * DM * 4);
constexpr size_t WS_Y = WS_MB + al256((size_t)NROW * KP2 * 2);
constexpr size_t WS_RKV = WS_Y + al256((size_t)NROW * DM * 4);
constexpr size_t WS_RQ = WS_RKV + al256((size_t)NROW * 4);
constexpr size_t WS_XL = WS_RQ + al256((size_t)NROW * 4);
constexpr size_t WS_NK = WS_XL + al256((size_t)NROW * DM * 4);
constexpr size_t WS_NV = WS_NK + al256((size_t)NROW * 1024 * 2);
constexpr size_t WS_NQ = WS_NV + al256((size_t)NROW * 1024 * 2);
constexpr size_t WS_MG = WS_NQ + al256((size_t)NROW * 1024 * 2);
constexpr size_t WS_SSQ = WS_MG + al256((size_t)4 * NROW * DM * 2);
constexpr size_t WS_BAR = WS_SSQ + al256((size_t)NCTX * 8 * 4);
constexpr size_t WS_END = WS_BAR + 16384;

struct Params { const gf32* in[20]; gf32* out; gu8* ws; };
enum { I_X = 0, I_C, I_CTX, I_CCTX, I_GPRE, I_GPOST, I_WADA, I_BADA, I_WIN, I_GQ, I_GKV, I_WUQ, I_WUKV, I_CONVW, I_RPB, I_WPC, I_WPM, I_WPN, I_WPF, I_WOUT };

__device__ __forceinline__ size_t hm_row(int r, int h, int NH) {
    return r < NLAT ? (size_t)(((r >> 11) * NH + h) * SEQ + (r & (SEQ - 1))) : (size_t)NB * NH * SEQ + (size_t)((((r - NLAT) >> 8) * NH + h) * CTXL + ((r - NLAT) & (CTXL - 1)));
}

__device__ __forceinline__ size_t mg_off(int z, int r, int c) { return ((((size_t)z * (NROW / 256) + (r >> 8)) * (DM / 256) + (c >> 8)) * 256 + (r & 255)) * 256 + (c & 255); }

__device__ __forceinline__ unsigned f2bf(float f) { unsigned u = __builtin_bit_cast(unsigned, f); return (u + 0x7fffu + ((u >> 16) & 1u)) >> 16; }
typedef float f32x2_t __attribute__((ext_vector_type(2))); typedef __bf16 bf16x2_t __attribute__((ext_vector_type(2)));
__device__ __forceinline__ unsigned pk2(float lo, float hi) { f32x2_t v = {lo, hi}; bf16x2_t b = __builtin_convertvector(v, bf16x2_t); return __builtin_bit_cast(unsigned, b); }
__device__ __forceinline__ float bf2f(unsigned short b) { return __builtin_bit_cast(float, (unsigned)b << 16); }
__device__ __forceinline__ float bflo(unsigned w) { return __builtin_bit_cast(float, w << 16); }
__device__ __forceinline__ float bfhi(unsigned w) { return __builtin_bit_cast(float, w & 0xffff0000u); }
__device__ __forceinline__ u32x2 pk4(f32x4 v) { u32x2 r; r.x = pk2(v[0], v[1]); r.y = pk2(v[2], v[3]); return r; }
__device__ __forceinline__ u32x4 pk8(f32x4 a, f32x4 b) { u32x4 r; r.x = pk2(a[0], a[1]); r.y = pk2(a[2], a[3]); r.z = pk2(b[0], b[1]); r.w = pk2(b[2], b[3]); return r; }
__device__ __forceinline__ void unpk8(u32x4 w, f32x4& a, f32x4& b) { a = (f32x4){bflo(w.x), bfhi(w.x), bflo(w.y), bfhi(w.y)}; b = (f32x4){bflo(w.z), bfhi(w.z), bflo(w.w), bfhi(w.w)}; }
__device__ __forceinline__ f32x4 unpk4(u32x2 w) { return (f32x4){bflo(w.x), bfhi(w.x), bflo(w.y), bfhi(w.y)}; }
__device__ __forceinline__ float sigmoidf_(float x) { return __builtin_amdgcn_rcpf(1.0f + __builtin_amdgcn_exp2f(x * -LOG2E)); }
__device__ __forceinline__ float siluf_(float x) { return x * __builtin_amdgcn_rcpf(1.0f + __builtin_amdgcn_exp2f(x * -LOG2E)); }
__device__ __forceinline__ float wave_sum(float v) {
#pragma unroll
    for (int o = 1; o < 64; o <<= 1) v += __shfl_xor(v, o);
    return v;
}
__device__ __forceinline__ float wave_max(float v) {
#pragma unroll
    for (int o = 1; o < 64; o <<= 1) v = fmaxf(v, __shfl_xor(v, o));
    return v;
}

typedef __attribute__((address_space(4))) const unsigned char* kargp_t;
__device__ __forceinline__ kargp_t karg_op() { kargp_t k = (kargp_t)__builtin_amdgcn_kernarg_segment_ptr(); asm volatile("" : "+s"(k)); return k; }
__device__ __forceinline__ const gf32* pin(int i) { return *(const gf32* const __attribute__((address_space(4)))*)(karg_op() + 8 * i); }
__device__ __forceinline__ gf32* pout() { return *(gf32* const __attribute__((address_space(4)))*)(karg_op() + 8 * 20); }
__device__ __forceinline__ gu8* wsb() { return *(gu8* const __attribute__((address_space(4)))*)(karg_op() + 8 * 21); }
__device__ __forceinline__ int tid_op() { int t = threadIdx.x; asm volatile("" : "+v"(t)); return t; }

struct GemmJob { const gbf* A; int lda; const gbf* Bt; int ldb; int M, N, K; };

#define LAS __attribute__((address_space(3)))
typedef short bf16x8 __attribute__((ext_vector_type(8)));
namespace fg {
constexpr int BM = 256, BK = 64, HALF = 128, HTB = HALF * BK * 2, STAGE_BYTES = 8 * HTB, NXCD = 8, WGM = 4;
__device__ __forceinline__ int lds_byte(int r, int c) { const int st = (r >> 4) * 2 + (c >> 5), rr = r & 15, cc = c & 31, ob = rr * 64 + cc * 2; return st * 1024 + (ob ^ (((ob >> 9) & 1) << 5)); }
__device__ __forceinline__ void stage_rc(int b, int& R, int& C) { const int st = b / 1024, sb = b % 1024, swz = sb ^ (((sb >> 9) & 1) << 5); R = (st >> 1) * 16 + swz / 64; C = (st & 1) * 32 + (swz % 64) / 2; }
__device__ __forceinline__ int perm32(int rho) { const int n = rho >> 4, i = rho & 15; return 8 * (i >> 2) + 4 * n + (i & 3); }
struct Unit { const GAS char* A; const GAS char* B; int pm, pn, z; };
template <class Map> struct Sched {
    Map map; int nM, nN, nz, G, c;
    __device__ __forceinline__ bool next(int i, Unit& u) const {
        const int per = nM * nN, nwg = per * nz; const long L = (long)i * G + c; if (L >= nwg) return false;
        int wgid = (int)L; { const int q = nwg / NXCD, r = nwg % NXCD, xcd = wgid % NXCD, off = wgid / NXCD; wgid = (xcd < r ? xcd * (q + 1) : r * (q + 1) + (xcd - r) * q) + off; }
        const int z = wgid / per, w = wgid % per;
        const int nig = WGM * nN, gidx = w / nig, fm = gidx * WGM, gsz = (nM - fm) < WGM ? (nM - fm) : WGM;
        u.pm = fm + ((w % nig) % gsz); u.pn = (w % nig) / gsz; u.z = z; u.A = (const GAS char*)map.a(z, u.pm); u.B = (const GAS char*)map.b(z, u.pn); return true;
    }
};
template <class Epi, class S_>
__device__ __forceinline__ void gemm(LAS unsigned char* lds, int lda, int ldb, int K, const S_& S, const Epi& E) {
    const int tid = tid_op(), wid = __builtin_amdgcn_readfirstlane(tid >> 6), lane = tid & 63, wr = wid >> 2, wc = wid & 3, fr = lane & 15, fq = lane >> 4;
    int Kop = K; asm volatile("" : "+s"(Kop));
    const int nt = Kop / BK;
    unsigned voffA[2], voffB[2];
#pragma unroll
    for (int i = 0; i < 2; ++i) { int R, C; stage_rc(tid * 16 + i * 8192, R, C); const int Rb = Epi::PERM ? ((R & ~31) + perm32(R & 31)) : R;
        voffA[i] = (unsigned)(R * lda + C) * 2u; voffB[i] = (unsigned)(Rb * ldb + C) * 2u; }
    const size_t kstep = (size_t)(BK * 2);
    const size_t hstepA = (size_t)HALF * lda * 2, hstepB = (size_t)HALF * ldb * 2;
    const unsigned ldsw = (unsigned)wid * 1024u;
    const int aoff = lds_byte(wr * 64 + fr, fq * 8), boff = lds_byte(wc * 32 + fr, fq * 8);
#define FG_SA(b, h) (((b) * 2 + (h)) * HTB)
#define FG_SB(b, h) ((4 + (b) * 2 + (h)) * HTB)
#define FG_STAGE(bufoff, gbase, voff) do { _Pragma("unroll") for (int _i = 0; _i < 2; ++_i) \
        __builtin_amdgcn_global_load_lds((const GAS unsigned*)((const GAS char*)(gbase) + (voff)[_i]), (LAS unsigned*)(lds + (bufoff) + ldsw + _i * 8192), 16, 0, 0); } while (0)
#define FG_LDA(dst, b, h) do { _Pragma("unroll") for (int m = 0; m < 4; ++m) _Pragma("unroll") for (int k = 0; k < 2; ++k) dst[m][k] = *(const LAS bf16x8*)(lds + FG_SA(b, h) + aoff + m * 2048 + k * 1024); } while (0)
#define FG_LDB(dst, b, h) do { _Pragma("unroll") for (int n = 0; n < 2; ++n) _Pragma("unroll") for (int k = 0; k < 2; ++k) dst[n][k] = *(const LAS bf16x8*)(lds + FG_SB(b, h) + boff + n * 2048 + k * 1024); } while (0)
#define FG_MMA(ai, bj, At, Bt) do { __builtin_amdgcn_s_setprio(1); _Pragma("unroll") for (int m = 0; m < 4; ++m) _Pragma("unroll") for (int n = 0; n < 2; ++n) _Pragma("unroll") for (int k = 0; k < 2; ++k) \
        acc[ai][bj][m][n] = __builtin_amdgcn_mfma_f32_16x16x32_bf16(Bt[n][k], At[m][k], acc[ai][bj][m][n], 0, 0, 0); __builtin_amdgcn_s_setprio(0); } while (0)
#define FG_WAIT_V(n) asm volatile("s_waitcnt vmcnt(" #n ")" ::: "memory")
#define FG_WAIT_L(n) asm volatile("s_waitcnt lgkmcnt(" #n ")" ::: "memory")
#define FG_BAR __builtin_amdgcn_s_barrier()
#define FG_SCHED __builtin_amdgcn_sched_barrier(0)
    Unit cur, nxt; int ui = 0;
    if (!S.next(0, cur)) return;
    f32x4 acc[2][2][4][2];
#pragma unroll
    for (int a = 0; a < 2; ++a)
#pragma unroll
        for (int b = 0; b < 2; ++b)
#pragma unroll
            for (int m = 0; m < 4; ++m)
#pragma unroll
                for (int n = 0; n < 2; ++n) acc[a][b][m][n] = (f32x4){0.f, 0.f, 0.f, 0.f};
    bf16x8 At[4][2], B0[2][2], B1[2][2];
    const GAS char* cA = cur.A; const GAS char* cB = cur.B;
    FG_STAGE(FG_SB(0, 0), cB, voffB); FG_STAGE(FG_SB(0, 1), cB + hstepB, voffB); FG_STAGE(FG_SA(0, 0), cA, voffA); FG_STAGE(FG_SA(0, 1), cA + hstepA, voffA);
    if (wr == 1) FG_BAR;
    FG_WAIT_V(2); FG_BAR;
    FG_STAGE(FG_SB(1, 0), cB + kstep, voffB); FG_STAGE(FG_SA(1, 0), cA + kstep, voffA); FG_STAGE(FG_SB(1, 1), cB + hstepB + kstep, voffB);
    FG_WAIT_V(6); FG_BAR;
    for (;;) {
        const bool has_next = S.next(ui + 1, nxt);
        const GAS char* nA = has_next ? nxt.A : cA; const GAS char* nB = has_next ? nxt.B : cB;
        for (int t = 0; t < nt; t += 2) {
            const bool last = (t == nt - 2);
            const GAS char* a1 = cA + (size_t)(t + 1) * kstep;
            const GAS char* a2 = last ? nA : cA + (size_t)(t + 2) * kstep; const GAS char* b2 = last ? nB : cB + (size_t)(t + 2) * kstep;
            const GAS char* a3 = a2 + kstep; const GAS char* b3 = b2 + kstep;
            FG_LDB(B0, 0, 0); FG_LDB(B1, 0, 1); FG_SCHED; FG_LDA(At, 0, 0); FG_STAGE(FG_SA(1, 1), a1 + hstepA, voffA);
            FG_WAIT_V(8); FG_WAIT_L(0); FG_BAR; FG_MMA(0, 0, At, B0); FG_MMA(0, 1, At, B1); FG_BAR; FG_SCHED;
            FG_LDA(At, 0, 1); FG_STAGE(FG_SB(0, 0), b2, voffB); FG_STAGE(FG_SB(0, 1), b2 + hstepB, voffB); FG_STAGE(FG_SA(0, 0), a2, voffA);
            FG_WAIT_V(8); FG_WAIT_L(0); FG_BAR; FG_MMA(1, 0, At, B0); FG_MMA(1, 1, At, B1); FG_BAR; FG_SCHED;
            FG_LDB(B0, 1, 0); FG_LDB(B1, 1, 1); FG_SCHED; FG_LDA(At, 1, 0); FG_STAGE(FG_SA(0, 1), a2 + hstepA, voffA);
            FG_WAIT_V(8); FG_WAIT_L(0); FG_BAR; FG_MMA(0, 0, At, B0); FG_MMA(0, 1, At, B1); FG_BAR; FG_SCHED;
            FG_LDA(At, 1, 1); FG_STAGE(FG_SB(1, 0), b3, voffB); FG_STAGE(FG_SB(1, 1), b3 + hstepB, voffB); FG_STAGE(FG_SA(1, 0), a3, voffA);
            FG_WAIT_V(8); FG_WAIT_L(0); FG_BAR; FG_MMA(1, 0, At, B0); FG_MMA(1, 1, At, B1); FG_BAR; FG_SCHED;
        }
        if (wr == 0) FG_BAR;
        bool keep_acc = false;
        {
            const auto Ez = E.z(cur.z);
            if constexpr (Epi::CHAIN) keep_acc = Epi::keep(cur.z);
            if constexpr (Epi::CHAIN) Ez.pre(cur.pm, cur.pn, cur.z);
#pragma unroll
            for (int ai = 0; ai < 2; ++ai)
#pragma unroll
                for (int m = 0; m < 4; ++m)
#pragma unroll
                    for (int bj = 0; bj < 2; ++bj) {
                        const int row_ = cur.pm * BM + ai * HALF + wr * 64 + m * 16 + fr, col_ = cur.pn * BM + bj * HALF + wc * 32 + (Epi::PERM ? 8 : 4) * fq;
                        if constexpr (Epi::CHAIN) Ez.chain(row_, col_, acc[ai][bj][m][0], acc[ai][bj][m][1], cur.z);
                        else Ez(row_, col_, acc[ai][bj][m][0], acc[ai][bj][m][1]);
                        if (bj == 1 && (m & 1)) asm volatile("" ::: "memory");
                    }
            if constexpr (Epi::CHAIN) Ez.post(cur.pm, cur.pn, cur.z);
        }
        if (!has_next) break;
        if (!keep_acc) {
#pragma unroll
        for (int a = 0; a < 2; ++a)
#pragma unroll
            for (int b = 0; b < 2; ++b)
#pragma unroll
                for (int m = 0; m < 4; ++m)
#pragma unroll
                    for (int n = 0; n < 2; ++n) acc[a][b][m][n] = (f32x4){0.f, 0.f, 0.f, 0.f};
        }
        cur = nxt; cA = nA; cB = nB; ++ui;
        if (wr == 1) FG_BAR;
    }
    FG_WAIT_V(0);
    FG_BAR;
#undef FG_SA
#undef FG_SB
#undef FG_STAGE
#undef FG_LDA
#undef FG_LDB
#undef FG_MMA
#undef FG_WAIT_V
#undef FG_WAIT_L
#undef FG_BAR
#undef FG_SCHED
}

struct UnitM { const GAS char* A; const GAS char* B; int lda, ldb, nt, pm, pn, z, job; };
template <class EpiM, class SM>
__device__ __forceinline__ void gemm_multi(LAS unsigned char* lds, const SM& S, const EpiM& E) {
    const int tid = tid_op(), wid = __builtin_amdgcn_readfirstlane(tid >> 6), lane = tid & 63, wr = wid >> 2, wc = wid & 3, fr = lane & 15, fq = lane >> 4;
    int sR[2], sRb[2], sC[2];
#pragma unroll
    for (int i = 0; i < 2; ++i) { stage_rc(tid * 16 + i * 8192, sR[i], sC[i]); sRb[i] = (sR[i] & ~31) + perm32(sR[i] & 31); }
    const size_t kstep = (size_t)(BK * 2);
    const unsigned ldsw = (unsigned)wid * 1024u;
    const int aoff = lds_byte(wr * 64 + fr, fq * 8), boff = lds_byte(wc * 32 + fr, fq * 8);
#define FG_SA(b, h) (((b) * 2 + (h)) * HTB)
#define FG_SB(b, h) ((4 + (b) * 2 + (h)) * HTB)
#define FG_STAGE(bufoff, gbase, voff) do { _Pragma("unroll") for (int _i = 0; _i < 2; ++_i) \
        __builtin_amdgcn_global_load_lds((const GAS unsigned*)((const GAS char*)(gbase) + (voff)[_i]), (LAS unsigned*)(lds + (bufoff) + ldsw + _i * 8192), 16, 0, 0); } while (0)
#define FG_LDA(dst, b, h) do { _Pragma("unroll") for (int m = 0; m < 4; ++m) _Pragma("unroll") for (int k = 0; k < 2; ++k) dst[m][k] = *(const LAS bf16x8*)(lds + FG_SA(b, h) + aoff + m * 2048 + k * 1024); } while (0)
#define FG_LDB(dst, b, h) do { _Pragma("unroll") for (int n = 0; n < 2; ++n) _Pragma("unroll") for (int k = 0; k < 2; ++k) dst[n][k] = *(const LAS bf16x8*)(lds + FG_SB(b, h) + boff + n * 2048 + k * 1024); } while (0)
#define FG_MMA(ai, bj, At, Bt) do { __builtin_amdgcn_s_setprio(1); _Pragma("unroll") for (int m = 0; m < 4; ++m) _Pragma("unroll") for (int n = 0; n < 2; ++n) _Pragma("unroll") for (int k = 0; k < 2; ++k) \
        acc[ai][bj][m][n] = __builtin_amdgcn_mfma_f32_16x16x32_bf16(Bt[n][k], At[m][k], acc[ai][bj][m][n], 0, 0, 0); __builtin_amdgcn_s_setprio(0); } while (0)
#define FG_WAIT_V(n) asm volatile("s_waitcnt vmcnt(" #n ")" ::: "memory")
#define FG_WAIT_L(n) asm volatile("s_waitcnt lgkmcnt(" #n ")" ::: "memory")
#define FG_BAR __builtin_amdgcn_s_barrier()
#define FG_SCHED __builtin_amdgcn_sched_barrier(0)
#define FG_OFFS(u, vA, vB, hA, hB) do { _Pragma("unroll") for (int _i = 0; _i < 2; ++_i) { vA[_i] = (unsigned)(sR[_i] * (u).lda + sC[_i]) * 2u; vB[_i] = (unsigned)(sRb[_i] * (u).ldb + sC[_i]) * 2u; } \
        hA = (size_t)HALF * (u).lda * 2; hB = (size_t)HALF * (u).ldb * 2; } while (0)
    UnitM cur, nxt; int ui = 0;
    if (!S.next(0, cur)) return;
    unsigned vAc[2], vBc[2], vAn[2], vBn[2]; size_t hAc, hBc, hAn, hBn;
    FG_OFFS(cur, vAc, vBc, hAc, hBc);
    f32x4 acc[2][2][4][2];
#pragma unroll
    for (int a = 0; a < 2; ++a)
#pragma unroll
        for (int b = 0; b < 2; ++b)
#pragma unroll
            for (int m = 0; m < 4; ++m)
#pragma unroll
                for (int n = 0; n < 2; ++n) acc[a][b][m][n] = (f32x4){0.f, 0.f, 0.f, 0.f};
    bf16x8 At[4][2], B0[2][2], B1[2][2];
    const GAS char* cA = cur.A; const GAS char* cB = cur.B;
    FG_STAGE(FG_SB(0, 0), cB, vBc); FG_STAGE(FG_SB(0, 1), cB + hBc, vBc); FG_STAGE(FG_SA(0, 0), cA, vAc); FG_STAGE(FG_SA(0, 1), cA + hAc, vAc);
    if (wr == 1) FG_BAR;
    FG_WAIT_V(2); FG_BAR;
    FG_STAGE(FG_SB(1, 0), cB + kstep, vBc); FG_STAGE(FG_SA(1, 0), cA + kstep, vAc); FG_STAGE(FG_SB(1, 1), cB + hBc + kstep, vBc);
    FG_WAIT_V(6); FG_BAR;
    for (;;) {
        const bool has_next = S.next(ui + 1, nxt);
        if (!has_next) nxt = cur;
        FG_OFFS(nxt, vAn, vBn, hAn, hBn);
        const GAS char* nA = nxt.A; const GAS char* nB = nxt.B;
        const int nt = cur.nt;
        for (int t = 0; t < nt; t += 2) {
            const bool last = (t == nt - 2);
            const GAS char* a1 = cA + (size_t)(t + 1) * kstep;
            const GAS char* a2 = last ? nA : cA + (size_t)(t + 2) * kstep; const GAS char* b2 = last ? nB : cB + (size_t)(t + 2) * kstep;
            const GAS char* a3 = a2 + kstep; const GAS char* b3 = b2 + kstep;
            unsigned vA2[2], vB2[2];
#pragma unroll
            for (int _i = 0; _i < 2; ++_i) { vA2[_i] = last ? vAn[_i] : vAc[_i]; vB2[_i] = last ? vBn[_i] : vBc[_i]; }
            const size_t hA2 = last ? hAn : hAc, hB2 = last ? hBn : hBc;
            FG_LDB(B0, 0, 0); FG_LDB(B1, 0, 1); FG_SCHED; FG_LDA(At, 0, 0); FG_STAGE(FG_SA(1, 1), a1 + hAc, vAc);
            FG_WAIT_V(8); FG_WAIT_L(0); FG_BAR; FG_MMA(0, 0, At, B0); FG_MMA(0, 1, At, B1); FG_BAR; FG_SCHED;
            FG_LDA(At, 0, 1); FG_STAGE(FG_SB(0, 0), b2, vB2); FG_STAGE(FG_SB(0, 1), b2 + hB2, vB2); FG_STAGE(FG_SA(0, 0), a2, vA2);
            FG_WAIT_V(8); FG_WAIT_L(0); FG_BAR; FG_MMA(1, 0, At, B0); FG_MMA(1, 1, At, B1); FG_BAR; FG_SCHED;
            FG_LDB(B0, 1, 0); FG_LDB(B1, 1, 1); FG_SCHED; FG_LDA(At, 1, 0); FG_STAGE(FG_SA(0, 1), a2 + hA2, vA2);
            FG_WAIT_V(8); FG_WAIT_L(0); FG_BAR; FG_MMA(0, 0, At, B0); FG_MMA(0, 1, At, B1); FG_BAR; FG_SCHED;
            FG_LDA(At, 1, 1); FG_STAGE(FG_SB(1, 0), b3, vB2); FG_STAGE(FG_SB(1, 1), b3 + hB2, vB2); FG_STAGE(FG_SA(1, 0), a3, vA2);
            FG_WAIT_V(8); FG_WAIT_L(0); FG_BAR; FG_MMA(1, 0, At, B0); FG_MMA(1, 1, At, B1); FG_BAR; FG_SCHED;
        }
        if (wr == 0) FG_BAR;
#pragma unroll
        for (int ai = 0; ai < 2; ++ai)
#pragma unroll
            for (int m = 0; m < 4; ++m)
#pragma unroll
                for (int bj = 0; bj < 2; ++bj) {
                    E.apply(cur, cur.pm * BM + ai * HALF + wr * 64 + m * 16 + fr, cur.pn * BM + bj * HALF + wc * 32 + 8 * fq, acc[ai][bj][m][0], acc[ai][bj][m][1]);
                    if (bj == 1 && (m & 1)) asm volatile("" ::: "memory");
                }
        if (!has_next) break;
#pragma unroll
        for (int a = 0; a < 2; ++a)
#pragma unroll
            for (int b = 0; b < 2; ++b)
#pragma unroll
                for (int m = 0; m < 4; ++m)
#pragma unroll
                    for (int n = 0; n < 2; ++n) acc[a][b][m][n] = (f32x4){0.f, 0.f, 0.f, 0.f};
        cur = nxt; cA = nA; cB = nB; ++ui;
#pragma unroll
        for (int _i = 0; _i < 2; ++_i) { vAc[_i] = vAn[_i]; vBc[_i] = vBn[_i]; }
        hAc = hAn; hBc = hBn;
        if (wr == 1) FG_BAR;
    }
    FG_WAIT_V(0);
    FG_BAR;
#undef FG_SA
#undef FG_SB
#undef FG_STAGE
#undef FG_LDA
#undef FG_LDB
#undef FG_MMA
#undef FG_WAIT_V
#undef FG_WAIT_L
#undef FG_BAR
#undef FG_SCHED
#undef FG_OFFS
}
struct SchedBranch { const gbf* AB; const gbf* WpT; int nM, nN, G, c, pm0;
    __device__ __forceinline__ bool next(int i, Unit& u) const {
        const int nwg = nM * nN; const long L = (long)(i >> 2) * G + c; if (L >= nwg) return false;
        int wgid = (int)L; { const int q = nwg / NXCD, r = nwg % NXCD, xcd = wgid % NXCD, off = wgid / NXCD; wgid = (xcd < r ? xcd * (q + 1) : r * (q + 1) + (xcd - r) * q) + off; }
        const int nig = WGM * nN, gidx = wgid / nig, fm = gidx * WGM, gsz = (nM - fm) < WGM ? (nM - fm) : WGM;
        u.pm = fm + ((wgid % nig) % gsz); u.pn = (wgid % nig) / gsz; u.z = i & 3;
        u.A = (const GAS char*)(AB + (size_t)(pm0 + u.pm) * BM * ABW + u.z * 1024); u.B = (const GAS char*)(WpT + ((size_t)u.z * 2048 + (size_t)u.pn * BM) * KP1); return true;
    }
};
struct SchedBranchH { const gbf* AB; const gbf* WpT; int nM, nN, c, pm0;
    __device__ __forceinline__ bool next(int i, Unit& u) const {
        if (i >= 2 || (c >> 1) >= nM * nN) return false;
        const int t = c >> 1; u.pm = t % nM; u.pn = t / nM; u.z = 2 * (c & 1) + i;
        u.A = (const GAS char*)(AB + (size_t)(pm0 + u.pm) * BM * ABW + u.z * 1024); u.B = (const GAS char*)(WpT + ((size_t)u.z * 2048 + (size_t)u.pn * BM) * KP1); return true;
    }
};
struct SchedIn0 { const gbf* U; const gbf* WinT; int G, c, i0, i1;
    __device__ __forceinline__ bool next(int i, Unit& u) const {
        const int ii = i + i0; if (ii >= i1) return false;
        const int L = ii * G + c; if (L >= 36 * 80) return false;
        const int xcd = L & 7, off = L >> 3; int t, nNc, pn0;
        if (off < 216) { t = xcd * 216 + off; nNc = 48; pn0 = 0; } else { t = xcd * 144 + (off - 216); nNc = 32; pn0 = 48; }
        const int nig = WGM * nNc, gidx = t / nig, fm = gidx * WGM, gsz = (36 - fm) < WGM ? (36 - fm) : WGM;
        u.pm = fm + ((t % nig) % gsz); u.pn = pn0 + (t % nig) / gsz; u.z = 0;
        u.A = (const GAS char*)(U + (size_t)u.pm * BM * KP2); u.B = (const GAS char*)(WinT + (size_t)u.pn * BM * KP2); return true;
    }
};
struct MapPlain { const gbf* A; int lda; const gbf* Bt; int ldb;
    __device__ __forceinline__ const gbf* a(int, int pm) const { return A + (size_t)pm * BM * lda; }
    __device__ __forceinline__ const gbf* b(int, int pn) const { return Bt + (size_t)pn * BM * ldb; } };
}

template <class Epi>
__device__ __forceinline__ void gemm_fast_plain(unsigned char* lds, const GemmJob j, const Epi& E, int gid, int G) {
    __syncthreads();
    fg::Sched<fg::MapPlain> S{fg::MapPlain{j.A, j.lda, j.Bt, j.ldb}, j.M / 256, j.N / 256, 1, G, gid};
    fg::gemm((LAS unsigned char*)lds, j.lda, j.ldb, j.K, S, E);
    __syncthreads();
}

struct MapF1 { const gbf* DC; const gbf* Pfv; int zrows;
    __device__ __forceinline__ const gbf* a(int, int pm) const { return DC + (size_t)pm * 256 * 256; }
    __device__ __forceinline__ const gbf* b(int z, int pn) const { return Pfv + ((size_t)(z >> 2) * zrows + (size_t)pn * 256) * PP + (z & 3) * 256; } };
struct MapF2 { const gbf* DN; const gbf* GT; int ld;
    __device__ __forceinline__ const gbf* a(int, int pm) const { return DN + (size_t)pm * 256 * ld; }
    __device__ __forceinline__ const gbf* b(int z, int pn) const { return GT + ((size_t)z * 1024 + (size_t)pn * 256) * ld; } };
template <class Map, class Epi>
__device__ __forceinline__ void gemm_fast_z(unsigned char* lds, const Map& map, int lda, int ldb, int K, int nM, int nN, int nz, const Epi& E, int c, int Gs) {
    __syncthreads();
    if (c >= 0) { fg::Sched<Map> S{map, nM, nN, nz, Gs, c}; fg::gemm((LAS unsigned char*)lds, lda, ldb, K, S, E); }
    __syncthreads();
}

template <class Epi>
__device__ __forceinline__ void gemm_run(unsigned char* lds, const GemmJob j, const Epi& E, int first, int stride) {
    gemm_fast_plain(lds, j, E, first, stride);
}

struct EpiInProj {
    static constexpr bool PERM = true, CHAIN = false;
    gbf* P; int row0; gbf* NK; gbf* NV; gbf* NQ; gbf* MG;
    __device__ __forceinline__ EpiInProj z(int) const { return *this; }
    __device__ __forceinline__ void operator()(int row, int col, f32x4 a, f32x4 b) const {
        if (col >= C_MG) {
#pragma unroll
            for (int i = 0; i < 4; ++i) { a[i] = sigmoidf_(fminf(fmaxf(a[i], -30.f), 30.f)); b[i] = sigmoidf_(fminf(fmaxf(b[i], -30.f), 30.f)); }
        } else if (col >= C_GCV) {
#pragma unroll
            for (int i = 0; i < 4; ++i) { a[i] = siluf_(a[i]); b[i] = siluf_(b[i]); }
        } else if (col >= C_NAQ && col < C_CB) { a = a * NASCALE; b = b * NASCALE; }
        const int r = row0 + row;
        if (col >= C_MG) { const int cc = col - C_MG; __builtin_nontemporal_store(pk8(a, b), (GAS u32x4*)(MG + mg_off(cc >> 11, r, cc & 2047))); }
        else if (col >= C_NAK && col < C_CB && !(col >= C_QL && col < C_NAQ)) {
            const int sel = (col < C_NAV) ? 0 : (col < C_QL) ? 1 : 2, cc = (col < C_NAV) ? col - C_NAK : (col < C_QL) ? col - C_NAV : col - C_NAQ;
            __builtin_nontemporal_store(pk8(a, b), (GAS u32x4*)(NK + (size_t)sel * ((WS_NV - WS_NK) / 2) + hm_row(r, cc >> 6, 16) * 64 + (cc & 63)));
        } else __builtin_nontemporal_store(pk8(a, b), (GAS u32x4*)(P + (size_t)r * PP + col));
    }
};
struct EpiInProjC1 {
    static constexpr bool PERM = true, CHAIN = false;
    gbf* P; gbf* NK; gbf* KM; gf32* SSQ;
    __device__ __forceinline__ EpiInProjC1 z(int) const { return *this; }
    __device__ __forceinline__ void operator()(int row, int col, f32x4 a, f32x4 b) const {
        const int r = NLAT + row;
        if (col < 256) {
            *(GAS u32x4*)(P + (size_t)r * PP + col) = pk8(a, b);
            float s = a[0] * a[0] + a[1] * a[1] + a[2] * a[2] + a[3] * a[3] + b[0] * b[0] + b[1] * b[1] + b[2] * b[2] + b[3] * b[3];
            s += __shfl_xor(s, 16); s += __shfl_xor(s, 32);
            if ((col & 31) == 0) SSQ[(size_t)row * 8 + (col >> 5)] = s;
        } else if (col < 512) {
            if (col < 320) { const u32x4 v = pk8(a, b);
#pragma unroll
                for (int h = 0; h < 8; ++h) *(GAS u32x4*)(KM + hm_row(r, h, 8) * 192 + 128 + (col - 256)) = v; }
        } else {
            const int sel = (col < C_NAV) ? 0 : 1, cc = (col < C_NAV) ? col - C_NAK : col - C_NAV;
            *(GAS u32x4*)(NK + (size_t)sel * ((WS_NV - WS_NK) / 2) + hm_row(r, cc >> 6, 16) * 64 + (cc & 63)) = pk8(a, b);
        }
    }
};
struct EpiKvUp {
    static constexpr bool PERM = true, CHAIN = false;
    gbf* KM; gbf* VM; const gf32* rstd; int row0;
    __device__ __forceinline__ EpiKvUp z(int) const { return *this; }
    __device__ __forceinline__ void operator()(int row, int col, f32x4 a, f32x4 b) const {
        const int r = row0 + row, h = col >> 8, jj = col & 255; const float s = rstd[r];
        const size_t hr = hm_row(r, h, 8); gbf* p = (jj < 128) ? KM + hr * 192 + jj : VM + hr * 128 + (jj - 128);
        *(GAS u32x4*)p = pk8(a * s, b * s);
    }
};
struct EpiQUp {
    static constexpr bool PERM = false, CHAIN = false;
    gbf* QM; const gf32* rstd; const gf32* rope; int row0;
    __device__ __forceinline__ EpiQUp z(int) const { return *this; }
    __device__ __forceinline__ void operator()(int row, int col, f32x4 a, f32x4 b) const {
        const int r = row0 + row, h = col / 192, jj = col - h * 192; const float s = rstd[r] * QSCALE;
        a = a * s; b = b * s;
        if (jj >= 128 && r < NLAT) {
            const int t = r & (SEQ - 1), e = jj - 128, pos = (e < 32) ? (t >> 6) : (t & 63), f0 = e & 15;
            const gf32* rp = rope + (pos * 16 + f0) * 2;
#pragma unroll
            for (int i = 0; i < 4; ++i) { const float c = rp[2 * i], sn = rp[2 * i + 1]; const float x = a[i], y = b[i]; a[i] = x * c - y * sn; b[i] = x * sn + y * c; }
        }
        gbf* p = QM + hm_row(r, h, 8) * 192 + jj;
        *(GAS u32x2*)p = pk4(a); *(GAS u32x2*)(p + 16) = pk4(b);
    }
};
struct EpiF1 {
    static constexpr bool PERM = true, CHAIN = false;
    gbf* GT; int S; int g;
    __device__ __forceinline__ EpiF1 z(int zz) const { return EpiF1{GT + (size_t)(zz >> 2) * 1024 * 2 * S, S, zz & 3}; }
    __device__ __forceinline__ void operator()(int row, int col, f32x4 a, f32x4 b) const {
        *(GAS u32x4*)(GT + (size_t)(g * 256 + (row & 255)) * (2 * S) + (row >> 8) * S + col) = pk8(a, b);
    }
};
struct EpiF2 {
    static constexpr bool PERM = true, CHAIN = false;
    gbf* AB; const gbf* P; int row0; int zrows;
    __device__ __forceinline__ EpiF2 z(int zz) const { return EpiF2{AB, P, row0 + zz * zrows, zrows}; }
    __device__ __forceinline__ void operator()(int row, int col, f32x4 a, f32x4 b) const {
        const size_t r = (size_t)(row0 + row);
        f32x4 ga, gb; unpk8(*(const GAS u32x4*)(P + r * PP + C_GFN + col), ga, gb);
        *(GAS u32x4*)(AB + r * ABW + 3072 + col) = pk8(a * ga, b * gb);
    }
};
struct EpiF2M {
    static constexpr bool PERM = true, CHAIN = false;
    gbf* AB; const gbf* P; int row0; int zrows;
    __device__ __forceinline__ EpiF2M z(int zz) const { return EpiF2M{AB, P, row0 + zz * zrows, zrows}; }
    __device__ __forceinline__ void operator()(int row, int col, f32x4 a, f32x4 b) const {
        const size_t r = (size_t)(row0 + row);
        f32x4 ga, gb; unpk8(*(const GAS u32x4*)(P + r * PP + C_GFN + col), ga, gb);
        *(GAS u32x4*)(AB + r * ABW + 3072 + col) = pk8(a * ga, b * gb);
        if (row != 0) {
            const size_t rm = (size_t)(row0 + SEQ - row); const int gbase = col & ~255, c = col & 255;
            const int cA = gbase + 248 - c, cB = gbase + ((256 - c) & 255);
            f32x4 xa, xb, ya, yb; unpk8(*(const GAS u32x4*)(P + rm * PP + C_GFN + cA), xa, xb); unpk8(*(const GAS u32x4*)(P + rm * PP + C_GFN + cB), ya, yb);
            gbf* o = AB + rm * ABW + 3072;
            *(GAS unsigned short*)(o + cA + 1) = (unsigned short)f2bf(b[3] * xa[1]);
            *(GAS unsigned*)(o + cA + 2) = pk2(b[2] * xa[2], b[1] * xa[3]);
            *(GAS unsigned*)(o + cA + 4) = pk2(b[0] * xb[0], a[3] * xb[1]);
            *(GAS unsigned*)(o + cA + 6) = pk2(a[2] * xb[2], a[1] * xb[3]);
            *(GAS unsigned short*)(o + cB) = (unsigned short)f2bf(a[0] * ya[0]);
            (void)yb;
        }
    }
};
struct EpiBranch {
    static constexpr bool PERM = true, CHAIN = false;
    gf32* MF; gbf* MB; const gbf* P; int i; int row0;
    __device__ __forceinline__ EpiBranch z(int) const { return *this; }
    __device__ __forceinline__ void operator()(int row, int col, f32x4 a, f32x4 b) const {
        const size_t r = (size_t)(row0 + row);
        f32x4 ga, gb; unpk8(*(const GAS u32x4*)(P + r * PP + C_MG + i * DM + col), ga, gb);
        gf32* m = MF + r * DM + col;
        f32x4 va = a * ga, vb = b * gb;
        if (i > 0) { va += *(const GAS f32x4*)m; vb += *(const GAS f32x4*)(m + 4); }
        if (i < 3) { *(GAS f32x4*)m = va; *(GAS f32x4*)(m + 4) = vb; }
        else *(GAS u32x4*)(MB + r * DM + col) = pk8(va, vb);
    }
};
struct EpiChain {
    static constexpr bool PERM = true, CHAIN = true;
    gbf* MB; const gbf* P; int row0;
    __device__ __forceinline__ EpiChain z(int) const { return *this; }
    static __device__ __forceinline__ bool keep(int zz) { return zz < 3; }
    __device__ __forceinline__ void pre(int, int, int) const {}
    __device__ __forceinline__ void post(int, int, int) const {}
    __device__ __forceinline__ void chain(int row, int col, f32x4& a, f32x4& b, int zz) const {
        const size_t r = (size_t)(row0 + row);
        if (zz < 3) {
            f32x4 ga, gb, ha, hb; unpk8(__builtin_nontemporal_load((const GAS u32x4*)(P + mg_off(zz, (int)r, col))), ga, gb); unpk8(__builtin_nontemporal_load((const GAS u32x4*)(P + mg_off(zz + 1, (int)r, col))), ha, hb);
#pragma unroll
            for (int i = 0; i < 4; ++i) { a[i] *= ga[i] * __builtin_amdgcn_rcpf(ha[i]); b[i] *= gb[i] * __builtin_amdgcn_rcpf(hb[i]); }
        } else {
            f32x4 ga, gb; unpk8(__builtin_nontemporal_load((const GAS u32x4*)(P + mg_off(3, (int)r, col))), ga, gb);
            *(GAS u32x4*)(MB + r * KP2 + col) = pk8(a * ga, b * gb);
        }
    }
};
#define HC_FLAG0 3700
struct EpiChainH {
    static constexpr bool PERM = true, CHAIN = true;
    gbf* MB; const gbf* P; int row0; gf32* PART; unsigned* flags;
    __device__ __forceinline__ EpiChainH z(int) const { return *this; }
    static __device__ __forceinline__ bool keep(int zz) { return (zz & 1) == 0; }
    __device__ __forceinline__ void pre(int pm, int pn, int zz) const {
        if (zz == 3) {
            if (threadIdx.x == 0) { unsigned sp = 0; while (__hip_atomic_load(flags + pm * 8 + pn, __ATOMIC_ACQUIRE, __HIP_MEMORY_SCOPE_AGENT) == 0u && ++sp < (1u << 22)) __builtin_amdgcn_s_sleep(2); }
            __syncthreads(); __builtin_amdgcn_fence(__ATOMIC_ACQUIRE, "agent");
        }
    }
    __device__ __forceinline__ void post(int pm, int pn, int zz) const {
        if (zz == 1) {
            asm volatile("s_waitcnt vmcnt(0)" ::: "memory"); __syncthreads();
            if (threadIdx.x == 0) { __builtin_amdgcn_fence(__ATOMIC_RELEASE, "agent"); __hip_atomic_store(flags + pm * 8 + pn, 1u, __ATOMIC_RELEASE, __HIP_MEMORY_SCOPE_AGENT); }
        }
    }
    __device__ __forceinline__ void chain(int row, int col, f32x4& a, f32x4& b, int zz) const {
        const size_t r = (size_t)(row0 + row);
        if ((zz & 1) == 0) {
            f32x4 ga, gb, ha, hb; unpk8(__builtin_nontemporal_load((const GAS u32x4*)(P + mg_off(zz, (int)r, col))), ga, gb); unpk8(__builtin_nontemporal_load((const GAS u32x4*)(P + mg_off(zz + 1, (int)r, col))), ha, hb);
#pragma unroll
            for (int i = 0; i < 4; ++i) { a[i] *= ga[i] * __builtin_amdgcn_rcpf(ha[i]); b[i] *= gb[i] * __builtin_amdgcn_rcpf(hb[i]); }
        } else {
            f32x4 ga, gb; unpk8(__builtin_nontemporal_load((const GAS u32x4*)(P + mg_off(zz, (int)r, col))), ga, gb);
            gf32* pp = PART + (size_t)row * DM + col;
            if (zz == 1) { *(GAS f32x4*)pp = a * ga; *(GAS f32x4*)(pp + 4) = b * gb; }
            else { const f32x4 pa = *(const GAS f32x4*)pp, pb = *(const GAS f32x4*)(pp + 4); *(GAS u32x4*)(MB + r * KP2 + col) = pk8(a * ga + pa, b * gb + pb); }
        }
    }
};
struct EpiOut {
    static constexpr bool PERM = true, CHAIN = false;
    gf32* Y; int row0;
    __device__ __forceinline__ EpiOut z(int) const { return *this; }
    __device__ __forceinline__ void operator()(int row, int col, f32x4 a, f32x4 b) const {
        gf32* p = Y + (size_t)(row0 + row) * DM + col; *(GAS f32x4*)p = a; *(GAS f32x4*)(p + 4) = b;
    }
};

struct EpiC2 {
    gbf* KM; gbf* VM; gbf* QM; gbf* GT; gbf* GTC; const gf32* RKV; const gf32* RQ; const gf32* rope; const gf32* SSQ;
    __device__ __forceinline__ void apply(const fg::UnitM& u, int row, int col, f32x4 a, f32x4 b) const {
        if (u.job == 0) {
            const int h = col >> 8, jj = col & 255; float s;
            if (SSQ != nullptr && row >= NLAT) { const f32x4 s0 = *(const GAS f32x4*)(SSQ + (size_t)(row - NLAT) * 8), s1 = *(const GAS f32x4*)(SSQ + (size_t)(row - NLAT) * 8 + 4);
                s = rsqrtf(((s0[0] + s0[1]) + (s0[2] + s0[3]) + (s1[0] + s1[1]) + (s1[2] + s1[3])) * (1.0f / 256.0f) + EPS); }
            else s = RKV[row];
            const size_t hr = hm_row(row, h, 8); gbf* p = (jj < 128) ? KM + hr * 192 + jj : VM + hr * 128 + (jj - 128);
            *(GAS u32x4*)p = pk8(a * s, b * s);
        } else if (u.job == 1) {
            const int h = col / 192, jj = col - h * 192; const float s = RQ[row] * QSCALE;
            a = a * s; b = b * s;
            if (jj >= 128 && row < NLAT) {
                const int t = row & (SEQ - 1), e = jj - 128, pos = (e < 32) ? (t >> 6) : (t & 63), f0 = e & 15; const bool second = (e & 16) != 0;
                const gf32* rp = rope + (pos * 16 + f0) * 2;
                const f32x4 cs0 = *(const GAS f32x4*)rp, cs1 = *(const GAS f32x4*)(rp + 4), cs2 = *(const GAS f32x4*)(rp + 8), cs3 = *(const GAS f32x4*)(rp + 12);
                const float cc[8] = {cs0[0], cs0[2], cs1[0], cs1[2], cs2[0], cs2[2], cs3[0], cs3[2]}, ss[8] = {cs0[1], cs0[3], cs1[1], cs1[3], cs2[1], cs2[3], cs3[1], cs3[3]};
#pragma unroll
                for (int i = 0; i < 4; ++i) { const float ya = __shfl_xor(a[i], 32), yb = __shfl_xor(b[i], 32);
                    a[i] = second ? (ya * ss[i] + a[i] * cc[i]) : (a[i] * cc[i] - ya * ss[i]);
                    b[i] = second ? (yb * ss[4 + i] + b[i] * cc[4 + i]) : (b[i] * cc[4 + i] - yb * ss[4 + i]); }
            }
            *(GAS u32x4*)(QM + hm_row(row, h, 8) * 192 + jj) = pk8(a, b);
        } else {
            const int S_ = (u.job == 2) ? SEQ : CTXL, ld_ = (u.job == 2) ? KP4 : 2 * CTXL; gbf* G_ = (u.job == 2) ? GT : GTC; const int bb = u.z >> 2, g = u.z & 3;
            *(GAS u32x4*)(G_ + (size_t)bb * 1024 * ld_ + (size_t)(g * 256 + (row & 255)) * ld_ + (row >> 8) * S_ + col) = pk8(a, b);
        }
    }
};
struct SchedC2 {
    const gbf* P; const gbf* WukvT; const gbf* WuqT; const gbf* DC; int nq_tiles, n3, G, c;
    __device__ __forceinline__ bool next(int i, fg::UnitM& u) const {
        int L = i * G + c; const int n0 = (NROW / 256) * 8, n1 = nq_tiles * 6, n2 = 16 * 2 * 8;
        if (L < n0) { u.job = 0; u.pm = L >> 3; u.pn = L & 7; u.z = 0; u.lda = PP; u.ldb = 256; u.nt = 4;
            u.A = (const GAS char*)(P + (size_t)u.pm * 256 * PP + C_CKV); u.B = (const GAS char*)(WukvT + (size_t)u.pn * 256 * 256); return true; }
        L -= n0;
        if (L < n1) { u.job = 1; u.pm = L / 6; u.pn = L % 6; u.z = 0; u.lda = PP; u.ldb = 512; u.nt = 8;
            u.A = (const GAS char*)(P + (size_t)u.pm * 256 * PP + C_QL); u.B = (const GAS char*)(WuqT + (size_t)u.pn * 256 * 512); return true; }
        L -= n1;
        if (L < n2) { u.job = 2; u.z = L >> 4; u.pm = (L >> 3) & 1; u.pn = L & 7; u.lda = 256; u.ldb = PP; u.nt = 4;
            u.A = (const GAS char*)(DC + (size_t)u.pm * 256 * 256); u.B = (const GAS char*)(P + ((size_t)(u.z >> 2) * SEQ + (size_t)u.pn * 256) * PP + C_FV + (u.z & 3) * 256); return true; }
        L -= n2;
        if (L < n3) { u.job = 3; u.z = L >> 1; u.pm = L & 1; u.pn = 0; u.lda = 256; u.ldb = PP; u.nt = 4;
            u.A = (const GAS char*)(DC + (size_t)u.pm * 256 * 256); u.B = (const GAS char*)(P + ((size_t)NLAT + (size_t)(u.z >> 2) * CTXL) * PP + C_FV + (u.z & 3) * 256); return true; }
        return false;
    }
};

struct TrItem { const gf32* W; gbf* WT; const gf32* ks; int N, ldt, k0, n0, nd0; };
constexpr int TR_IN = 32 * 634, TR_KV = 4 * 64, TR_Q = 8 * 48, TR_P = 16 * 64, TR_O = 32 * 64;
constexpr int TR_PER_L = TR_IN + TR_KV + TR_Q + 4 * TR_P + TR_O;
__device__ __forceinline__ TrItem tr_decode(int it) {
    gu8* ws = wsb();
    const int l = it / TR_PER_L; int r = it % TR_PER_L;
    const gf32* W; gbf* WT; const gf32* ks = nullptr; int K, N, ldt; bool remap = false;
    if (r < TR_IN) { W = pin(I_WIN) + (size_t)l * DM * N_IN; K = DM; N = N_IN; WT = (gbf*)(ws + WS_WIN) + (size_t)l * NP * KP2; ldt = KP2; remap = true; }
    else if ((r -= TR_IN) < TR_KV) { W = pin(I_WUKV) + (size_t)l * 256 * 2048; K = 256; N = 2048; WT = (gbf*)(ws + WS_WUKV) + (size_t)l * 2048 * 256; ldt = 256; ks = pin(I_GKV) + l * 256; }
    else if ((r -= TR_KV) < TR_Q) { W = pin(I_WUQ) + (size_t)l * 512 * 1536; K = 512; N = 1536; WT = (gbf*)(ws + WS_WUQ) + (size_t)l * 1536 * 512; ldt = 512; ks = pin(I_GQ) + l * 512; }
    else if ((r -= TR_Q) < 4 * TR_P) { const int b = r / TR_P; r = r % TR_P; W = pin(I_WPC + b) + (size_t)l * 1024 * 2048; K = 1024; N = 2048; WT = (gbf*)(ws + WS_WP) + ((size_t)l * 4 + b) * 2048 * KP1; ldt = KP1; }
    else { r -= 4 * TR_P; W = pin(I_WOUT) + (size_t)l * 2048 * 2048; K = 2048; N = 2048; WT = (gbf*)(ws + WS_WO) + (size_t)l * 2048 * KP2; ldt = KP2; }
    (void)K;
    const int nblk = N / 32, kb = r / nblk, nb = r % nblk, n0 = 32 * nb;
    return TrItem{W, WT, ks, N, ldt, 64 * kb, n0, (remap && n0 >= 320) ? n0 + 192 : n0};
}
__device__ __forceinline__ void tr_load(const TrItem& t, float (&v)[32], int lane) {
    const gf32* src = t.W + (size_t)(t.k0 + (lane >> 5)) * t.N + t.n0 + (lane & 31);
#pragma unroll
    for (int i = 0; i < 32; ++i) v[i] = __builtin_nontemporal_load(src + (size_t)(2 * i) * t.N);
}
__device__ __forceinline__ void tr_to_lds(const TrItem& t, const float (&v)[32], int lane, float* scr) {
    if (t.ks != nullptr) {
#pragma unroll
        for (int i = 0; i < 32; ++i) { const int kk = 2 * i + (lane >> 5); scr[kk * 33 + (lane & 31)] = v[i] * t.ks[t.k0 + kk]; }
    } else {
#pragma unroll
        for (int i = 0; i < 32; ++i) { const int kk = 2 * i + (lane >> 5); scr[kk * 33 + (lane & 31)] = v[i]; }
    }
    __builtin_amdgcn_fence(__ATOMIC_RELEASE, "wavefront"); asm volatile("s_waitcnt lgkmcnt(0)" ::: "memory");
}
__device__ __forceinline__ void tr_store(const TrItem& t, int lane, const float* scr) {
    const int c = lane & 7;
#pragma unroll
    for (int j = 0; j < 4; ++j) { const int n = (lane >> 3) + 8 * j; const float* s = scr + (8 * c) * 33 + n;
        u32x4 o; o.x = pk2(s[0 * 33], s[1 * 33]); o.y = pk2(s[2 * 33], s[3 * 33]); o.z = pk2(s[4 * 33], s[5 * 33]); o.w = pk2(s[6 * 33], s[7 * 33]);
        __builtin_nontemporal_store(o, (GAS u32x4*)(t.WT + (size_t)(t.nd0 + n) * t.ldt + t.k0 + 8 * c)); }
    asm volatile("s_waitcnt lgkmcnt(0)" ::: "memory");
}
__device__ __forceinline__ void weight_transposes(unsigned char* lds, int beg, int end, int gw, int ngw) {
    const int tid = tid_op(), lane = tid & 63, wid = tid >> 6;
    float* scr = (float*)lds + wid * (64 * 33);
    int it = beg + gw;
    if (it >= end) return;
    float v[32];
    TrItem cur = tr_decode(it);
    tr_load(cur, v, lane);
    while (true) {
        tr_to_lds(cur, v, lane, scr);
        const int nit = it + ngw; const bool more = nit < end;
        TrItem nx = cur;
        if (more) { nx = tr_decode(nit); tr_load(nx, v, lane); }
        tr_store(cur, lane, scr);
        if (!more) break;
        cur = nx; it = nit;
    }
}

__device__ __forceinline__ void phase0(const Params& p, unsigned char* lds, int gid, int G) {
    const int tid = tid_op(), lane = tid & 63, wid = tid >> 6;
    gu8* ws = wsb();
    {
        float* sv = (float*)lds;
        float* part = sv + 5 * 2048;
        bool have = false;
        for (int it = gid; it < 2 * 96; it += G) {
            if (!have) {
                for (int i = tid; i < 5 * 2048; i += NTHREADS) { const float v = (i < 4 * 2048) ? pin(I_C)[i] : pin(I_CCTX)[i - 4 * 2048]; sv[i] = siluf_(v); }
                have = true;
            }
            __syncthreads();
            const int l = it / 96, nb = it % 96;
            const gf32* W = pin(I_WADA) + (size_t)l * DM * 6144 + nb * 64 + lane;
            float a0 = 0.f, a1 = 0.f, a2 = 0.f, a3 = 0.f, a4 = 0.f;
#pragma unroll 8
            for (int k = wid * 256; k < wid * 256 + 256; ++k) {
                const float w = W[(size_t)k * 6144];
                a0 = fmaf(sv[k], w, a0); a1 = fmaf(sv[2048 + k], w, a1); a2 = fmaf(sv[4096 + k], w, a2); a3 = fmaf(sv[6144 + k], w, a3); a4 = fmaf(sv[8192 + k], w, a4);
            }
            part[(wid * 5 + 0) * 64 + lane] = a0; part[(wid * 5 + 1) * 64 + lane] = a1; part[(wid * 5 + 2) * 64 + lane] = a2; part[(wid * 5 + 3) * 64 + lane] = a3; part[(wid * 5 + 4) * 64 + lane] = a4;
            __syncthreads();
            if (tid < 320) {
                const int r = tid / 64, cidx = tid % 64; float s = 0.f;
#pragma unroll
                for (int w = 0; w < 8; ++w) s += part[(w * 5 + r) * 64 + cidx];
                const int n = nb * 64 + cidx;
                ((gf32*)(ws + WS_MOD))[((size_t)l * 5 + r) * 6144 + n] = s + pin(I_BADA)[(size_t)l * 6144 + n];
            }
        }
        __syncthreads();
    }
    {
        const long gt = (long)gid * NTHREADS + tid, NT = (long)G * NTHREADS;
        gf32* rope = (gf32*)(ws + WS_ROPE);
        for (long i = gt; i < 64 * 16; i += NT) { const int pos = (int)(i >> 4), f = (int)(i & 15); const float inv = exp2f(-(float)f * (13.287712379549449f / 16.0f)); const float ang = (float)pos * inv;
            rope[2 * i] = cosf(ang); rope[2 * i + 1] = sinf(ang); }
        gbf* DC = (gbf*)(ws + WS_DC);
        for (long i = gt; i < 512 * 256; i += NT) { const int m = (int)(i >> 8), k = (int)(i & 255); const int jdx = ((m & 255) * k) & 255; const float ang = (float)jdx * (6.283185307179586f / 256.0f);
            DC[i] = (bf16_t)f2bf((m < 256 ? cosf(ang) : sinf(ang)) * 0.0625f); }
        gbf* DN = (gbf*)(ws + WS_DN);
        for (long i = gt; i < (long)2048 * 4096; i += NT) { const int n = (int)(i >> 12), k = (int)(i & 4095); const int jdx = (n * (k & 2047)) & 2047; const float ang = (float)jdx * (6.283185307179586f / 2048.0f);
            DN[(size_t)n * KP4 + k] = (bf16_t)f2bf((k < 2048 ? cosf(ang) : -sinf(ang)) * 0.02209708691207961f); }
        gbf* DNC = (gbf*)(ws + WS_DNC);
        for (long i = gt; i < 256 * 512; i += NT) { const int n = (int)(i >> 9), k = (int)(i & 511); const int jdx = (n * (k & 255)) & 255; const float ang = (float)jdx * (6.283185307179586f / 256.0f);
            DNC[i] = (bf16_t)f2bf((k < 256 ? cosf(ang) : -sinf(ang)) * 0.0625f); }
        for (long i = gt; i < (long)2 * 192 * DM / 8; i += NT) { const int l = (int)(i / (192 * DM / 8)); const long r = i % (192 * DM / 8);
            *(GAS u32x4*)((gbf*)(ws + WS_WIN) + (size_t)l * NP * KP2 + (size_t)(320 + r / (DM / 8)) * KP2 + (r % (DM / 8)) * 8) = (u32x4){0u, 0u, 0u, 0u}; }
    }
    weight_transposes(lds, 0, (G == 256) ? TR_PER_L : 2 * TR_PER_L, gid * NWAVES + wid, G * NWAVES);
}

__device__ __forceinline__ void u_row(const f32x4 (&v)[8], float rstd, const gf32* gpre, const gf32* mod  , gbf* urow, int lane) {
#pragma unroll
    for (int j = 0; j < 8; ++j) { const int c = 4 * lane + 256 * j;
        const f32x4 g = *(const GAS f32x4*)(gpre + c), sh = *(const GAS f32x4*)(mod + c), sc = *(const GAS f32x4*)(mod + 2048 + c);
        const f32x4 o = v[j] * rstd * g * (sc + 1.0f) + sh;
        *(GAS u32x2*)(urow + c) = pk4(o); }
}
__device__ __forceinline__ void phase_uprep0(const Params& p, int gid, int G) {
    const int tid = tid_op(), lane = tid & 63, gw = gid * NWAVES + (tid >> 6), NGW = G * NWAVES;
    const gf32* mod0 = (const gf32*)(wsb() + WS_MOD);
    gbf* U = (gbf*)(wsb() + WS_U);
    for (int r = gw; r < NROW; r += NGW) {
        const gf32* xr = (r < NLAT) ? pin(I_X) + (size_t)r * DM : pin(I_CTX) + (size_t)(r - NLAT) * DM;
        const int mr = (r < NLAT) ? (r >> 11) : 4;
        f32x4 v[8]; float s = 0.f;
#pragma unroll
        for (int j = 0; j < 8; ++j) { v[j] = *(const GAS f32x4*)(xr + 4 * lane + 256 * j); s += v[j][0] * v[j][0] + v[j][1] * v[j][1] + v[j][2] * v[j][2] + v[j][3] * v[j][3]; }
        const float rstd = rsqrtf(wave_sum(s) * (1.0f / DM) + EPS);
        u_row(v, rstd, pin(I_GPRE), mod0 + (size_t)mr * 6144, U + (size_t)r * KP2, lane);
    }
}
__device__ __forceinline__ void phase_final(const Params& p, int l, int rbeg, int rend, int cu, int ncu) {
    const int tid = tid_op(), lane = tid & 63, gw = rbeg + cu * NWAVES + (tid >> 6), NGW = ncu * NWAVES;
    const gf32* mod = (const gf32*)(wsb() + WS_MOD) + (size_t)l * 5 * 6144;
    const gf32* Y = (const gf32*)(wsb() + WS_Y);
    gf32* XL = (gf32*)(wsb() + WS_XL);
    gbf* U = (gbf*)(wsb() + WS_U);
    const int nrows = rend;
    auto xrow = [&](int r) -> const gf32* { return (l == 0) ? ((r < NLAT) ? pin(I_X) + (size_t)r * DM : pin(I_CTX) + (size_t)(r - NLAT) * DM) : XL + (size_t)r * DM; };
    f32x4 y[8], x[8], yn[8], xn[8];
    if (gw < nrows) { const gf32* yr = Y + (size_t)gw * DM; const gf32* xr = xrow(gw);
#pragma unroll
        for (int j = 0; j < 8; ++j) { y[j] = *(const GAS f32x4*)(yr + 4 * lane + 256 * j); x[j] = *(const GAS f32x4*)(xr + 4 * lane + 256 * j); } }
    for (int r = gw; r < nrows; r += NGW) {
        const int rn = r + NGW;
        if (rn < nrows) { const gf32* yr = Y + (size_t)rn * DM; const gf32* xr = xrow(rn);
#pragma unroll
            for (int j = 0; j < 8; ++j) { yn[j] = *(const GAS f32x4*)(yr + 4 * lane + 256 * j); xn[j] = *(const GAS f32x4*)(xr + 4 * lane + 256 * j); } }
        const int mr = (r < NLAT) ? (r >> 11) : 4;
        gf32* orow = (l == 0) ? XL + (size_t)r * DM : pout() + (size_t)r * DM;
        float s = 0.f;
#pragma unroll
        for (int j = 0; j < 8; ++j) s += y[j][0] * y[j][0] + y[j][1] * y[j][1] + y[j][2] * y[j][2] + y[j][3] * y[j][3];
        const float rstd = rsqrtf(wave_sum(s) * (1.0f / DM) + EPS);
        float s2 = 0.f;
#pragma unroll
        for (int j = 0; j < 8; ++j) { const int c = 4 * lane + 256 * j;
            const f32x4 g = *(const GAS f32x4*)(pin(I_GPOST) + (size_t)l * DM + c), gt = *(const GAS f32x4*)(mod + (size_t)mr * 6144 + 4096 + c);
            const f32x4 o = x[j] + gt * (y[j] * rstd * g);
            *(GAS f32x4*)(orow + c) = o; y[j] = o; s2 += o[0] * o[0] + o[1] * o[1] + o[2] * o[2] + o[3] * o[3]; }
        if (l == 0) {
            const float rstd2 = rsqrtf(wave_sum(s2) * (1.0f / DM) + EPS);
            u_row(y, rstd2, pin(I_GPRE) + DM, mod + 5 * 6144 + (size_t)mr * 6144, U + (size_t)r * KP2, lane);
        }
#pragma unroll
        for (int j = 0; j < 8; ++j) { y[j] = yn[j]; x[j] = xn[j]; }
    }
}
__device__ __forceinline__ void c1_loadz(const gbf* pr, bool ok, int lane, f32x4 (&z)[4]) {
#pragma unroll
    for (int j = 0; j < 4; ++j) { const int c = 4 * lane + 256 * j;
        if (ok) z[j] = unpk4(*(const GAS u32x2*)(pr + C_CC + c)) * unpk4(*(const GAS u32x2*)(pr + C_CX + c)); else z[j] = (f32x4){0.f, 0.f, 0.f, 0.f}; }
}
__device__ __forceinline__ void phase_c1(const Params& p, int l, int nrows, int gid, int G) {
    const int tid = tid_op(), lane = tid & 63, gw = gid * NWAVES + (tid >> 6), NGW = G * NWAVES;
    const gbf* P = (const gbf*)(wsb() + WS_P);
    gbf* KM = (gbf*)(wsb() + WS_KM); gbf* AB = (gbf*)(wsb() + WS_AB);
    gf32* RKV = (gf32*)(wsb() + WS_RKV); gf32* RQ = (gf32*)(wsb() + WS_RQ);
    const gf32* rope = (const gf32*)(wsb() + WS_ROPE);
    const gf32* cw = pin(I_CONVW) + (size_t)l * 3 * 1024;
    const int chunk = (nrows + NGW - 1) / NGW, rbeg = gw * chunk, rend = min(rbeg + chunk, nrows);
    if (rbeg >= rend) return;
    f32x4 w0[4], w1[4], w2[4];
#pragma unroll
    for (int j = 0; j < 4; ++j) { const int c = 4 * lane + 256 * j; w0[j] = *(const GAS f32x4*)(cw + c); w1[j] = *(const GAS f32x4*)(cw + 1024 + c); w2[j] = *(const GAS f32x4*)(cw + 2048 + c); }
    auto seqpos = [](int r, int& t, int& slen) { if (r < NLAT) { t = r & (SEQ - 1); slen = SEQ; } else { t = (r - NLAT) & (CTXL - 1); slen = CTXL; } };
    f32x4 zp[4], zc[4], zn[4];
    { int t, slen; seqpos(rbeg, t, slen); const bool full0 = (rbeg < NLAT) || (l == 0);
      c1_loadz(P + (size_t)(rbeg - 1) * PP, full0 && t > 0, lane, zp); c1_loadz(P + (size_t)rbeg * PP, full0, lane, zc); (void)slen; }
    for (int r = rbeg; r < rend; ++r) {
        const gbf* pr = P + (size_t)r * PP;
        const bool full = (r < NLAT) || (l == 0);
        int t, slen; seqpos(r, t, slen);
        c1_loadz(pr + PP, (r + 1 < NROW) && ((r + 1 < NLAT) || (l == 0)), lane, zn);
        const float mp = (t > 0) ? 1.f : 0.f, mn = (t < slen - 1) ? 1.f : 0.f;
        const u32x2 ckv = *(const GAS u32x2*)(pr + C_CKV + 4 * lane);
        u32x2 q0 = {0u, 0u}, q1 = {0u, 0u}, cb[4], gc[4];
        if (full) { q0 = *(const GAS u32x2*)(pr + C_QL + 4 * lane); q1 = *(const GAS u32x2*)(pr + C_QL + 256 + 4 * lane);
#pragma unroll
            for (int j = 0; j < 4; ++j) { const int c = 4 * lane + 256 * j; cb[j] = *(const GAS u32x2*)(pr + C_CB + c); gc[j] = *(const GAS u32x2*)(pr + C_GCV + c); } }
        float x = bf2f(pr[C_KR + lane]);
        float rc = 1.f, rsn = 0.f;
        if (r < NLAT) { const int tt = r & (SEQ - 1), pos = (lane < 32) ? (tt >> 6) : (tt & 63), f = lane & 15; rc = rope[(pos * 16 + f) * 2]; rsn = rope[(pos * 16 + f) * 2 + 1]; }
        { const f32x4 v = unpk4(ckv); const float s = wave_sum(v[0] * v[0] + v[1] * v[1] + v[2] * v[2] + v[3] * v[3]);
          if (lane == 0) RKV[r] = rsqrtf(s * (1.0f / 256.0f) + EPS); }
        if (full) { const f32x4 v0 = unpk4(q0), v1 = unpk4(q1);
          const float s = wave_sum(v0[0] * v0[0] + v0[1] * v0[1] + v0[2] * v0[2] + v0[3] * v0[3] + v1[0] * v1[0] + v1[1] * v1[1] + v1[2] * v1[2] + v1[3] * v1[3]);
          if (lane == 0) RQ[r] = rsqrtf(s * (1.0f / 512.0f) + EPS); }
        {
          const float y = __shfl_xor(x, 16);
          x = (lane & 16) ? (y * rsn + x * rc) : (x * rc - y * rsn);
          const bf16_t o = (bf16_t)f2bf(x);
#pragma unroll
          for (int h = 0; h < 8; ++h) KM[hm_row(r, h, 8) * 192 + 128 + lane] = o; }
        if (full) {
#pragma unroll
          for (int j = 0; j < 4; ++j) { const int c = 4 * lane + 256 * j;
              const f32x4 o = (zp[j] * (w0[j] * mp) + zc[j] * w1[j] + zn[j] * (w2[j] * mn)) * unpk4(cb[j]) * unpk4(gc[j]);
              *(GAS u32x2*)(AB + (size_t)r * ABW + c) = pk4(o); } }
#pragma unroll
        for (int j = 0; j < 4; ++j) { zp[j] = zc[j]; zc[j] = zn[j]; }
    }
}

namespace fa {
typedef float f32x16 __attribute__((ext_vector_type(16)));
typedef short s16x4 __attribute__((ext_vector_type(4)));
constexpr float THRL = 8.0f;
__device__ __forceinline__ int crow(int r, int hi) { return (r & 3) + 8 * (r >> 2) + 4 * hi; }
__device__ __forceinline__ unsigned cvtpk(float lo, float hi) { unsigned r; asm volatile("v_cvt_pk_bf16_f32 %0, %1, %2" : "=v"(r) : "v"(lo), "v"(hi)); return r; }
template <int OFF> __device__ __forceinline__ s16x4 tr_read(int vb) { s16x4 r; asm volatile("ds_read_b64_tr_b16 %0, %1 offset:%2" : "=&v"(r) : "v"(vb), "i"(OFF) : "memory"); return r; }
__device__ __forceinline__ int v_rd_base(int lane) { return ((lane & 3) << 3) | (((lane >> 2) & 3) << 6) | (((lane >> 4) & 1) << 5) | (((lane >> 5) & 1) << 8); }
template <int NCB, int D0> __device__ __forceinline__ void pv_one(f32x16& od, int vb, bf16x8 pa0, bf16x8 pa1, bf16x8 pa2, bf16x8 pa3) {
    constexpr int KS = 2 * NCB * 512, HF = NCB * 512, B = D0 * 512;
    const s16x4 l0 = tr_read<B + 0 * KS>(vb), h0 = tr_read<B + 0 * KS + HF>(vb), l1 = tr_read<B + 1 * KS>(vb), h1 = tr_read<B + 1 * KS + HF>(vb);
    const s16x4 l2 = tr_read<B + 2 * KS>(vb), h2 = tr_read<B + 2 * KS + HF>(vb), l3 = tr_read<B + 3 * KS>(vb), h3 = tr_read<B + 3 * KS + HF>(vb);
    asm volatile("s_waitcnt lgkmcnt(0)" ::: "memory"); __builtin_amdgcn_sched_barrier(0);
#define FA_PK(L, H) (bf16x8){L[0], L[1], L[2], L[3], H[0], H[1], H[2], H[3]}
    od = __builtin_amdgcn_mfma_f32_32x32x16_bf16(pa0, FA_PK(l0, h0), od, 0, 0, 0);
    od = __builtin_amdgcn_mfma_f32_32x32x16_bf16(pa1, FA_PK(l1, h1), od, 0, 0, 0);
    od = __builtin_amdgcn_mfma_f32_32x32x16_bf16(pa2, FA_PK(l2, h2), od, 0, 0, 0);
    od = __builtin_amdgcn_mfma_f32_32x32x16_bf16(pa3, FA_PK(l3, h3), od, 0, 0, 0);
#undef FA_PK
}
struct Desc {
    const gbf* Q; int ldq;
    const gbf* K; int ldk;
    const gbf* V; int ldv;
    int row0a, nta, row0b, NT;
    const gbf* G; int ldg;
    gbf* O; int ldo;
    int r0, wr0; const gf32* rpb;
    int hsa, hsb;
};
template <int N> __device__ __forceinline__ void wait_bar() {
    if constexpr (N == 0) asm volatile("s_waitcnt vmcnt(0) lgkmcnt(0)\n\ts_barrier" ::: "memory");
    else if constexpr (N == 2) asm volatile("s_waitcnt vmcnt(2) lgkmcnt(0)\n\ts_barrier" ::: "memory");
    else if constexpr (N == 5) asm volatile("s_waitcnt vmcnt(5) lgkmcnt(0)\n\ts_barrier" ::: "memory");
    else static_assert(N == 0, "wait_bar count");
}
template <int N> __device__ __forceinline__ void wait_bar2() {
    if constexpr (N == 0) asm volatile("s_waitcnt vmcnt(0) lgkmcnt(0)\n\ts_barrier" ::: "memory");
    else if constexpr (N == 1) asm volatile("s_waitcnt vmcnt(1) lgkmcnt(0)\n\ts_barrier" ::: "memory");
    else if constexpr (N == 2) asm volatile("s_waitcnt vmcnt(2) lgkmcnt(0)\n\ts_barrier" ::: "memory");
    else if constexpr (N == 5) asm volatile("s_waitcnt vmcnt(5) lgkmcnt(0)\n\ts_barrier" ::: "memory");
    else static_assert(N == 0, "wait_bar2 count");
}
template <int MODE, unsigned L0 = 0xFFFFu, unsigned L1 = 0xFFFFu> __device__ __forceinline__ void partial_sm(f32x16& p0, f32x16& p1, float& m_reg, float& alpha) {
    if constexpr (MODE == 1) {
#pragma unroll
        for (int r = 0; r < 16; ++r) { p0[r] *= NASCALE; p1[r] *= NASCALE; }
    }
    float pmax = -3.0e38f;
#pragma unroll
    for (int r = 0; r < 16; ++r) if ((L0 >> r) & 1u) pmax = fmaxf(pmax, p0[r]);
#pragma unroll
    for (int r = 0; r < 16; ++r) if ((L1 >> r) & 1u) pmax = fmaxf(pmax, p1[r]);
    { auto rr = __builtin_amdgcn_permlane32_swap(__float_as_uint(pmax), __float_as_uint(pmax), false, false); pmax = fmaxf(__uint_as_float(rr[0]), __uint_as_float(rr[1])); }
    if (__builtin_expect(__all(pmax - m_reg <= THRL), 1)) alpha = 1.f;
    else { const float mn = fmaxf(m_reg, pmax); alpha = __builtin_amdgcn_exp2f(m_reg - mn); m_reg = mn; }
#pragma unroll
    for (int r = 0; r < 16; ++r) { if ((L0 >> r) & 1u) p0[r] = __builtin_amdgcn_exp2f(p0[r] - m_reg); else p0[r] = 0.f; if ((L1 >> r) & 1u) p1[r] -= m_reg; }
}
template <unsigned L0 = 0xFFFFu, unsigned L1 = 0xFFFFu>
__device__ __forceinline__ void finish_sm(f32x16& p0, f32x16& p1, float alpha, float& l_reg, bf16x8& pa0, bf16x8& pa1, bf16x8& pa2, bf16x8& pa3) {
#pragma unroll
    for (int r = 0; r < 16; ++r) { if ((L1 >> r) & 1u) p1[r] = __builtin_amdgcn_exp2f(p1[r]); else p1[r] = 0.f; }
    float ps = 0.f;
#pragma unroll
    for (int r = 0; r < 16; ++r) if ((L0 >> r) & 1u) ps += p0[r];
#pragma unroll
    for (int r = 0; r < 16; ++r) if ((L1 >> r) & 1u) ps += p1[r];
    { auto rr = __builtin_amdgcn_permlane32_swap(__float_as_uint(ps), __float_as_uint(ps), false, false); ps = __uint_as_float(rr[0]) + __uint_as_float(rr[1]); }
    l_reg = l_reg * alpha + ps;
#define FA_PK4(P, BASE, OUT) do { unsigned a0 = cvtpk(P[BASE + 0], P[BASE + 1]), a1 = cvtpk(P[BASE + 2], P[BASE + 3]); \
    unsigned b0_ = cvtpk(P[BASE + 4], P[BASE + 5]), b1_ = cvtpk(P[BASE + 6], P[BASE + 7]); \
    auto r0_ = __builtin_amdgcn_permlane32_swap(a0, b0_, false, false); auto r1_ = __builtin_amdgcn_permlane32_swap(a1, b1_, false, false); \
    u32x4 w_ = {r0_[0], r1_[0], r0_[1], r1_[1]}; OUT = __builtin_bit_cast(bf16x8, w_); } while (0)
    FA_PK4(p0, 0, pa0); FA_PK4(p0, 8, pa1); FA_PK4(p1, 0, pa2); FA_PK4(p1, 8, pa3);
#undef FA_PK4
}
template <unsigned L0, unsigned L1> __device__ __forceinline__ void bias_win(f32x16& p0, f32x16& p1, const LAS float* brow, int cs, int hi) {
#pragma unroll
    for (int r = 0; r < 16; ++r) { const int kc = crow(r, hi);
        if ((L0 >> r) & 1u) p0[r] = ((unsigned)(kc - cs) < 16u) ? p0[r] + brow[kc] : -30000.f;
        if ((L1 >> r) & 1u) p1[r] = ((unsigned)(kc + 32 - cs) < 16u) ? p1[r] + brow[kc + 32] : -30000.f; }
}
template <int N> __device__ __forceinline__ void wait_barn() { asm volatile("s_waitcnt vmcnt(%0) lgkmcnt(0)\n\ts_barrier" :: "n"(N) : "memory"); }
template <int DQK, int DV, int MODE, int S, int NHU = 1>
__device__ __forceinline__ void unit_pipe(LAS unsigned char* lds, const Desc& d) {
    constexpr int RB = DQK * 2, KB1 = 64 * RB, VB1 = 64 * DV * 2, KB = NHU * KB1, VB = NHU * VB1, SLOT = KB + VB, KP = KB / 8192, VP = VB / 8192, NCB = DV / 32, NK = DQK / 16, NPIECE = KP + VP;
    constexpr int DK = S - 1, DVV = S - 2, WSTEADY = DVV * NPIECE;
    static_assert(S >= 2 && WSTEADY < 64 && S * SLOT + 2048 + NHU * 1920 + 16 <= LDS_BYTES && (NHU == 1 || NHU == 4), "ring geometry");
    const int tid = tid_op(), wid = __builtin_amdgcn_readfirstlane(tid >> 6), lane = tid & 63, r32 = lane & 31, hi = lane >> 5;
    const int hl = (NHU > 1) ? (wid >> 1) : 0, wrow0 = (NHU > 1) ? (wid & 1) * 32 : wid * 32;
    LAS float* wsf = (LAS float*)(lds + S * SLOT) + wid * 64;
    LAS float* rpbs = (LAS float*)(lds + S * SLOT + 2048) + hl * 480;
    unsigned koff[KP], voff[VP], koffb[KP], voffb[VP];
#pragma unroll
    for (int i = 0; i < KP; ++i) { const int pp = (wid * KP + i) * 1024 + lane * 16, hh = pp / KB1, p = pp % KB1, row = p / RB, cs = (p % RB) >> 4, c = cs ^ ((row >> 1) & 7);
        koff[i] = (unsigned)((hh * d.hsa + row) * d.ldk + c * 8) * 2u; koffb[i] = (unsigned)(hh * (d.hsb - d.hsa) * d.ldk) * 2u; }
#pragma unroll
    for (int i = 0; i < VP; ++i) { const int pp = (wid * VP + i) * 1024 + lane * 16, hh = pp / VB1, p = pp % VB1, st = p >> 9, q = p & 511, kk = (st / NCB) * 8 + (q >> 6), c = (st % NCB) * 32 + ((q & 63) >> 1);
        const int k = (kk & ~0xC) | ((kk & 4) << 1) | ((kk & 8) >> 1); voff[i] = (unsigned)((hh * d.hsa + k) * d.ldv + c) * 2u; voffb[i] = (unsigned)(hh * (d.hsb - d.hsa) * d.ldv) * 2u; }
    int qr_row = 0, qc = 0, rs = 0, cs = 0;
    if constexpr (MODE == 2) {
        qr_row = d.r0 + ((NHU > 1) ? 0 : (wid >> 1)); qc = (wid & 1) * 32 + r32; rs = min(max(qr_row - 4, 0), 24); cs = min(max(qc - 8, 0), 48);
        for (int i = tid; i < NHU * 15 * 31; i += NTHREADS) ((LAS float*)(lds + S * SLOT + 2048))[(i / 465) * 480 + i % 465] = d.rpb[i] * LOG2E;
    }
#define FP_ACT(t) ((MODE != 2) || (t) >= d.nta || (d.wr0 + (t) >= rs && d.wr0 + (t) <= rs + 7))
#define FP_VAR(t) ((MODE == 2 && (t) < d.nta) ? 1 + (wid & 1) : 0)
#define FP_PSM(P0, P1, al, t, v) do { if ((v) == 0) partial_sm<MODE>(P0, P1, m_reg, al); \
        else { const LAS float* brow_ = rpbs + (d.wr0 + (t) - qr_row + 7) * 31 - qc + 15; \
               if ((v) == 1) { bias_win<0xFFFFu, 0x000Fu>(P0, P1, brow_, cs, hi); partial_sm<MODE, 0xFFFFu, 0x000Fu>(P0, P1, m_reg, al); } \
               else          { bias_win<0xF000u, 0xFFFFu>(P0, P1, brow_, cs, hi); partial_sm<MODE, 0xF000u, 0xFFFFu>(P0, P1, m_reg, al); } } } while (0)
#define FP_FSM(P0, P1, al, v) do { if ((v) == 0) finish_sm(P0, P1, al, l_reg, pa0, pa1, pa2, pa3); else if ((v) == 1) finish_sm<0xFFFFu, 0x000Fu>(P0, P1, al, l_reg, pa0, pa1, pa2, pa3); \
        else finish_sm<0xF000u, 0xFFFFu>(P0, P1, al, l_reg, pa0, pa1, pa2, pa3); } while (0)
#define FP_ROW(t) (((t) < d.nta) ? d.row0a + 64 * (t) : d.row0b + 64 * ((t) - d.nta))
#define FP_DMAK(t) do { const int t_ = (t); const GAS char* kb_ = (const GAS char*)(d.K + (size_t)FP_ROW(t_) * d.ldk); const int s_ = t_ % S; const unsigned sb_ = (t_ < d.nta) ? 0u : 1u; \
        _Pragma("unroll") for (int i_ = 0; i_ < KP; ++i_) __builtin_amdgcn_global_load_lds((const GAS unsigned*)(kb_ + (koff[i_] + sb_ * koffb[i_])), (LAS unsigned*)(lds + s_ * KB + (wid * KP + i_) * 1024), 16, 0, 0); } while (0)
#define FP_DMAV(t) do { const int t_ = (t); const GAS char* vb_ = (const GAS char*)(d.V + (size_t)FP_ROW(t_) * d.ldv); const int s_ = t_ % S; const unsigned sb_ = (t_ < d.nta) ? 0u : 1u; \
        _Pragma("unroll") for (int i_ = 0; i_ < VP; ++i_) __builtin_amdgcn_global_load_lds((const GAS unsigned*)(vb_ + (voff[i_] + sb_ * voffb[i_])), (LAS unsigned*)(lds + S * KB + s_ * VB + (wid * VP + i_) * 1024), 16, 0, 0); } while (0)
#pragma unroll
    for (int s = -DK; s < 0; ++s) { FP_DMAK(s + DK); if (s + DVV >= 0) FP_DMAV(s + DVV); }
    bf16x8 qr[NK];
    { const gbf* Qw = d.Q + (size_t)(hl * d.hsa + wrow0 + r32) * d.ldq + hi * 8;
#pragma unroll
      for (int d0 = 0; d0 < NK; ++d0) qr[d0] = *(const GAS bf16x8*)(Qw + d0 * 16); }
    float m_reg = -1e30f, l_reg = 0.f;
    f32x16 o[NCB];
#pragma unroll
    for (int i = 0; i < NCB; ++i) o[i] = f32x16{};
    const int vbase = (int)(unsigned)(size_t)(lds + S * KB + hl * VB1) + v_rd_base(lane);
    const int ksw = ((r32 >> 1) & 7);
    const int NT = d.NT;
#define FP_QKT(P0, P1, t) do { const LAS unsigned char* Ks_ = lds + ((t) % S) * KB + hl * KB1; P0 = f32x16{}; P1 = f32x16{}; \
        _Pragma("unroll") for (int d0 = 0; d0 < NK; ++d0) { const int cb_ = ((2 * d0 + hi) ^ ksw) << 4; \
            const bf16x8 b0_ = *(const LAS bf16x8*)(Ks_ + r32 * RB + cb_), b1_ = *(const LAS bf16x8*)(Ks_ + (32 + r32) * RB + cb_); \
            P0 = __builtin_amdgcn_mfma_f32_32x32x16_bf16(b0_, qr[d0], P0, 0, 0, 0); P1 = __builtin_amdgcn_mfma_f32_32x32x16_bf16(b1_, qr[d0], P1, 0, 0, 0); } } while (0)
#define FP_PV(t) do { const int vb_ = vbase + ((t) % S) * VB; pv_one<NCB, 0>(o[0], vb_, pa0, pa1, pa2, pa3); pv_one<NCB, 1>(o[1], vb_, pa0, pa1, pa2, pa3); \
        if constexpr (NCB == 4) { pv_one<NCB, 2>(o[2], vb_, pa0, pa1, pa2, pa3); pv_one<NCB, 3>(o[3], vb_, pa0, pa1, pa2, pa3); } } while (0)
#define FP_RESC(a) do { if (__any((a) < 1.f)) { if (hi == 0) wsf[r32] = (a); asm volatile("s_waitcnt lgkmcnt(0)" ::: "memory"); \
        _Pragma("unroll") for (int dd = 0; dd < NCB; ++dd) _Pragma("unroll") for (int r = 0; r < 16; ++r) o[dd][r] *= wsf[crow(r, hi)]; } } while (0)
#define FP_ENDWAIT(j) do { if ((j) + DK < NT) wait_barn<WSTEADY>(); else wait_barn<0>(); } while (0)
#define FP_STEP(C0, C1, alC, Pv0, Pv1, alP, j) do { \
        if ((j) + DK < NT) FP_DMAK((j) + DK); \
        if ((j) + DVV < NT) FP_DMAV((j) + DVV); \
        __builtin_amdgcn_sched_barrier(0); \
        const bool actC_ = FP_ACT(j); \
        if (actC_) { FP_QKT(C0, C1, j); } \
        FP_FSM(Pv0, Pv1, alP, varP); __builtin_amdgcn_sched_barrier(0); \
        if (actP) { FP_PV((j) - 1); } \
        const int varC_ = FP_VAR(j); \
        if (actC_) { FP_PSM(C0, C1, alC, j, varC_); FP_RESC(alC); } \
        else { _Pragma("unroll") for (int r = 0; r < 16; ++r) { C0[r] = 0.f; C1[r] = -30000.f; } alC = 1.f; }     \
        actP = actC_; varP = varC_; \
        FP_ENDWAIT(j); } while (0)
    f32x16 pA0, pA1, pB0, pB1; float alA = 1.f, alB = 1.f; bf16x8 pa0, pa1, pa2, pa3;
    wait_barn<WSTEADY>();
    if (DK < NT) FP_DMAK(DK);
    if (DVV < NT) FP_DMAV(DVV);
    bool actP = FP_ACT(0);
    int varP = FP_VAR(0);
    if (actP) { FP_QKT(pA0, pA1, 0); FP_PSM(pA0, pA1, alA, 0, varP); }
    else {
#pragma unroll
        for (int r = 0; r < 16; ++r) { pA0[r] = 0.f; pA1[r] = -30000.f; } }
    FP_ENDWAIT(0);
    for (int j = 1; j + 1 < NT; j += 2) {
        FP_STEP(pB0, pB1, alB, pA0, pA1, alA, j);
        FP_STEP(pA0, pA1, alA, pB0, pB1, alB, j + 1);
    }
    FP_STEP(pB0, pB1, alB, pA0, pA1, alA, NT - 1);
    FP_FSM(pB0, pB1, alB, varP); __builtin_amdgcn_sched_barrier(0);
    if (actP) { FP_PV(NT - 1); }
    if (hi == 0) wsf[32 + r32] = l_reg;
    wait_barn<0>();
    {
        constexpr int RS = DV + 8, CPR = DV / 8, NCHL = 32 * CPR / 64;
        LAS bf16_t* st = (LAS bf16_t*)(lds + wid * (32 * RS * 2));
        const gbf* Gw = d.G + (size_t)wrow0 * d.ldg + hl * DV; gbf* Ow = d.O + (size_t)wrow0 * d.ldo + hl * DV;
        u32x4 gv[NCHL];
#pragma unroll
        for (int i = 0; i < NCHL; ++i) { const int idx = i * 64 + lane, row = idx / CPR, cc = idx % CPR; gv[i] = *(const GAS u32x4*)(Gw + (size_t)row * d.ldg + cc * 8); }
#pragma unroll
        for (int r = 0; r < 16; ++r) { const float rl = __builtin_amdgcn_rcpf(wsf[32 + crow(r, hi)]);
#pragma unroll
            for (int dd = 0; dd < NCB; ++dd) st[crow(r, hi) * RS + dd * 32 + r32] = (bf16_t)f2bf(o[dd][r] * rl); }
        asm volatile("s_waitcnt lgkmcnt(0)" ::: "memory");
#pragma unroll
        for (int i = 0; i < NCHL; ++i) { const int idx = i * 64 + lane, row = idx / CPR, cc = idx % CPR;
            f32x4 va, vb, ga, gb; unpk8(*(const LAS u32x4*)(st + row * RS + cc * 8), va, vb); unpk8(gv[i], ga, gb);
            *(GAS u32x4*)(Ow + (size_t)row * d.ldo + cc * 8) = pk8(va * ga, vb * gb); }
    }
    asm volatile("s_waitcnt lgkmcnt(0)\n\ts_barrier" ::: "memory");
#undef FP_ROW
#undef FP_ACT
#undef FP_VAR
#undef FP_PSM
#undef FP_FSM
#undef FP_DMAK
#undef FP_DMAV
#undef FP_QKT
#undef FP_PV
#undef FP_RESC
#undef FP_ENDWAIT
#undef FP_STEP
}
}

__device__ __forceinline__ void phase_attn_fast(const Params& p, int l, unsigned char* lds_, int gid, int G) {
    LAS unsigned char* lds = (LAS unsigned char*)lds_;
    gu8* ws = wsb();
    const gbf* P = (const gbf*)(ws + WS_P); const gbf* KM = (const gbf*)(ws + WS_KM); const gbf* VM = (const gbf*)(ws + WS_VM); const gbf* QM = (const gbf*)(ws + WS_QM);
    const gbf* NK = (const gbf*)(ws + WS_NK); const gbf* NV = (const gbf*)(ws + WS_NV); const gbf* NQ = (const gbf*)(ws + WS_NQ);
    gbf* AB = (gbf*)(ws + WS_AB);
    const gf32* rpb = pin(I_RPB) + (size_t)l * 16 * 15 * 31;
    const int vcu = (G % 8 == 0) ? (gid % 8) * (G / 8) + gid / 8 : gid;
    const bool split = (l == 0 && G == 256); const int a = gid - 32;
    __syncthreads();
    if (split && gid < 32) { weight_transposes(lds_, TR_PER_L, 2 * TR_PER_L, gid * NWAVES + (tid_op() >> 6), 32 * NWAVES); __syncthreads(); return; }
    {
        const int tid = tid_op(), lane = tid & 63, off = split ? 32 : 0;
        const gbf* GT = (const gbf*)(ws + WS_GT);
        for (int t = (gid - off) * NWAVES + (tid >> 6); t < NB * 1024; t += (G - off) * NWAVES) {
            const int b = t >> 10, ch = t & 1023; const gbf* gr = GT + ((size_t)b * 1024 + ch) * KP4;
            float acc = 0.f;
#pragma unroll
            for (int jj = 0; jj < 4; ++jj) { f32x4 va, vb; unpk8(*(const GAS u32x4*)(gr + lane * 8 + 512 * jj), va, vb); acc += (va[0] - va[1]) + (va[2] - va[3]) + (vb[0] - vb[1]) + (vb[2] - vb[3]); }
            acc = wave_sum(acc) * 0.02209708691207961f;
            if (lane == 0) { const size_t r = (size_t)b * SEQ + SEQ / 2; const float g = bf2f(P[r * PP + C_GFN + ch]); AB[r * ABW + 3072 + ch] = (bf16_t)f2bf(acc * g); }
        }
    }
    const int m_first = split ? (a % 8) * 28 + a / 8 : vcu, m_step = split ? (a < 32 ? 224 + a - m_first : 256) : G;
    for (int rep = 0; rep < (PROBE_DUP == 50 ? 2 : 1); ++rep)
    for (int u = m_first; u < NB * 8 * 8; u += m_step) { const int b = u >> 6, h = (u >> 3) & 7, qb = u & 7; const size_t q0 = (size_t)b * SEQ + qb * 256;
        const int lat0 = (b * 8 + h) * SEQ, ctx0 = NB * 8 * SEQ + (b * 8 + h) * CTXL;
        fa::Desc d{QM + (size_t)(lat0 + qb * 256) * 192, 192, KM, 192, VM, 128, ctx0, 4, lat0, 36, P + q0 * PP + C_GML + h * 128, PP, AB + q0 * ABW + 1024 + h * 128, ABW, 0, 0, nullptr, 0, 0};
        fa::unit_pipe<192, 128, 0, 3>(lds, d); }
    int na_b, na_e, na_st;
    if (G != 256) { na_b = gid; na_e = NB * 16 * 8; na_st = G; }
    else if (split) { na_b = (a >= 96) ? (a - 96) * 4 : 0; na_e = (a >= 96) ? na_b + 4 : 0; na_st = 1; }
    else { na_b = gid < 64 ? 0 : gid < 192 ? (gid - 64) * 3 : 384 + (gid - 192) * 2; na_e = gid < 64 ? 0 : gid < 192 ? na_b + 3 : na_b + 2; na_st = 1; }
    for (int rep = 0; rep < (PROBE_DUP == 51 ? 2 : 1); ++rep)
    for (int u = na_b; u < na_e; u += na_st) {
        const int b = u >> 7, h0 = ((u >> 5) & 3) * 4, r = u & 31, rs = min(max(r - 4, 0), 24); const size_t q0 = (size_t)b * SEQ + r * 64;
        const int lat0 = (b * 16 + h0) * SEQ, ctx0 = NB * 16 * SEQ + (b * 16 + h0) * CTXL;
        fa::Desc d{NQ + (size_t)(lat0 + r * 64) * 64, 64, NK, 64, NV, 64, lat0 + rs * 64, 8, ctx0, 12, P + q0 * PP + C_GNA + h0 * 64, PP, AB + q0 * ABW + 2048 + h0 * 64, ABW,
                   r, rs, rpb + h0 * 15 * 31, SEQ, CTXL};
        fa::unit_pipe<64, 64, 2, 2, 4>(lds, d); }
    if (l == 0) {
        const int x0 = split ? 64 : G / 2, x1 = split ? 64 : G / 2 + 32;
        for (int u = gid - x0; u >= 0 && u < NB * 8; u += G) { const int b = u >> 3, h = u & 7; const size_t q0 = (size_t)NLAT + b * CTXL; const int ctx0 = NB * 8 * SEQ + (b * 8 + h) * CTXL;
            fa::Desc d{QM + (size_t)ctx0 * 192, 192, KM, 192, VM, 128, ctx0, 4, 0, 4, P + q0 * PP + C_GML + h * 128, PP, AB + q0 * ABW + 1024 + h * 128, ABW, 0, 0, nullptr, 0, 0};
            fa::unit_pipe<192, 128, 0, 3>(lds, d); }
        for (int u = gid - x1; u >= 0 && u < NB * 16; u += G) { const int b = u >> 4, h = u & 15; const size_t q0 = (size_t)NLAT + b * CTXL; const int ctx0 = NB * 16 * SEQ + (b * 16 + h) * CTXL;
            fa::Desc d{NQ + (size_t)ctx0 * 64, 64, NK, 64, NV, 64, ctx0, 4, 0, 4, P + q0 * PP + C_GNA + h * 64, PP, AB + q0 * ABW + 2048 + h * 64, ABW, 0, 0, nullptr, 0, 0};
            fa::unit_pipe<64, 64, 0, 4>(lds, d); }
    }
    __syncthreads();
}


#define XB_TMO      128
#define XB_XCNT(j)  (256  + 64 * (j))
#define XB_XSUB(j)  (1280 + 64 * (j))
#define XB_XGEN(j)  (2304 + 64 * (j))
#define XB_TOP      3328
#define XB_TOPGEN   3392
#define XCD_BAR_WORDS 3456
#define XB_SPIN_CAP (1u << 18)
__device__ __forceinline__ unsigned xb_ld(unsigned* p)              { return __hip_atomic_load(p, __ATOMIC_RELAXED, __HIP_MEMORY_SCOPE_AGENT); }
__device__ __forceinline__ unsigned xb_add(unsigned* p, unsigned v) { return __hip_atomic_fetch_add(p, v, __ATOMIC_RELAXED, __HIP_MEMORY_SCOPE_AGENT); }
__device__ __forceinline__ unsigned xb_xcc_id() { return (unsigned)__builtin_amdgcn_s_getreg((3 << 11) | 20) & 0xFu; }
#define XB_SPIN(cond, bar) do { unsigned _sp = 0; while (cond) { __builtin_amdgcn_s_sleep(1); \
    if ((++_sp & 255u) == 0u) { if (xb_ld(&(bar)[XB_TMO])) break; if (_sp > XB_SPIN_CAP) { atomicAdd(&(bar)[XB_TMO], 1u); break; } } } } while (0)
struct XcdBarrier { unsigned* bar; unsigned x; volatile LAS unsigned* st; };
__device__ __forceinline__ XcdBarrier xcd_barrier_post(unsigned* bar, volatile LAS unsigned* st) {
    XcdBarrier b; b.bar = bar; b.x = xb_xcc_id(); b.st = st;
    if (threadIdx.x == 0) (void)xb_add(&bar[XB_XCNT(b.x)], 1u);
    return b;
}
__device__ __forceinline__ void xcd_barrier_complete(unsigned* bar, unsigned x, unsigned& nloc, unsigned& nx) {
    const unsigned G = gridDim.x * gridDim.y * gridDim.z;
    unsigned sum, cnt, mine, sp = 0u;
    for (;;) {
        sum = 0u; cnt = 0u; mine = 0u;
#pragma unroll
        for (unsigned j = 0; j < 16; ++j) { const unsigned c = xb_ld(&bar[XB_XCNT(j)]); sum += c; cnt += (c > 0u) ? 1u : 0u; mine = (j == x) ? c : mine; }
        if (sum == G) break;
        __builtin_amdgcn_s_sleep(1);
        if ((++sp & 255u) == 0u) { if (xb_ld(&bar[XB_TMO])) break; if (sp > XB_SPIN_CAP) { atomicAdd(&bar[XB_TMO], 1u); break; } }
    }
    nloc = mine > 0u ? mine : 1u; nx = cnt > 0u ? cnt : 1u;
}
__device__ __forceinline__ void xcd_barrier(const XcdBarrier& b) {
    asm volatile("s_waitcnt vmcnt(0)" ::: "memory");
    __syncthreads();
    if (threadIdx.x == 0) {
        unsigned* bar = b.bar;
        __builtin_amdgcn_s_waitcnt(0);
        unsigned nloc = b.st[0], nx = b.st[1];
        if (nloc == 0u) { xcd_barrier_complete(bar, b.x, nloc, nx); b.st[0] = nloc; b.st[1] = nx; }
        const unsigned old = xb_add(&bar[XB_XSUB(b.x)], 1u);
        const unsigned gen = old / nloc;
        if (old + 1u == (gen + 1u) * nloc) {
            __builtin_amdgcn_fence(__ATOMIC_RELEASE, "agent");
            asm volatile("s_waitcnt vmcnt(0)" ::: "memory");
            const unsigned og = xb_add(&bar[XB_TOP], 1u);
            const unsigned tg = og / nx;
            if (og + 1u == (tg + 1u) * nx) xb_add(&bar[XB_TOPGEN], 1u);
            else XB_SPIN(xb_ld(&bar[XB_TOPGEN]) == tg, bar);
            __builtin_amdgcn_fence(__ATOMIC_ACQUIRE, "agent");
            xb_add(&bar[XB_XGEN(b.x)], 1u);
            asm volatile("s_waitcnt vmcnt(0)" ::: "memory");
        } else {
            XB_SPIN(xb_ld(&bar[XB_XGEN(b.x)]) == gen, bar);
            __builtin_amdgcn_fence(__ATOMIC_ACQUIRE, "agent");
            asm volatile("s_waitcnt vmcnt(0)" ::: "memory");
        }
    }
    __syncthreads();
}

#define WSB(off) (wsb() + (off))
__global__ void __launch_bounds__(NTHREADS, 2) fwd_megakernel(Params p) {
    extern __shared__ __attribute__((aligned(16))) unsigned char lds[];
    cg::grid_group grid = cg::this_grid();
    const int gid_ = blockIdx.x, G_ = gridDim.x;
    auto sop = [](int v) { asm volatile("" : "+s"(v)); return v; };
#define gid sop(gid_)
#define G sop(G_)

    { volatile LAS unsigned* st0 = (volatile LAS unsigned*)((LAS unsigned char*)lds + LDS_BYTES - 16); if (threadIdx.x < 4) st0[threadIdx.x] = 0u; __syncthreads(); }
    (void)xcd_barrier_post((unsigned*)(wsb() + WS_BAR), (volatile LAS unsigned*)((LAS unsigned char*)lds + LDS_BYTES - 16));
    if (wsb() == nullptr) grid.sync();
#define GSYNC() xcd_barrier(XcdBarrier{(unsigned*)(wsb() + WS_BAR), xb_xcc_id(), (volatile LAS unsigned*)((LAS unsigned char*)lds + LDS_BYTES - 16)})
    for (int rep = 0; rep < (PROBE_DUP == 0 ? 2 : 1); ++rep) { phase0(p, lds, gid, G); GSYNC(); }

    for (int rep = 0; rep < (PROBE_DUP == 1 ? 2 : 1); ++rep) { phase_uprep0(p, gid, G); GSYNC(); }
    for (int l = 0; l < DEPTH; ++l) {
        const int nq = (l == 0) ? NROW : NLAT;
        for (int rep = 0; rep < ((PROBE_DUP == 2 || PROBE_DUP == 3) ? 2 : 1); ++rep) {
            const gbf* WinT = (const gbf*)WSB(WS_WIN) + (size_t)l * NP * KP2; gbf* U = (gbf*)WSB(WS_U); gbf* P = (gbf*)WSB(WS_P);
            const EpiInProj E{P, 0, (gbf*)WSB(WS_NK), (gbf*)WSB(WS_NV), (gbf*)WSB(WS_NQ), (gbf*)WSB(WS_MG)};
            if (l == 0 && G == 256) {
                __syncthreads();
                { fg::SchedIn0 S{U, WinT, G, gid, 0, 11}; fg::gemm((LAS unsigned char*)lds, KP2, KP2, DM, S, E); }
                __syncthreads();
                GSYNC();
                if (gid < 64) { fg::SchedIn0 S{U, WinT, G, gid, 11, 12}; fg::gemm((LAS unsigned char*)lds, KP2, KP2, DM, S, E); __syncthreads(); }
                else phase_c1(p, l, NROW, gid - 64, G - 64);
                GSYNC();
            } else {
                gemm_run(lds, GemmJob{U, KP2, WinT, KP2, nq, NP, DM}, E, gid, G);
                GSYNC();
                if (l == 0) phase_c1(p, l, NROW, gid, G);
                else if (gid < 40) gemm_run(lds, GemmJob{(const gbf*)WSB(WS_U) + (size_t)NLAT * KP2, KP2, (const gbf*)WSB(WS_WIN) + (size_t)l * NP * KP2, KP2, NCTX, KVC_P, DM},
                                            EpiInProjC1{(gbf*)WSB(WS_P), (gbf*)WSB(WS_NK), (gbf*)WSB(WS_KM), (gf32*)WSB(WS_SSQ)}, gid, 40);
                else phase_c1(p, l, NLAT, gid - 40, G - 40);
                GSYNC();
            }
        }
        for (int rep = 0; rep < (PROBE_DUP == 4 ? 2 : 1); ++rep) {
            __syncthreads();
            { SchedC2 S{(const gbf*)WSB(WS_P), (const gbf*)WSB(WS_WUKV) + (size_t)l * 2048 * 256, (const gbf*)WSB(WS_WUQ) + (size_t)l * 1536 * 512, (const gbf*)WSB(WS_DC), nq / 256, l == 0 ? 32 : 0, G, gid};
              EpiC2 E{(gbf*)WSB(WS_KM), (gbf*)WSB(WS_VM), (gbf*)WSB(WS_QM), (gbf*)WSB(WS_GT), (gbf*)WSB(WS_GTC), (const gf32*)WSB(WS_RKV), (const gf32*)WSB(WS_RQ), (const gf32*)WSB(WS_ROPE), l == 1 ? (const gf32*)WSB(WS_SSQ) : (const gf32*)nullptr};
              fg::gemm_multi((LAS unsigned char*)lds, S, E); }
            __syncthreads();
            GSYNC();
        }
        for (int rep = 0; rep < (PROBE_DUP == 5 ? 2 : 1); ++rep) {
        phase_attn_fast(p, l, lds, gid, G);
        for (int rep2 = 0; rep2 < (PROBE_DUP == 52 ? 2 : 1); ++rep2)
        gemm_fast_z(lds, MapF2{(const gbf*)WSB(WS_DN), (const gbf*)WSB(WS_GT), KP4}, KP4, KP4, 2 * SEQ, SEQ / 512, 4, NB, EpiF2M{(gbf*)WSB(WS_AB), (const gbf*)WSB(WS_P), 0, SEQ},
                    (G != 256) ? (gid < 64 ? gid : -1) : (l == 0) ? ((gid >= 64 && gid < 128) ? gid - 64 : -1) : (gid < 64 ? gid : -1), 64);
        if (l == 0) gemm_fast_z(lds, MapF2{(const gbf*)WSB(WS_DNC), (const gbf*)WSB(WS_GTC), 2 * CTXL}, 2 * CTXL, 2 * CTXL, 2 * CTXL, 1, 4, NB, EpiF2{(gbf*)WSB(WS_AB), (const gbf*)WSB(WS_P), NLAT, CTXL}, gid - (G == 256 ? 96 : G / 2 + 96), G);
        GSYNC();
        }
        const gbf* WpT = (const gbf*)WSB(WS_WP) + (size_t)l * 4 * 2048 * KP1; const gbf* WoT = (const gbf*)WSB(WS_WO) + (size_t)l * 2048 * KP2;
        const int NC = G / 8;
        for (int rep = 0; rep < (PROBE_DUP == 6 ? 2 : 1); ++rep) {
          __syncthreads();
          { fg::SchedBranch S{(const gbf*)WSB(WS_AB), WpT, NLAT / 256, DM / 256, G, gid, 0};
            fg::gemm((LAS unsigned char*)lds, ABW, KP1, 1024, S, EpiChain{(gbf*)WSB(WS_MB), (const gbf*)WSB(WS_MG), 0}); }
          __syncthreads();
          GSYNC();
        }
        for (int rep = 0; rep < (PROBE_DUP == 7 ? 2 : 1); ++rep) {
          if (l == 0) {
            __syncthreads();
            const int NH = (G >= 128) ? 2 * NC : 0;
            if (NH == 0 && gid < NC) { fg::SchedBranch S{(const gbf*)WSB(WS_AB), WpT, NCTX / 256, DM / 256, NC, gid, NLAT / 256};
                            fg::gemm((LAS unsigned char*)lds, ABW, KP1, 1024, S, EpiChain{(gbf*)WSB(WS_MB), (const gbf*)WSB(WS_MG), NLAT}); }
            else if (gid < NH) { fg::SchedBranchH S{(const gbf*)WSB(WS_AB), WpT, NCTX / 256, DM / 256, gid, NLAT / 256};
                            fg::gemm((LAS unsigned char*)lds, ABW, KP1, 1024, S, EpiChainH{(gbf*)WSB(WS_MB), (const gbf*)WSB(WS_MG), NLAT, (gf32*)WSB(WS_MF), (unsigned*)WSB(WS_BAR) + HC_FLAG0}); }
            else { const int nf = NH ? NH : NC; fg::Sched<fg::MapPlain> S{fg::MapPlain{(const gbf*)WSB(WS_MB), KP2, WoT, KP2}, NLAT / 256, DM / 256, 1, G - nf, gid - nf};
                   fg::gemm((LAS unsigned char*)lds, KP2, KP2, DM, S, EpiOut{(gf32*)WSB(WS_Y), 0}); }
            __syncthreads();
          } else gemm_run(lds, GemmJob{(const gbf*)WSB(WS_MB), KP2, WoT, KP2, NLAT, DM, DM}, EpiOut{(gf32*)WSB(WS_Y), 0}, gid, G);
          GSYNC();
        }
        for (int rep = 0; rep < (PROBE_DUP == 8 ? 2 : 1); ++rep) {
          if (l == 0) {
            if (gid < NC) gemm_run(lds, GemmJob{(const gbf*)WSB(WS_MB) + (size_t)NLAT * KP2, KP2, WoT, KP2, NCTX, DM, DM}, EpiOut{(gf32*)WSB(WS_Y), NLAT}, gid, NC);
            else phase_final(p, l, 0, NLAT, gid - NC, G - NC);
            GSYNC();
            phase_final(p, l, NLAT, NROW, gid, G);
            GSYNC();
          } else {
            phase_final(p, l, 0, NLAT, gid, G);
            if (rep + 1 < (PROBE_DUP == 8 ? 2 : 1)) GSYNC();
          }
        }
    }
}
#undef gid
#undef G

extern "C" void kernel_launch(void* const* d_in, const int* in_sizes, int n_in, void* d_out, int out_size, void* d_ws, size_t ws_size, hipStream_t stream) {
    static int grid_blocks = 0;
    if (grid_blocks == 0) {
        if (n_in != 20 || out_size != NLAT * DM || ws_size < WS_END) { fprintf(stderr, "kernel_launch: unexpected shapes (n_in %d out %d ws %zu, need ws >= %zu)\n", n_in, out_size, ws_size, (size_t)WS_END); grid_blocks = -1; return; }
        int dev = 0, cus = 0, per_cu = 0;
        hipGetDevice(&dev);
        hipDeviceGetAttribute(&cus, hipDeviceAttributeMultiprocessorCount, dev);
        if (hipFuncSetAttribute((const void*)fwd_megakernel, hipFuncAttributeMaxDynamicSharedMemorySize, LDS_BYTES) != hipSuccess) { fprintf(stderr, "kernel_launch: hipFuncSetAttribute failed\n"); grid_blocks = -1; return; }
        if (hipOccupancyMaxActiveBlocksPerMultiprocessor(&per_cu, (const void*)fwd_megakernel, NTHREADS, LDS_BYTES) != hipSuccess || per_cu < 1) { fprintf(stderr, "kernel_launch: occupancy query failed (%d)\n", per_cu); grid_blocks = -1; return; }
        grid_blocks = cus;
        fprintf(stderr, "kernel_launch: cus %d per_cu %d grid %d\n", cus, per_cu, grid_blocks);
    }
    if (grid_blocks < 0) return;
    if (hipMemsetAsync((char*)d_ws + WS_BAR, 0, 16384, stream) != hipSuccess) { fprintf(stderr, "kernel_launch: hipMemsetAsync of the barrier words failed\n"); return; }
    Params p{};
    for (int i = 0; i < 20; ++i) p.in[i] = (const gf32*)d_in[i];
    p.out = (gf32*)d_out; p.ws = (gu8*)d_ws;
    void* args[] = {&p};
    hipError_t e = hipLaunchCooperativeKernel((const void*)fwd_megakernel, dim3(grid_blocks), dim3(NTHREADS), args, LDS_BYTES, stream);
    if (e != hipSuccess) fprintf(stderr, "kernel_launch: cooperative launch failed: %s (grid %d)\n", hipGetErrorString(e), grid_blocks);
}
```

```cpp
#include <hip/hip_runtime.h>
#include <hip/hip_cooperative_groups.h>
#include <cstdio>
#include <cstdint>
namespace cg = cooperative_groups;
#ifndef PROBE_DUP
#define PROBE_DUP -1
#endif

#define GAS __attribute__((address_space(1)))
typedef unsigned short bf16_t;
typedef GAS bf16_t gbf;
typedef GAS float gf32;
typedef GAS unsigned char gu8;
typedef float f32x4 __attribute__((ext_vector_type(4)));
typedef unsigned u32x4 __attribute__((ext_vector_type(4)));
typedef unsigned u32x2 __attribute__((ext_vector_type(2)));

constexpr int DM = 2048, NB = 4, SEQ = 2048, CTXL = 256, DEPTH = 2;
constexpr int NLAT = NB * SEQ, NCTX = NB * CTXL, NROW = NLAT + NCTX;
constexpr int N_IN = 20288, NP = 20480;
constexpr int PP = 12288 + 64;
constexpr int KP2 = DM + 64;
constexpr int KP1 = 1024 + 64;
constexpr int KP4 = 4096 + 64;
constexpr int C_CKV = 0, C_KR = 256, C_NAK = 512, C_NAV = 1536, C_QL = 2560, C_NAQ = 3072, C_CB = 4096, C_CC = 5120, C_CX = 6144, C_FV = 7168,
              C_GCV = 8192, C_GML = 9216, C_GNA = 10240, C_GFN = 11264, C_MG = 12288;
constexpr int KVC_P = 2560;
constexpr int KMW = 1536, VMW = 1024, QMW = 1536, ABW = 4160;
constexpr float EPS = 1e-6f;
constexpr float LOG2E = 1.4426950408889634f;
constexpr float QSCALE = 0.07216878364870322f * LOG2E;
constexpr float NASCALE = 0.125f * LOG2E;
constexpr int NTHREADS = 512, NWAVES = 8;
constexpr int LDS_BYTES = 147456;

constexpr size_t al256(size_t x) { return (x + 255) / 256 * 256; }
constexpr size_t WS_WIN = 0;
constexpr size_t WS_WUKV = WS_WIN + al256((size_t)2 * NP * KP2 * 2);
constexpr size_t WS_WUQ = WS_WUKV + al256((size_t)2 * 2048 * 256 * 2);
constexpr size_t WS_WP = WS_WUQ + al256((size_t)2 * 1536 * 512 * 2);
constexpr size_t WS_WO = WS_WP + al256((size_t)2 * 4 * 2048 * KP1 * 2);
constexpr size_t WS_MOD = WS_WO + al256((size_t)2 * 2048 * KP2 * 2);
constexpr size_t WS_ROPE = WS_MOD + al256((size_t)2 * 5 * 6144 * 4);
constexpr size_t WS_DC = WS_ROPE + al256((size_t)64 * 16 * 2 * 4);
constexpr size_t WS_DN = WS_DC + al256((size_t)512 * 256 * 2);
constexpr size_t WS_DNC = WS_DN + al256((size_t)2048 * KP4 * 2);
constexpr size_t WS_U = WS_DNC + al256((size_t)256 * 512 * 2);
constexpr size_t WS_P = WS_U + al256((size_t)NROW * KP2 * 2);
constexpr size_t WS_KM = WS_P + al256((size_t)NROW * PP * 2);
constexpr size_t WS_VM = WS_KM + al256((size_t)NROW * KMW * 2);
constexpr size_t WS_QM = WS_VM + al256((size_t)NROW * VMW * 2);
constexpr size_t WS_AB = WS_QM + al256((size_t)NROW * QMW * 2);
constexpr size_t WS_GT = WS_AB + al256((size_t)NROW * ABW * 2);
constexpr size_t WS_GTC = WS_GT + al256((size_t)4 * 1024 * KP4 * 2);
constexpr size_t WS_MF = WS_GTC + al256((size_t)4 * 1024 * 512 * 2);
constexpr size_t WS_MB = WS_MF + al256((size_t)NROW * DM * 4);
constexpr size_t WS_Y = WS_MB + al256((size_t)NROW * KP2 * 2);
constexpr size_t WS_RKV = WS_Y + al256((size_t)NROW * DM * 4);
constexpr size_t WS_RQ = WS_RKV + al256((size_t)NROW * 4);
constexpr size_t WS_XL = WS_RQ + al256((size_t)NROW * 4);
constexpr size_t WS_NK = WS_XL + al256((size_t)NROW * DM * 4);
constexpr size_t WS_NV = WS_NK + al256((size_t)NROW * 1024 * 2);
constexpr size_t WS_NQ = WS_NV + al256((size_t)NROW * 1024 * 2);
constexpr size_t WS_MG = WS_NQ + al256((size_t)NROW * 1024 * 2);
constexpr size_t WS_SSQ = WS_MG + al256((size_t)4 * NROW * DM * 2);
constexpr size_t WS_BAR = WS_SSQ + al256((size_t)NCTX * 8 * 4);
constexpr size_t WS_END = WS_BAR + 16384;

struct Params { const gf32* in[20]; gf32* out; gu8* ws; };
enum { I_X = 0, I_C, I_CTX, I_CCTX, I_GPRE, I_GPOST, I_WADA, I_BADA, I_WIN, I_GQ, I_GKV, I_WUQ, I_WUKV, I_CONVW, I_RPB, I_WPC, I_WPM, I_WPN, I_WPF, I_WOUT };

__device__ __forceinline__ size_t hm_row(int r, int h, int NH) {
    return r < NLAT ? (size_t)(((r >> 11) * NH + h) * SEQ + (r & (SEQ - 1))) : (size_t)NB * NH * SEQ + (size_t)((((r - NLAT) >> 8) * NH + h) * CTXL + ((r - NLAT) & (CTXL - 1)));
}

__device__ __forceinline__ size_t mg_off(int z, int r, int c) { return ((((size_t)z * (NROW / 256) + (r >> 8)) * (DM / 256) + (c >> 8)) * 256 + (r & 255)) * 256 + (c & 255); }

__device__ __forceinline__ unsigned f2bf(float f) { unsigned u = __builtin_bit_cast(unsigned, f); return (u + 0x7fffu + ((u >> 16) & 1u)) >> 16; }
typedef float f32x2_t __attribute__((ext_vector_type(2))); typedef __bf16 bf16x2_t __attribute__((ext_vector_type(2)));
__device__ __forceinline__ unsigned pk2(float lo, float hi) { f32x2_t v = {lo, hi}; bf16x2_t b = __builtin_convertvector(v, bf16x2_t); return __builtin_bit_cast(unsigned, b); }
__device__ __forceinline__ float bf2f(unsigned short b) { return __builtin_bit_cast(float, (unsigned)b << 16); }
__device__ __forceinline__ float bflo(unsigned w) { return __builtin_bit_cast(float, w << 16); }
__device__ __forceinline__ float bfhi(unsigned w) { return __builtin_bit_cast(float, w & 0xffff0000u); }
__device__ __forceinline__ u32x2 pk4(f32x4 v) { u32x2 r; r.x = pk2(v[0], v[1]); r.y = pk2(v[2], v[3]); return r; }
__device__ __forceinline__ u32x4 pk8(f32x4 a, f32x4 b) { u32x4 r; r.x = pk2(a[0], a[1]); r.y = pk2(a[2], a[3]); r.z = pk2(b[0], b[1]); r.w = pk2(b[2], b[3]); return r; }
__device__ __forceinline__ void unpk8(u32x4 w, f32x4& a, f32x4& b) { a = (f32x4){bflo(w.x), bfhi(w.x), bflo(w.y), bfhi(w.y)}; b = (f32x4){bflo(w.z), bfhi(w.z), bflo(w.w), bfhi(w.w)}; }
__device__ __forceinline__ f32x4 unpk4(u32x2 w) { return (f32x4){bflo(w.x), bfhi(w.x), bflo(w.y), bfhi(w.y)}; }
__device__ __forceinline__ float sigmoidf_(float x) { return __builtin_amdgcn_rcpf(1.0f + __builtin_amdgcn_exp2f(x * -LOG2E)); }
__device__ __forceinline__ float siluf_(float x) { return x * __builtin_amdgcn_rcpf(1.0f + __builtin_amdgcn_exp2f(x * -LOG2E)); }
__device__ __forceinline__ float wave_sum(float v) {
#pragma unroll
    for (int o = 1; o < 64; o <<= 1) v += __shfl_xor(v, o);
    return v;
}
__device__ __forceinline__ float wave_max(float v) {
#pragma unroll
    for (int o = 1; o < 64; o <<= 1) v = fmaxf(v, __shfl_xor(v, o));
    return v;
}

typedef __attribute__((address_space(4))) const unsigned char* kargp_t;
__device__ __forceinline__ kargp_t karg_op() { kargp_t k = (kargp_t)__builtin_amdgcn_kernarg_segment_ptr(); asm volatile("" : "+s"(k)); return k; }
__device__ __forceinline__ const gf32* pin(int i) { return *(const gf32* const __attribute__((address_space(4)))*)(karg_op() + 8 * i); }
__device__ __forceinline__ gf32* pout() { return *(gf32* const __attribute__((address_space(4)))*)(karg_op() + 8 * 20); }
__device__ __forceinline__ gu8* wsb() { return *(gu8* const __attribute__((address_space(4)))*)(karg_op() + 8 * 21); }
__device__ __forceinline__ int tid_op() { int t = threadIdx.x; asm volatile("" : "+v"(t)); return t; }

struct GemmJob { const gbf* A; int lda; const gbf* Bt; int ldb; int M, N, K; };

#define LAS __attribute__((address_space(3)))
typedef short bf16x8 __attribute__((ext_vector_type(8)));
namespace fg {
constexpr int BM = 256, BK = 64, HALF = 128, HTB = HALF * BK * 2, STAGE_BYTES = 8 * HTB, NXCD = 8, WGM = 4;
__device__ __forceinline__ int lds_byte(int r, int c) { const int st = (r >> 4) * 2 + (c >> 5), rr = r & 15, cc = c & 31, ob = rr * 64 + cc * 2; return st * 1024 + (ob ^ (((ob >> 9) & 1) << 5)); }
__device__ __forceinline__ void stage_rc(int b, int& R, int& C) { const int st = b / 1024, sb = b % 1024, swz = sb ^ (((sb >> 9) & 1) << 5); R = (st >> 1) * 16 + swz / 64; C = (st & 1) * 32 + (swz % 64) / 2; }
__device__ __forceinline__ int perm32(int rho) { const int n = rho >> 4, i = rho & 15; return 8 * (i >> 2) + 4 * n + (i & 3); }
struct Unit { const GAS char* A; const GAS char* B; int pm, pn, z; };
template <class Map> struct Sched {
    Map map; int nM, nN, nz, G, c;
    __device__ __forceinline__ bool next(int i, Unit& u) const {
        const int per = nM * nN, nwg = per * nz; const long L = (long)i * G + c; if (L >= nwg) return false;
        int wgid = (int)L; { const int q = nwg / NXCD, r = nwg % NXCD, xcd = wgid % NXCD, off = wgid / NXCD; wgid = (xcd < r ? xcd * (q + 1) : r * (q + 1) + (xcd - r) * q) + off; }
        const int z = wgid / per, w = wgid % per;
        const int nig = WGM * nN, gidx = w / nig, fm = gidx * WGM, gsz = (nM - fm) < WGM ? (nM - fm) : WGM;
        u.pm = fm + ((w % nig) % gsz); u.pn = (w % nig) / gsz; u.z = z; u.A = (const GAS char*)map.a(z, u.pm); u.B = (const GAS char*)map.b(z, u.pn); return true;
    }
};
template <class Epi, class S_>
__device__ __forceinline__ void gemm(LAS unsigned char* lds, int lda, int ldb, int K, const S_& S, const Epi& E) {
    const int tid = tid_op(), wid = __builtin_amdgcn_readfirstlane(tid >> 6), lane = tid & 63, wr = wid >> 2, wc = wid & 3, fr = lane & 15, fq = lane >> 4;
    int Kop = K; asm volatile("" : "+s"(Kop));
    const int nt = Kop / BK;
    unsigned voffA[2], voffB[2];
#pragma unroll
    for (int i = 0; i < 2; ++i) { int R, C; stage_rc(tid * 16 + i * 8192, R, C); const int Rb = Epi::PERM ? ((R & ~31) + perm32(R & 31)) : R;
        voffA[i] = (unsigned)(R * lda + C) * 2u; voffB[i] = (unsigned)(Rb * ldb + C) * 2u; }
    const size_t kstep = (size_t)(BK * 2);
    const size_t hstepA = (size_t)HALF * lda * 2, hstepB = (size_t)HALF * ldb * 2;
    const unsigned ldsw = (unsigned)wid * 1024u;
    const int aoff = lds_byte(wr * 64 + fr, fq * 8), boff = lds_byte(wc * 32 + fr, fq * 8);
#define FG_SA(b, h) (((b) * 2 + (h)) * HTB)
#define FG_SB(b, h) ((4 + (b) * 2 + (h)) * HTB)
#define FG_STAGE(bufoff, gbase, voff) do { _Pragma("unroll") for (int _i = 0; _i < 2; ++_i) \
        __builtin_amdgcn_global_load_lds((const GAS unsigned*)((const GAS char*)(gbase) + (voff)[_i]), (LAS unsigned*)(lds + (bufoff) + ldsw + _i * 8192), 16, 0, 0); } while (0)
#define FG_LDA(dst, b, h) do { _Pragma("unroll") for (int m = 0; m < 4; ++m) _Pragma("unroll") for (int k = 0; k < 2; ++k) dst[m][k] = *(const LAS bf16x8*)(lds + FG_SA(b, h) + aoff + m * 2048 + k * 1024); } while (0)
#define FG_LDB(dst, b, h) do { _Pragma("unroll") for (int n = 0; n < 2; ++n) _Pragma("unroll") for (int k = 0; k < 2; ++k) dst[n][k] = *(const LAS bf16x8*)(lds + FG_SB(b, h) + boff + n * 2048 + k * 1024); } while (0)
#define FG_MMA(ai, bj, At, Bt) do { __builtin_amdgcn_s_setprio(1); _Pragma("unroll") for (int m = 0; m < 4; ++m) _Pragma("unroll") for (int n = 0; n < 2; ++n) _Pragma("unroll") for (int k = 0; k < 2; ++k) \
        acc[ai][bj][m][n] = __builtin_amdgcn_mfma_f32_16x16x32_bf16(Bt[n][k], At[m][k], acc[ai][bj][m][n], 0, 0, 0); __builtin_amdgcn_s_setprio(0); } while (0)
#define FG_WAIT_V(n) asm volatile("s_waitcnt vmcnt(" #n ")" ::: "memory")
#define FG_WAIT_L(n) asm volatile("s_waitcnt lgkmcnt(" #n ")" ::: "memory")
#define FG_BAR __builtin_amdgcn_s_barrier()
#define FG_SCHED __builtin_amdgcn_sched_barrier(0)
    Unit cur, nxt; int ui = 0;
    if (!S.next(0, cur)) return;
    f32x4 acc[2][2][4][2];
#pragma unroll
    for (int a = 0; a < 2; ++a)
#pragma unroll
        for (int b = 0; b < 2; ++b)
#pragma unroll
            for (int m = 0; m < 4; ++m)
#pragma unroll
                for (int n = 0; n < 2; ++n) acc[a][b][m][n] = (f32x4){0.f, 0.f, 0.f, 0.f};
    bf16x8 At[4][2], B0[2][2], B1[2][2];
    const GAS char* cA = cur.A; const GAS char* cB = cur.B;
    FG_STAGE(FG_SB(0, 0), cB, voffB); FG_STAGE(FG_SB(0, 1), cB + hstepB, voffB); FG_STAGE(FG_SA(0, 0), cA, voffA); FG_STAGE(FG_SA(0, 1), cA + hstepA, voffA);
    if (wr == 1) FG_BAR;
    FG_WAIT_V(2); FG_BAR;
    FG_STAGE(FG_SB(1, 0), cB + kstep, voffB); FG_STAGE(FG_SA(1, 0), cA + kstep, voffA); FG_STAGE(FG_SB(1, 1), cB + hstepB + kstep, voffB);
    FG_WAIT_V(6); FG_BAR;
    for (;;) {
        const bool has_next = S.next(ui + 1, nxt);
        const GAS char* nA = has_next ? nxt.A : cA; const GAS char* nB = has_next ? nxt.B : cB;
        for (int t = 0; t < nt; t += 2) {
            const bool last = (t == nt - 2);
            const GAS char* a1 = cA + (size_t)(t + 1) * kstep;
            const GAS char* a2 = last ? nA : cA + (size_t)(t + 2) * kstep; const GAS char* b2 = last ? nB : cB + (size_t)(t + 2) * kstep;
            const GAS char* a3 = a2 + kstep; const GAS char* b3 = b2 + kstep;
            FG_LDB(B0, 0, 0); FG_LDB(B1, 0, 1); FG_SCHED; FG_LDA(At, 0, 0); FG_STAGE(FG_SA(1, 1), a1 + hstepA, voffA);
            FG_WAIT_V(8); FG_WAIT_L(0); FG_BAR; FG_MMA(0, 0, At, B0); FG_MMA(0, 1, At, B1); FG_BAR; FG_SCHED;
            FG_LDA(At, 0, 1); FG_STAGE(FG_SB(0, 0), b2, voffB); FG_STAGE(FG_SB(0, 1), b2 + hstepB, voffB); FG_STAGE(FG_SA(0, 0), a2, voffA);
            FG_WAIT_V(8); FG_WAIT_L(0); FG_BAR; FG_MMA(1, 0, At, B0); FG_MMA(1, 1, At, B1); FG_BAR; FG_SCHED;
            FG_LDB(B0, 1, 0); FG_LDB(B1, 1, 1); FG_SCHED; FG_LDA(At, 1, 0); FG_STAGE(FG_SA(0, 1), a2 + hstepA, voffA);
            FG_WAIT_V(8); FG_WAIT_L(0); FG_BAR; FG_MMA(0, 0, At, B0); FG_MMA(0, 1, At, B1); FG_BAR; FG_SCHED;
            FG_LDA(At, 1, 1); FG_STAGE(FG_SB(1, 0), b3, voffB); FG_STAGE(FG_SB(1, 1), b3 + hstepB, voffB); FG_STAGE(FG_SA(1, 0), a3, voffA);
            FG_WAIT_V(8); FG_WAIT_L(0); FG_BAR; FG_MMA(1, 0, At, B0); FG_MMA(1, 1, At, B1); FG_BAR; FG_SCHED;
        }
        if (wr == 0) FG_BAR;
        bool keep_acc = false;
        {
            const auto Ez = E.z(cur.z);
            if constexpr (Epi::CHAIN) keep_acc = Epi::keep(cur.z);
            if constexpr (Epi::CHAIN) Ez.pre(cur.pm, cur.pn, cur.z);
#pragma unroll
            for (int ai = 0; ai < 2; ++ai)
#pragma unroll
                for (int m = 0; m < 4; ++m)
#pragma unroll
                    for (int bj = 0; bj < 2; ++bj) {
                        const int row_ = cur.pm * BM + ai * HALF + wr * 64 + m * 16 + fr, col_ = cur.pn * BM + bj * HALF + wc * 32 + (Epi::PERM ? 8 : 4) * fq;
                        if constexpr (Epi::CHAIN) Ez.chain(row_, col_, acc[ai][bj][m][0], acc[ai][bj][m][1], cur.z);
                        else Ez(row_, col_, acc[ai][bj][m][0], acc[ai][bj][m][1]);
                        if (bj == 1 && (m & 1)) asm volatile("" ::: "memory");
                    }
            if constexpr (Epi::CHAIN) Ez.post(cur.pm, cur.pn, cur.z);
        }
        if (!has_next) break;
        if (!keep_acc) {
#pragma unroll
        for (int a = 0; a < 2; ++a)
#pragma unroll
            for (int b = 0; b < 2; ++b)
#pragma unroll
                for (int m = 0; m < 4; ++m)
#pragma unroll
                    for (int n = 0; n < 2; ++n) acc[a][b][m][n] = (f32x4){0.f, 0.f, 0.f, 0.f};
        }
        cur = nxt; cA = nA; cB = nB; ++ui;
        if (wr == 1) FG_BAR;
    }
    FG_WAIT_V(0);
    FG_BAR;
#undef FG_SA
#undef FG_SB
#undef FG_STAGE
#undef FG_LDA
#undef FG_LDB
#undef FG_MMA
#undef FG_WAIT_V
#undef FG_WAIT_L
#undef FG_BAR
#undef FG_SCHED
}

struct UnitM { const GAS char* A; const GAS char* B; int lda, ldb, nt, pm, pn, z, job; };
template <class EpiM, class SM>
__device__ __forceinline__ void gemm_multi(LAS unsigned char* lds, const SM& S, const EpiM& E) {
    const int tid = tid_op(), wid = __builtin_amdgcn_readfirstlane(tid >> 6), lane = tid & 63, wr = wid >> 2, wc = wid & 3, fr = lane & 15, fq = lane >> 4;
    int sR[2], sRb[2], sC[2];
#pragma unroll
    for (int i = 0; i < 2; ++i) { stage_rc(tid * 16 + i * 8192, sR[i], sC[i]); sRb[i] = (sR[i] & ~31) + perm32(sR[i] & 31); }
    const size_t kstep = (size_t)(BK * 2);
    const unsigned ldsw = (unsigned)wid * 1024u;
    const int aoff = lds_byte(wr * 64 + fr, fq * 8), boff = lds_byte(wc * 32 + fr, fq * 8);
#define FG_SA(b, h) (((b) * 2 + (h)) * HTB)
#define FG_SB(b, h) ((4 + (b) * 2 + (h)) * HTB)
#define FG_STAGE(bufoff, gbase, voff) do { _Pragma("unroll") for (int _i = 0; _i < 2; ++_i) \
        __builtin_amdgcn_global_load_lds((const GAS unsigned*)((const GAS char*)(gbase) + (voff)[_i]), (LAS unsigned*)(lds + (bufoff) + ldsw + _i * 8192), 16, 0, 0); } while (0)
#define FG_LDA(dst, b, h) do { _Pragma("unroll") for (int m = 0; m < 4; ++m) _Pragma("unroll") for (int k = 0; k < 2; ++k) dst[m][k] = *(const LAS bf16x8*)(lds + FG_SA(b, h) + aoff + m * 2048 + k * 1024); } while (0)
#define FG_LDB(dst, b, h) do { _Pragma("unroll") for (int n = 0; n < 2; ++n) _Pragma("unroll") for (int k = 0; k < 2; ++k) dst[n][k] = *(const LAS bf16x8*)(lds + FG_SB(b, h) + boff + n * 2048 + k * 1024); } while (0)
#define FG_MMA(ai, bj, At, Bt) do { __builtin_amdgcn_s_setprio(1); _Pragma("unroll") for (int m = 0; m < 4; ++m) _Pragma("unroll") for (int n = 0; n < 2; ++n) _Pragma("unroll") for (int k = 0; k < 2; ++k) \
        acc[ai][bj][m][n] = __builtin_amdgcn_mfma_f32_16x16x32_bf16(Bt[n][k], At[m][k], acc[ai][bj][m][n], 0, 0, 0); __builtin_amdgcn_s_setprio(0); } while (0)
#define FG_WAIT_V(n) asm volatile("s_waitcnt vmcnt(" #n ")" ::: "memory")
#define FG_WAIT_L(n) asm volatile("s_waitcnt lgkmcnt(" #n ")" ::: "memory")
#define FG_BAR __builtin_amdgcn_s_barrier()
#define FG_SCHED __builtin_amdgcn_sched_barrier(0)
#define FG_OFFS(u, vA, vB, hA, hB) do { _Pragma("unroll") for (int _i = 0; _i < 2; ++_i) { vA[_i] = (unsigned)(sR[_i] * (u).lda + sC[_i]) * 2u; vB[_i] = (unsigned)(sRb[_i] * (u).ldb + sC[_i]) * 2u; } \
        hA = (size_t)HALF * (u).lda * 2; hB = (size_t)HALF * (u).ldb * 2; } while (0)
    UnitM cur, nxt; int ui = 0;
    if (!S.next(0, cur)) return;
    unsigned vAc[2], vBc[2], vAn[2], vBn[2]; size_t hAc, hBc, hAn, hBn;
    FG_OFFS(cur, vAc, vBc, hAc, hBc);
    f32x4 acc[2][2][4][2];
#pragma unroll
    for (int a = 0; a < 2; ++a)
#pragma unroll
        for (int b = 0; b < 2; ++b)
#pragma unroll
            for (int m = 0; m < 4; ++m)
#pragma unroll
                for (int n = 0; n < 2; ++n) acc[a][b][m][n] = (f32x4){0.f, 0.f, 0.f, 0.f};
    bf16x8 At[4][2], B0[2][2], B1[2][2];
    const GAS char* cA = cur.A; const GAS char* cB = cur.B;
    FG_STAGE(FG_SB(0, 0), cB, vBc); FG_STAGE(FG_SB(0, 1), cB + hBc, vBc); FG_STAGE(FG_SA(0, 0), cA, vAc); FG_STAGE(FG_SA(0, 1), cA + hAc, vAc);
    if (wr == 1) FG_BAR;
    FG_WAIT_V(2); FG_BAR;
    FG_STAGE(FG_SB(1, 0), cB + kstep, vBc); FG_STAGE(FG_SA(1, 0), cA + kstep, vAc); FG_STAGE(FG_SB(1, 1), cB + hBc + kstep, vBc);
    FG_WAIT_V(6); FG_BAR;
    for (;;) {
        const bool has_next = S.next(ui + 1, nxt);
        if (!has_next) nxt = cur;
        FG_OFFS(nxt, vAn, vBn, hAn, hBn);
        const GAS char* nA = nxt.A; const GAS char* nB = nxt.B;
        const int nt = cur.nt;
        for (int t = 0; t < nt; t += 2) {
            const bool last = (t == nt - 2);
            const GAS char* a1 = cA + (size_t)(t + 1) * kstep;
            const GAS char* a2 = last ? nA : cA + (size_t)(t + 2) * kstep; const GAS char* b2 = last ? nB : cB + (size_t)(t + 2) * kstep;
            const GAS char* a3 = a2 + kstep; const GAS char* b3 = b2 + kstep;
            unsigned vA2[2], vB2[2];
#pragma unroll
            for (int _i = 0; _i < 2; ++_i) { vA2[_i] = last ? vAn[_i] : vAc[_i]; vB2[_i] = last ? vBn[_i] : vBc[_i]; }
            const size_t hA2 = last ? hAn : hAc, hB2 = last ? hBn : hBc;
            FG_LDB(B0, 0, 0); FG_LDB(B1, 0, 1); FG_SCHED; FG_LDA(At, 0, 0); FG_STAGE(FG_SA(1, 1), a1 + hAc, vAc);
            FG_WAIT_V(8); FG_WAIT_L(0); FG_BAR; FG_MMA(0, 0, At, B0); FG_MMA(0, 1, At, B1); FG_BAR; FG_SCHED;
            FG_LDA(At, 0, 1); FG_STAGE(FG_SB(0, 0), b2, vB2); FG_STAGE(FG_SB(0, 1), b2 + hB2, vB2); FG_STAGE(FG_SA(0, 0), a2, vA2);
            FG_WAIT_V(8); FG_WAIT_L(0); FG_BAR; FG_MMA(1, 0, At, B0); FG_MMA(1, 1, At, B1); FG_BAR; FG_SCHED;
            FG_LDB(B0, 1, 0); FG_LDB(B1, 1, 1); FG_SCHED; FG_LDA(At, 1, 0); FG_STAGE(FG_SA(0, 1), a2 + hA2, vA2);
            FG_WAIT_V(8); FG_WAIT_L(0); FG_BAR; FG_MMA(0, 0, At, B0); FG_MMA(0, 1, At, B1); FG_BAR; FG_SCHED;
            FG_LDA(At, 1, 1); FG_STAGE(FG_SB(1, 0), b3, vB2); FG_STAGE(FG_SB(1, 1), b3 + hB2, vB2); FG_STAGE(FG_SA(1, 0), a3, vA2);
            FG_WAIT_V(8); FG_WAIT_L(0); FG_BAR; FG_MMA(1, 0, At, B0); FG_MMA(1, 1, At, B1); FG_BAR; FG_SCHED;
        }
        if (wr == 0) FG_BAR;
#pragma unroll
        for (int ai = 0; ai < 2; ++ai)
#pragma unroll
            for (int m = 0; m < 4; ++m)
#pragma unroll
                for (int bj = 0; bj < 2; ++bj) {
                    E.apply(cur, cur.pm * BM + ai * HALF + wr * 64 + m * 16 + fr, cur.pn * BM + bj * HALF + wc * 32 + 8 * fq, acc[ai][bj][m][0], acc[ai][bj][m][1]);
                    if (bj == 1 && (m & 1)) asm volatile("" ::: "memory");
                }
        if (!has_next) break;
#pragma unroll
        for (int a = 0; a < 2; ++a)
#pragma unroll
            for (int b = 0; b < 2; ++b)
#pragma unroll
                for (int m = 0; m < 4; ++m)
#pragma unroll
                    for (int n = 0; n < 2; ++n) acc[a][b][m][n] = (f32x4){0.f, 0.f, 0.f, 0.f};
        cur = nxt; cA = nA; cB = nB; ++ui;
#pragma unroll
        for (int _i = 0; _i < 2; ++_i) { vAc[_i] = vAn[_i]; vBc[_i] = vBn[_i]; }
        hAc = hAn; hBc = hBn;
        if (wr == 1) FG_BAR;
    }
    FG_WAIT_V(0);
    FG_BAR;
#undef FG_SA
#undef FG_SB
#undef FG_STAGE
#undef FG_LDA
#undef FG_LDB
#undef FG_MMA
#undef FG_WAIT_V
#undef FG_WAIT_L
#undef FG_BAR
#undef FG_SCHED
#undef FG_OFFS
}
struct SchedBranch { const gbf* AB; const gbf* WpT; int nM, nN, G, c, pm0;
    __device__ __forceinline__ bool next(int i, Unit& u) const {
        const int nwg = nM * nN; const long L = (long)(i >> 2) * G + c; if (L >= nwg) return false;
        int wgid = (int)L; { const int q = nwg / NXCD, r = nwg % NXCD, xcd = wgid % NXCD, off = wgid / NXCD; wgid = (xcd < r ? xcd * (q + 1) : r * (q + 1) + (xcd - r) * q) + off; }
        const int nig = WGM * nN, gidx = wgid / nig, fm = gidx * WGM, gsz = (nM - fm) < WGM ? (nM - fm) : WGM;
        u.pm = fm + ((wgid % nig) % gsz); u.pn = (wgid % nig) / gsz; u.z = i & 3;
        u.A = (const GAS char*)(AB + (size_t)(pm0 + u.pm) * BM * ABW + u.z * 1024); u.B = (const GAS char*)(WpT + ((size_t)u.z * 2048 + (size_t)u.pn * BM) * KP1); return true;
    }
};
struct SchedBranchH { const gbf* AB; const gbf* WpT; int nM, nN, c, pm0;
    __device__ __forceinline__ bool next(int i, Unit& u) const {
        if (i >= 2 || (c >> 1) >= nM * nN) return false;
        const int t = c >> 1; u.pm = t % nM; u.pn = t / nM; u.z = 2 * (c & 1) + i;
        u.A = (const GAS char*)(AB + (size_t)(pm0 + u.pm) * BM * ABW + u.z * 1024); u.B = (const GAS char*)(WpT + ((size_t)u.z * 2048 + (size_t)u.pn * BM) * KP1); return true;
    }
};
struct SchedIn0 { const gbf* U; const gbf* WinT; int G, c, i0, i1;
    __device__ __forceinline__ bool next(int i, Unit& u) const {
        const int ii = i + i0; if (ii >= i1) return false;
        const int L = ii * G + c; if (L >= 36 * 80) return false;
        const int xcd = L & 7, off = L >> 3; int t, nNc, pn0;
        if (off < 216) { t = xcd * 216 + off; nNc = 48; pn0 = 0; } else { t = xcd * 144 + (off - 216); nNc = 32; pn0 = 48; }
        const int nig = WGM * nNc, gidx = t / nig, fm = gidx * WGM, gsz = (36 - fm) < WGM ? (36 - fm) : WGM;
        u.pm = fm + ((t % nig) % gsz); u.pn = pn0 + (t % nig) / gsz; u.z = 0;
        u.A = (const GAS char*)(U + (size_t)u.pm * BM * KP2); u.B = (const GAS char*)(WinT + (size_t)u.pn * BM * KP2); return true;
    }
};
struct MapPlain { const gbf* A; int lda; const gbf* Bt; int ldb;
    __device__ __forceinline__ const gbf* a(int, int pm) const { return A + (size_t)pm * BM * lda; }
    __device__ __forceinline__ const gbf* b(int, int pn) const { return Bt + (size_t)pn * BM * ldb; } };
}

template <class Epi>
__device__ __forceinline__ void gemm_fast_plain(unsigned char* lds, const GemmJob j, const Epi& E, int gid, int G) {
    __syncthreads();
    fg::Sched<fg::MapPlain> S{fg::MapPlain{j.A, j.lda, j.Bt, j.ldb}, j.M / 256, j.N / 256, 1, G, gid};
    fg::gemm((LAS unsigned char*)lds, j.lda, j.ldb, j.K, S, E);
    __syncthreads();
}

struct MapF1 { const gbf* DC; const gbf* Pfv; int zrows;
    __device__ __forceinline__ const gbf* a(int, int pm) const { return DC + (size_t)pm * 256 * 256; }
    __device__ __forceinline__ const gbf* b(int z, int pn) const { return Pfv + ((size_t)(z >> 2) * zrows + (size_t)pn * 256) * PP + (z & 3) * 256; } };
struct MapF2 { const gbf* DN; const gbf* GT; int ld;
    __device__ __forceinline__ const gbf* a(int, int pm) const { return DN + (size_t)pm * 256 * ld; }
    __device__ __forceinline__ const gbf* b(int z, int pn) const { return GT + ((size_t)z * 1024 + (size_t)pn * 256) * ld; } };
template <class Map, class Epi>
__device__ __forceinline__ void gemm_fast_z(unsigned char* lds, const Map& map, int lda, int ldb, int K, int nM, int nN, int nz, const Epi& E, int c, int Gs) {
    __syncthreads();
    if (c >= 0) { fg::Sched<Map> S{map, nM, nN, nz, Gs, c}; fg::gemm((LAS unsigned char*)lds, lda, ldb, K, S, E); }
    __syncthreads();
}

template <class Epi>
__device__ __forceinline__ void gemm_run(unsigned char* lds, const GemmJob j, const Epi& E, int first, int stride) {
    gemm_fast_plain(lds, j, E, first, stride);
}

struct EpiInProj {
    static constexpr bool PERM = true, CHAIN = false;
    gbf* P; int row0; gbf* NK; gbf* NV; gbf* NQ; gbf* MG;
    __device__ __forceinline__ EpiInProj z(int) const { return *this; }
    __device__ __forceinline__ void operator()(int row, int col, f32x4 a, f32x4 b) const {
        if (col >= C_MG) {
#pragma unroll
            for (int i = 0; i < 4; ++i) { a[i] = sigmoidf_(fminf(fmaxf(a[i], -30.f), 30.f)); b[i] = sigmoidf_(fminf(fmaxf(b[i], -30.f), 30.f)); }
        } else if (col >= C_GCV) {
#pragma unroll
            for (int i = 0; i < 4; ++i) { a[i] = siluf_(a[i]); b[i] = siluf_(b[i]); }
        } else if (col >= C_NAQ && col < C_CB) { a = a * NASCALE; b = b * NASCALE; }
        const int r = row0 + row;
        if (col >= C_MG) { const int cc = col - C_MG; __builtin_nontemporal_store(pk8(a, b), (GAS u32x4*)(MG + mg_off(cc >> 11, r, cc & 2047))); }
        else if (col >= C_NAK && col < C_CB && !(col >= C_QL && col < C_NAQ)) {
            const int sel = (col < C_NAV) ? 0 : (col < C_QL) ? 1 : 2, cc = (col < C_NAV) ? col - C_NAK : (col < C_QL) ? col - C_NAV : col - C_NAQ;
            __builtin_nontemporal_store(pk8(a, b), (GAS u32x4*)(NK + (size_t)sel * ((WS_NV - WS_NK) / 2) + hm_row(r, cc >> 6, 16) * 64 + (cc & 63)));
        } else __builtin_nontemporal_store(pk8(a, b), (GAS u32x4*)(P + (size_t)r * PP + col));
    }
};
struct EpiInProjC1 {
    static constexpr bool PERM = true, CHAIN = false;
    gbf* P; gbf* NK; gbf* KM; gf32* SSQ;
    __device__ __forceinline__ EpiInProjC1 z(int) const { return *this; }
    __device__ __forceinline__ void operator()(int row, int col, f32x4 a, f32x4 b) const {
        const int r = NLAT + row;
        if (col < 256) {
            *(GAS u32x4*)(P + (size_t)r * PP + col) = pk8(a, b);
            float s = a[0] * a[0] + a[1] * a[1] + a[2] * a[2] + a[3] * a[3] + b[0] * b[0] + b[1] * b[1] + b[2] * b[2] + b[3] * b[3];
            s += __shfl_xor(s, 16); s += __shfl_xor(s, 32);
            if ((col & 31) == 0) SSQ[(size_t)row * 8 + (col >> 5)] = s;
        } else if (col < 512) {
            if (col < 320) { const u32x4 v = pk8(a, b);
#pragma unroll
                for (int h = 0; h < 8; ++h) *(GAS u32x4*)(KM + hm_row(r, h, 8) * 192 + 128 + (col - 256)) = v; }
        } else {
            const int sel = (col < C_NAV) ? 0 : 1, cc = (col < C_NAV) ? col - C_NAK : col - C_NAV;
            *(GAS u32x4*)(NK + (size_t)sel * ((WS_NV - WS_NK) / 2) + hm_row(r, cc >> 6, 16) * 64 + (cc & 63)) = pk8(a, b);
        }
    }
};
struct EpiKvUp {
    static constexpr bool PERM = true, CHAIN = false;
    gbf* KM; gbf* VM; const gf32* rstd; int row0;
    __device__ __forceinline__ EpiKvUp z(int) const { return *this; }
    __device__ __forceinline__ void operator()(int row, int col, f32x4 a, f32x4 b) const {
        const int r = row0 + row, h = col >> 8, jj = col & 255; const float s = rstd[r];
        const size_t hr = hm_row(r, h, 8); gbf* p = (jj < 128) ? KM + hr * 192 + jj : VM + hr * 128 + (jj - 128);
        *(GAS u32x4*)p = pk8(a * s, b * s);
    }
};
struct EpiQUp {
    static constexpr bool PERM = false, CHAIN = false;
    gbf* QM; const gf32* rstd; const gf32* rope; int row0;
    __device__ __forceinline__ EpiQUp z(int) const { return *this; }
    __device__ __forceinline__ void operator()(int row, int col, f32x4 a, f32x4 b) const {
        const int r = row0 + row, h = col / 192, jj = col - h * 192; const float s = rstd[r] * QSCALE;
        a = a * s; b = b * s;
        if (jj >= 128 && r < NLAT) {
            const int t = r & (SEQ - 1), e = jj - 128, pos = (e < 32) ? (t >> 6) : (t & 63), f0 = e & 15;
            const gf32* rp = rope + (pos * 16 + f0) * 2;
#pragma unroll
            for (int i = 0; i < 4; ++i) { const float c = rp[2 * i], sn = rp[2 * i + 1]; const float x = a[i], y = b[i]; a[i] = x * c - y * sn; b[i] = x * sn + y * c; }
        }
        gbf* p = QM + hm_row(r, h, 8) * 192 + jj;
        *(GAS u32x2*)p = pk4(a); *(GAS u32x2*)(p + 16) = pk4(b);
    }
};
struct EpiF1 {
    static constexpr bool PERM = true, CHAIN = false;
    gbf* GT; int S; int g;
    __device__ __forceinline__ EpiF1 z(int zz) const { return EpiF1{GT + (size_t)(zz >> 2) * 1024 * 2 * S, S, zz & 3}; }
    __device__ __forceinline__ void operator()(int row, int col, f32x4 a, f32x4 b) const {
        *(GAS u32x4*)(GT + (size_t)(g * 256 + (row & 255)) * (2 * S) + (row >> 8) * S + col) = pk8(a, b);
    }
};
struct EpiF2 {
    static constexpr bool PERM = true, CHAIN = false;
    gbf* AB; const gbf* P; int row0; int zrows;
    __device__ __forceinline__ EpiF2 z(int zz) const { return EpiF2{AB, P, row0 + zz * zrows, zrows}; }
    __device__ __forceinline__ void operator()(int row, int col, f32x4 a, f32x4 b) const {
        const size_t r = (size_t)(row0 + row);
        f32x4 ga, gb; unpk8(*(const GAS u32x4*)(P + r * PP + C_GFN + col), ga, gb);
        *(GAS u32x4*)(AB + r * ABW + 3072 + col) = pk8(a * ga, b * gb);
    }
};
struct EpiF2M {
    static constexpr bool PERM = true, CHAIN = false;
    gbf* AB; const gbf* P; int row0; int zrows;
    __device__ __forceinline__ EpiF2M z(int zz) const { return EpiF2M{AB, P, row0 + zz * zrows, zrows}; }
    __device__ __forceinline__ void operator()(int row, int col, f32x4 a, f32x4 b) const {
        const size_t r = (size_t)(row0 + row);
        f32x4 ga, gb; unpk8(*(const GAS u32x4*)(P + r * PP + C_GFN + col), ga, gb);
        *(GAS u32x4*)(AB + r * ABW + 3072 + col) = pk8(a * ga, b * gb);
        if (row != 0) {
            const size_t rm = (size_t)(row0 + SEQ - row); const int gbase = col & ~255, c = col & 255;
            const int cA = gbase + 248 - c, cB = gbase + ((256 - c) & 255);
            f32x4 xa, xb, ya, yb; unpk8(*(const GAS u32x4*)(P + rm * PP + C_GFN + cA), xa, xb); unpk8(*(const GAS u32x4*)(P + rm * PP + C_GFN + cB), ya, yb);
            gbf* o = AB + rm * ABW + 3072;
            *(GAS unsigned short*)(o + cA + 1) = (unsigned short)f2bf(b[3] * xa[1]);
            *(GAS unsigned*)(o + cA + 2) = pk2(b[2] * xa[2], b[1] * xa[3]);
            *(GAS unsigned*)(o + cA + 4) = pk2(b[0] * xb[0], a[3] * xb[1]);
            *(GAS unsigned*)(o + cA + 6) = pk2(a[2] * xb[2], a[1] * xb[3]);
            *(GAS unsigned short*)(o + cB) = (unsigned short)f2bf(a[0] * ya[0]);
            (void)yb;
        }
    }
};
struct EpiBranch {
    static constexpr bool PERM = true, CHAIN = false;
    gf32* MF; gbf* MB; const gbf* P; int i; int row0;
    __device__ __forceinline__ EpiBranch z(int) const { return *this; }
    __device__ __forceinline__ void operator()(int row, int col, f32x4 a, f32x4 b) const {
        const size_t r = (size_t)(row0 + row);
        f32x4 ga, gb; unpk8(*(const GAS u32x4*)(P + r * PP + C_MG + i * DM + col), ga, gb);
        gf32* m = MF + r * DM + col;
        f32x4 va = a * ga, vb = b * gb;
        if (i > 0) { va += *(const GAS f32x4*)m; vb += *(const GAS f32x4*)(m + 4); }
        if (i < 3) { *(GAS f32x4*)m = va; *(GAS f32x4*)(m + 4) = vb; }
        else *(GAS u32x4*)(MB + r * DM + col) = pk8(va, vb);
    }
};
struct EpiChain {
    static constexpr bool PERM = true, CHAIN = true;
    gbf* MB; const gbf* P; int row0;
    __device__ __forceinline__ EpiChain z(int) const { return *this; }
    static __device__ __forceinline__ bool keep(int zz) { return zz < 3; }
    __device__ __forceinline__ void pre(int, int, int) const {}
    __device__ __forceinline__ void post(int, int, int) const {}
    __device__ __forceinline__ void chain(int row, int col, f32x4& a, f32x4& b, int zz) const {
        const size_t r = (size_t)(row0 + row);
        if (zz < 3) {
            f32x4 ga, gb, ha, hb; unpk8(__builtin_nontemporal_load((const GAS u32x4*)(P + mg_off(zz, (int)r, col))), ga, gb); unpk8(__builtin_nontemporal_load((const GAS u32x4*)(P + mg_off(zz + 1, (int)r, col))), ha, hb);
#pragma unroll
            for (int i = 0; i < 4; ++i) { a[i] *= ga[i] * __builtin_amdgcn_rcpf(ha[i]); b[i] *= gb[i] * __builtin_amdgcn_rcpf(hb[i]); }
        } else {
            f32x4 ga, gb; unpk8(__builtin_nontemporal_load((const GAS u32x4*)(P + mg_off(3, (int)r, col))), ga, gb);
            *(GAS u32x4*)(MB + r * KP2 + col) = pk8(a * ga, b * gb);
        }
    }
};
#define HC_FLAG0 3700
struct EpiChainH {
    static constexpr bool PERM = true, CHAIN = true;
    gbf* MB; const gbf* P; int row0; gf32* PART; unsigned* flags;
    __device__ __forceinline__ EpiChainH z(int) const { return *this; }
    static __device__ __forceinline__ bool keep(int zz) { return (zz & 1) == 0; }
    __device__ __forceinline__ void pre(int pm, int pn, int zz) const {
        if (zz == 3) {
            if (threadIdx.x == 0) { unsigned sp = 0; while (__hip_atomic_load(flags + pm * 8 + pn, __ATOMIC_ACQUIRE, __HIP_MEMORY_SCOPE_AGENT) == 0u && ++sp < (1u << 22)) __builtin_amdgcn_s_sleep(2); }
            __syncthreads(); __builtin_amdgcn_fence(__ATOMIC_ACQUIRE, "agent");
        }
    }
    __device__ __forceinline__ void post(int pm, int pn, int zz) const {
        if (zz == 1) {
            asm volatile("s_waitcnt vmcnt(0)" ::: "memory"); __syncthreads();
            if (threadIdx.x == 0) { __builtin_amdgcn_fence(__ATOMIC_RELEASE, "agent"); __hip_atomic_store(flags + pm * 8 + pn, 1u, __ATOMIC_RELEASE, __HIP_MEMORY_SCOPE_AGENT); }
        }
    }
    __device__ __forceinline__ void chain(int row, int col, f32x4& a, f32x4& b, int zz) const {
        const size_t r = (size_t)(row0 + row);
        if ((zz & 1) == 0) {
            f32x4 ga, gb, ha, hb; unpk8(__builtin_nontemporal_load((const GAS u32x4*)(P + mg_off(zz, (int)r, col))), ga, gb); unpk8(__builtin_nontemporal_load((const GAS u32x4*)(P + mg_off(zz + 1, (int)r, col))), ha, hb);
#pragma unroll
            for (int i = 0; i < 4; ++i) { a[i] *= ga[i] * __builtin_amdgcn_rcpf(ha[i]); b[i] *= gb[i] * __builtin_amdgcn_rcpf(hb[i]); }
        } else {
            f32x4 ga, gb; unpk8(__builtin_nontemporal_load((const GAS u32x4*)(P + mg_off(zz, (int)r, col))), ga, gb);
            gf32* pp = PART + (size_t)row * DM + col;
            if (zz == 1) { *(GAS f32x4*)pp = a * ga; *(GAS f32x4*)(pp + 4) = b * gb; }
            else { const f32x4 pa = *(const GAS f32x4*)pp, pb = *(const GAS f32x4*)(pp + 4); *(GAS u32x4*)(MB + r * KP2 + col) = pk8(a * ga + pa, b * gb + pb); }
        }
    }
};
struct EpiOut {
    static constexpr bool PERM = true, CHAIN = false;
    gf32* Y; int row0;
    __device__ __forceinline__ EpiOut z(int) const { return *this; }
    __device__ __forceinline__ void operator()(int row, int col, f32x4 a, f32x4 b) const {
        gf32* p = Y + (size_t)(row0 + row) * DM + col; *(GAS f32x4*)p = a; *(GAS f32x4*)(p + 4) = b;
    }
};

struct EpiC2 {
    gbf* KM; gbf* VM; gbf* QM; gbf* GT; gbf* GTC; const gf32* RKV; const gf32* RQ; const gf32* rope; const gf32* SSQ; gbf* MG;
    __device__ __forceinline__ void apply(const fg::UnitM& u, int row, int col, f32x4 a, f32x4 b) const {
        if (u.job == 4) {
#pragma unroll
            for (int i = 0; i < 4; ++i) { a[i] = sigmoidf_(fminf(fmaxf(a[i], -30.f), 30.f)); b[i] = sigmoidf_(fminf(fmaxf(b[i], -30.f), 30.f)); }
            const int cc = col - C_MG; __builtin_nontemporal_store(pk8(a, b), (GAS u32x4*)(MG + mg_off(cc >> 11, row, cc & 2047)));
            return;
        }
        if (u.job == 0) {
            const int h = col >> 8, jj = col & 255; float s;
            if (SSQ != nullptr && row >= NLAT) { const f32x4 s0 = *(const GAS f32x4*)(SSQ + (size_t)(row - NLAT) * 8), s1 = *(const GAS f32x4*)(SSQ + (size_t)(row - NLAT) * 8 + 4);
                s = rsqrtf(((s0[0] + s0[1]) + (s0[2] + s0[3]) + (s1[0] + s1[1]) + (s1[2] + s1[3])) * (1.0f / 256.0f) + EPS); }
            else s = RKV[row];
            const size_t hr = hm_row(row, h, 8); gbf* p = (jj < 128) ? KM + hr * 192 + jj : VM + hr * 128 + (jj - 128);
            *(GAS u32x4*)p = pk8(a * s, b * s);
        } else if (u.job == 1) {
            const int h = col / 192, jj = col - h * 192; const float s = RQ[row] * QSCALE;
            a = a * s; b = b * s;
            if (jj >= 128 && row < NLAT) {
                const int t = row & (SEQ - 1), e = jj - 128, pos = (e < 32) ? (t >> 6) : (t & 63), f0 = e & 15; const bool second = (e & 16) != 0;
                const gf32* rp = rope + (pos * 16 + f0) * 2;
                const f32x4 cs0 = *(const GAS f32x4*)rp, cs1 = *(const GAS f32x4*)(rp + 4), cs2 = *(const GAS f32x4*)(rp + 8), cs3 = *(const GAS f32x4*)(rp + 12);
                const float cc[8] = {cs0[0], cs0[2], cs1[0], cs1[2], cs2[0], cs2[2], cs3[0], cs3[2]}, ss[8] = {cs0[1], cs0[3], cs1[1], cs1[3], cs2[1], cs2[3], cs3[1], cs3[3]};
#pragma unroll
                for (int i = 0; i < 4; ++i) { const float ya = __shfl_xor(a[i], 32), yb = __shfl_xor(b[i], 32);
                    a[i] = second ? (ya * ss[i] + a[i] * cc[i]) : (a[i] * cc[i] - ya * ss[i]);
                    b[i] = second ? (yb * ss[4 + i] + b[i] * cc[4 + i]) : (b[i] * cc[4 + i] - yb * ss[4 + i]); }
            }
            *(GAS u32x4*)(QM + hm_row(row, h, 8) * 192 + jj) = pk8(a, b);
        } else {
            const int S_ = (u.job == 2) ? SEQ : CTXL, ld_ = (u.job == 2) ? KP4 : 2 * CTXL; gbf* G_ = (u.job == 2) ? GT : GTC; const int bb = u.z >> 2, g = u.z & 3;
            *(GAS u32x4*)(G_ + (size_t)bb * 1024 * ld_ + (size_t)(g * 256 + (row & 255)) * ld_ + (row >> 8) * S_ + col) = pk8(a, b);
        }
    }
};
struct SchedC2 {
    const gbf* P; const gbf* WukvT; const gbf* WuqT; const gbf* DC; int nq_tiles, n3, G, c;
    const gbf* U; const gbf* WinT; int n4;
    __device__ __forceinline__ bool next(int i, fg::UnitM& u) const {
        const int n0 = (NROW / 256) * 8, n1 = nq_tiles * 6, n2 = 16 * 2 * 8;
        int L;
        if (n4 == 0) L = i * G + c;
        else if (c < n4) {
            if (i == 0) { fg::Unit t; fg::SchedIn0 S0{U, WinT, 256, c, 11, 12}; (void)S0.next(0, t);
                u.job = 4; u.pm = t.pm; u.pn = t.pn; u.z = 0; u.lda = KP2; u.ldb = KP2; u.nt = DM / 64; u.A = t.A; u.B = t.B; return true; }
            if (i > 1) return false;
            L = c;
        } else { L = n4 + i * (G - n4) + (c - n4); }
        if (L < n0) { u.job = 0; u.pm = L >> 3; u.pn = L & 7; u.z = 0; u.lda = PP; u.ldb = 256; u.nt = 4;
            u.A = (const GAS char*)(P + (size_t)u.pm * 256 * PP + C_CKV); u.B = (const GAS char*)(WukvT + (size_t)u.pn * 256 * 256); return true; }
        L -= n0;
        if (L < n1) { u.job = 1; u.pm = L / 6; u.pn = L % 6; u.z = 0; u.lda = PP; u.ldb = 512; u.nt = 8;
            u.A = (const GAS char*)(P + (size_t)u.pm * 256 * PP + C_QL); u.B = (const GAS char*)(WuqT + (size_t)u.pn * 256 * 512); return true; }
        L -= n1;
        if (L < n2) { u.job = 2; u.z = L >> 4; u.pm = (L >> 3) & 1; u.pn = L & 7; u.lda = 256; u.ldb = PP; u.nt = 4;
            u.A = (const GAS char*)(DC + (size_t)u.pm * 256 * 256); u.B = (const GAS char*)(P + ((size_t)(u.z >> 2) * SEQ + (size_t)u.pn * 256) * PP + C_FV + (u.z & 3) * 256); return true; }
        L -= n2;
        if (L < n3) { u.job = 3; u.z = L >> 1; u.pm = L & 1; u.pn = 0; u.lda = 256; u.ldb = PP; u.nt = 4;
            u.A = (const GAS char*)(DC + (size_t)u.pm * 256 * 256); u.B = (const GAS char*)(P + ((size_t)NLAT + (size_t)(u.z >> 2) * CTXL) * PP + C_FV + (u.z & 3) * 256); return true; }
        return false;
    }
};

struct TrItem { const gf32* W; gbf* WT; const gf32* ks; int N, ldt, k0, n0, nd0; };
constexpr int TR_IN = 32 * 634, TR_KV = 4 * 64, TR_Q = 8 * 48, TR_P = 16 * 64, TR_O = 32 * 64;
constexpr int TR_PER_L = TR_IN + TR_KV + TR_Q + 4 * TR_P + TR_O;
constexpr int TR_X0 = TR_IN + TR_KV + TR_Q;
__device__ __forceinline__ TrItem tr_decode(int it) {
    gu8* ws = wsb();
    const int l = it / TR_PER_L; int r = it % TR_PER_L;
    const gf32* W; gbf* WT; const gf32* ks = nullptr; int K, N, ldt; bool remap = false;
    if (r < TR_IN) { W = pin(I_WIN) + (size_t)l * DM * N_IN; K = DM; N = N_IN; WT = (gbf*)(ws + WS_WIN) + (size_t)l * NP * KP2; ldt = KP2; remap = true; }
    else if ((r -= TR_IN) < TR_KV) { W = pin(I_WUKV) + (size_t)l * 256 * 2048; K = 256; N = 2048; WT = (gbf*)(ws + WS_WUKV) + (size_t)l * 2048 * 256; ldt = 256; ks = pin(I_GKV) + l * 256; }
    else if ((r -= TR_KV) < TR_Q) { W = pin(I_WUQ) + (size_t)l * 512 * 1536; K = 512; N = 1536; WT = (gbf*)(ws + WS_WUQ) + (size_t)l * 1536 * 512; ldt = 512; ks = pin(I_GQ) + l * 512; }
    else if ((r -= TR_Q) < 4 * TR_P) { const int b = r / TR_P; r = r % TR_P; W = pin(I_WPC + b) + (size_t)l * 1024 * 2048; K = 1024; N = 2048; WT = (gbf*)(ws + WS_WP) + ((size_t)l * 4 + b) * 2048 * KP1; ldt = KP1; }
    else { r -= 4 * TR_P; W = pin(I_WOUT) + (size_t)l * 2048 * 2048; K = 2048; N = 2048; WT = (gbf*)(ws + WS_WO) + (size_t)l * 2048 * KP2; ldt = KP2; }
    (void)K;
    const int nblk = N / 32, kb = r / nblk, nb = r % nblk, n0 = 32 * nb;
    return TrItem{W, WT, ks, N, ldt, 64 * kb, n0, (remap && n0 >= 320) ? n0 + 192 : n0};
}
__device__ __forceinline__ void tr_load(const TrItem& t, float (&v)[32], int lane) {
    const gf32* src = t.W + (size_t)(t.k0 + (lane >> 5)) * t.N + t.n0 + (lane & 31);
#pragma unroll
    for (int i = 0; i < 32; ++i) v[i] = __builtin_nontemporal_load(src + (size_t)(2 * i) * t.N);
}
__device__ __forceinline__ void tr_to_lds(const TrItem& t, const float (&v)[32], int lane, float* scr) {
    if (t.ks != nullptr) {
#pragma unroll
        for (int i = 0; i < 32; ++i) { const int kk = 2 * i + (lane >> 5); scr[kk * 33 + (lane & 31)] = v[i] * t.ks[t.k0 + kk]; }
    } else {
#pragma unroll
        for (int i = 0; i < 32; ++i) { const int kk = 2 * i + (lane >> 5); scr[kk * 33 + (lane & 31)] = v[i]; }
    }
    __builtin_amdgcn_fence(__ATOMIC_RELEASE, "wavefront"); asm volatile("s_waitcnt lgkmcnt(0)" ::: "memory");
}
template <bool NT_ST> __device__ __forceinline__ void tr_store(const TrItem& t, int lane, const float* scr) {
    const int c = lane & 7;
#pragma unroll
    for (int j = 0; j < 4; ++j) { const int n = (lane >> 3) + 8 * j; const float* s = scr + (8 * c) * 33 + n;
        u32x4 o; o.x = pk2(s[0 * 33], s[1 * 33]); o.y = pk2(s[2 * 33], s[3 * 33]); o.z = pk2(s[4 * 33], s[5 * 33]); o.w = pk2(s[6 * 33], s[7 * 33]);
        if constexpr (NT_ST) __builtin_nontemporal_store(o, (GAS u32x4*)(t.WT + (size_t)(t.nd0 + n) * t.ldt + t.k0 + 8 * c)); else *(GAS u32x4*)(t.WT + (size_t)(t.nd0 + n) * t.ldt + t.k0 + 8 * c) = o; }
    asm volatile("s_waitcnt lgkmcnt(0)" ::: "memory");
}
template <bool NT_ST = true> __device__ __forceinline__ void weight_transposes(unsigned char* lds, int beg, int end, int gw, int ngw) {
    const int tid = tid_op(), lane = tid & 63, wid = tid >> 6;
    float* scr = (float*)lds + wid * (64 * 33);
    int it = beg + gw;
    if (it >= end) return;
    float v[32];
    TrItem cur = tr_decode(it);
    tr_load(cur, v, lane);
    while (true) {
        tr_to_lds(cur, v, lane, scr);
        const int nit = it + ngw; const bool more = nit < end;
        TrItem nx = cur;
        if (more) { nx = tr_decode(nit); tr_load(nx, v, lane); }
        tr_store<NT_ST>(cur, lane, scr);
        if (!more) break;
        cur = nx; it = nit;
    }
}

__device__ __forceinline__ void phase0(const Params& p, unsigned char* lds, int gid, int G) {
    const int tid = tid_op(), lane = tid & 63, wid = tid >> 6;
    gu8* ws = wsb();
    {
        float* sv = (float*)lds;
        float* part = sv + 5 * 2048;
        bool have = false;
        for (int it = gid; it < 2 * 96; it += G) {
            if (!have) {
                for (int i = tid; i < 5 * 2048; i += NTHREADS) { const float v = (i < 4 * 2048) ? pin(I_C)[i] : pin(I_CCTX)[i - 4 * 2048]; sv[i] = siluf_(v); }
                have = true;
            }
            __syncthreads();
            const int l = it / 96, nb = it % 96;
            const gf32* W = pin(I_WADA) + (size_t)l * DM * 6144 + nb * 64 + lane;
            float a0 = 0.f, a1 = 0.f, a2 = 0.f, a3 = 0.f, a4 = 0.f;
#pragma unroll 8
            for (int k = wid * 256; k < wid * 256 + 256; ++k) {
                const float w = __builtin_nontemporal_load(W + (size_t)k * 6144);
                a0 = fmaf(sv[k], w, a0); a1 = fmaf(sv[2048 + k], w, a1); a2 = fmaf(sv[4096 + k], w, a2); a3 = fmaf(sv[6144 + k], w, a3); a4 = fmaf(sv[8192 + k], w, a4);
            }
            part[(wid * 5 + 0) * 64 + lane] = a0; part[(wid * 5 + 1) * 64 + lane] = a1; part[(wid * 5 + 2) * 64 + lane] = a2; part[(wid * 5 + 3) * 64 + lane] = a3; part[(wid * 5 + 4) * 64 + lane] = a4;
            __syncthreads();
            if (tid < 320) {
                const int r = tid / 64, cidx = tid % 64; float s = 0.f;
#pragma unroll
                for (int w = 0; w < 8; ++w) s += part[(w * 5 + r) * 64 + cidx];
                const int n = nb * 64 + cidx;
                ((gf32*)(ws + WS_MOD))[((size_t)l * 5 + r) * 6144 + n] = s + pin(I_BADA)[(size_t)l * 6144 + n];
            }
        }
        __syncthreads();
    }
    {
        const long gt = (long)gid * NTHREADS + tid, NT = (long)G * NTHREADS;
        gf32* rope = (gf32*)(ws + WS_ROPE);
        for (long i = gt; i < 64 * 16; i += NT) { const int pos = (int)(i >> 4), f = (int)(i & 15); const float inv = exp2f(-(float)f * (13.287712379549449f / 16.0f)); const float ang = (float)pos * inv;
            rope[2 * i] = cosf(ang); rope[2 * i + 1] = sinf(ang); }
        gbf* DC = (gbf*)(ws + WS_DC);
        for (long i = gt; i < 512 * 256; i += NT) { const int m = (int)(i >> 8), k = (int)(i & 255); const int jdx = ((m & 255) * k) & 255; const float ang = (float)jdx * (6.283185307179586f / 256.0f);
            DC[i] = (bf16_t)f2bf((m < 256 ? cosf(ang) : sinf(ang)) * 0.0625f); }
        gbf* DN = (gbf*)(ws + WS_DN);
        for (long i = gt; i < (long)2048 * 4096; i += NT) { const int n = (int)(i >> 12), k = (int)(i & 4095); const int jdx = (n * (k & 2047)) & 2047; const float ang = (float)jdx * (6.283185307179586f / 2048.0f);
            DN[(size_t)n * KP4 + k] = (bf16_t)f2bf((k < 2048 ? cosf(ang) : -sinf(ang)) * 0.02209708691207961f); }
        gbf* DNC = (gbf*)(ws + WS_DNC);
        for (long i = gt; i < 256 * 512; i += NT) { const int n = (int)(i >> 9), k = (int)(i & 511); const int jdx = (n * (k & 255)) & 255; const float ang = (float)jdx * (6.283185307179586f / 256.0f);
            DNC[i] = (bf16_t)f2bf((k < 256 ? cosf(ang) : -sinf(ang)) * 0.0625f); }
        for (long i = gt; i < (long)2 * 192 * DM / 8; i += NT) { const int l = (int)(i / (192 * DM / 8)); const long r = i % (192 * DM / 8);
            *(GAS u32x4*)((gbf*)(ws + WS_WIN) + (size_t)l * NP * KP2 + (size_t)(320 + r / (DM / 8)) * KP2 + (r % (DM / 8)) * 8) = (u32x4){0u, 0u, 0u, 0u}; }
    }
    weight_transposes<false>(lds, 0, (G == 256) ? TR_X0 : 2 * TR_PER_L, gid * NWAVES + wid, G * NWAVES);
}

__device__ __forceinline__ void u_row(const f32x4 (&v)[8], float rstd, const gf32* gpre, const gf32* mod  , gbf* urow, int lane) {
#pragma unroll
    for (int j = 0; j < 8; ++j) { const int c = 4 * lane + 256 * j;
        const f32x4 g = *(const GAS f32x4*)(gpre + c), sh = *(const GAS f32x4*)(mod + c), sc = *(const GAS f32x4*)(mod + 2048 + c);
        const f32x4 o = v[j] * rstd * g * (sc + 1.0f) + sh;
        *(GAS u32x2*)(urow + c) = pk4(o); }
}
__device__ __forceinline__ void phase_uprep0(const Params& p, int gid, int G) {
    const int tid = tid_op(), lane = tid & 63, gw = gid * NWAVES + (tid >> 6), NGW = G * NWAVES;
    const gf32* mod0 = (const gf32*)(wsb() + WS_MOD);
    gbf* U = (gbf*)(wsb() + WS_U);
    for (int r = gw; r < NROW; r += NGW) {
        const gf32* xr = (r < NLAT) ? pin(I_X) + (size_t)r * DM : pin(I_CTX) + (size_t)(r - NLAT) * DM;
        const int mr = (r < NLAT) ? (r >> 11) : 4;
        f32x4 v[8]; float s = 0.f;
#pragma unroll
        for (int j = 0; j < 8; ++j) { v[j] = __builtin_nontemporal_load((const GAS f32x4*)(xr + 4 * lane + 256 * j)); s += v[j][0] * v[j][0] + v[j][1] * v[j][1] + v[j][2] * v[j][2] + v[j][3] * v[j][3]; }
        const float rstd = rsqrtf(wave_sum(s) * (1.0f / DM) + EPS);
        u_row(v, rstd, pin(I_GPRE), mod0 + (size_t)mr * 6144, U + (size_t)r * KP2, lane);
    }
}
__device__ __forceinline__ void phase_final(const Params& p, int l, int rbeg, int rend, int cu, int ncu) {
    const int tid = tid_op(), lane = tid & 63, gw = rbeg + cu * NWAVES + (tid >> 6), NGW = ncu * NWAVES;
    const gf32* mod = (const gf32*)(wsb() + WS_MOD) + (size_t)l * 5 * 6144;
    const gf32* Y = (const gf32*)(wsb() + WS_Y);
    gf32* XL = (gf32*)(wsb() + WS_XL);
    gbf* U = (gbf*)(wsb() + WS_U);
    const int nrows = rend;
    auto xrow = [&](int r) -> const gf32* { return (l == 0) ? ((r < NLAT) ? pin(I_X) + (size_t)r * DM : pin(I_CTX) + (size_t)(r - NLAT) * DM) : XL + (size_t)r * DM; };
    f32x4 y[8], x[8], yn[8], xn[8];
    if (gw < nrows) { const gf32* yr = Y + (size_t)gw * DM; const gf32* xr = xrow(gw);
#pragma unroll
        for (int j = 0; j < 8; ++j) { y[j] = *(const GAS f32x4*)(yr + 4 * lane + 256 * j); x[j] = *(const GAS f32x4*)(xr + 4 * lane + 256 * j); } }
    for (int r = gw; r < nrows; r += NGW) {
        const int rn = r + NGW;
        if (rn < nrows) { const gf32* yr = Y + (size_t)rn * DM; const gf32* xr = xrow(rn);
#pragma unroll
            for (int j = 0; j < 8; ++j) { yn[j] = *(const GAS f32x4*)(yr + 4 * lane + 256 * j); xn[j] = *(const GAS f32x4*)(xr + 4 * lane + 256 * j); } }
        const int mr = (r < NLAT) ? (r >> 11) : 4;
        gf32* orow = (l == 0) ? XL + (size_t)r * DM : pout() + (size_t)r * DM;
        float s = 0.f;
#pragma unroll
        for (int j = 0; j < 8; ++j) s += y[j][0] * y[j][0] + y[j][1] * y[j][1] + y[j][2] * y[j][2] + y[j][3] * y[j][3];
        const float rstd = rsqrtf(wave_sum(s) * (1.0f / DM) + EPS);
        float s2 = 0.f;
#pragma unroll
        for (int j = 0; j < 8; ++j) { const int c = 4 * lane + 256 * j;
            const f32x4 g = *(const GAS f32x4*)(pin(I_GPOST) + (size_t)l * DM + c), gt = *(const GAS f32x4*)(mod + (size_t)mr * 6144 + 4096 + c);
            const f32x4 o = x[j] + gt * (y[j] * rstd * g);
            *(GAS f32x4*)(orow + c) = o; y[j] = o; s2 += o[0] * o[0] + o[1] * o[1] + o[2] * o[2] + o[3] * o[3]; }
        if (l == 0) {
            const float rstd2 = rsqrtf(wave_sum(s2) * (1.0f / DM) + EPS);
            u_row(y, rstd2, pin(I_GPRE) + DM, mod + 5 * 6144 + (size_t)mr * 6144, U + (size_t)r * KP2, lane);
        }
#pragma unroll
        for (int j = 0; j < 8; ++j) { y[j] = yn[j]; x[j] = xn[j]; }
    }
}
__device__ __forceinline__ void c1_loadz(const gbf* pr, bool ok, int lane, f32x4 (&z)[4]) {
#pragma unroll
    for (int j = 0; j < 4; ++j) { const int c = 4 * lane + 256 * j;
        if (ok) z[j] = unpk4(*(const GAS u32x2*)(pr + C_CC + c)) * unpk4(*(const GAS u32x2*)(pr + C_CX + c)); else z[j] = (f32x4){0.f, 0.f, 0.f, 0.f}; }
}
__device__ __forceinline__ void phase_c1(const Params& p, int l, int nrows, int gid, int G) {
    const int tid = tid_op(), lane = tid & 63, gw = gid * NWAVES + (tid >> 6), NGW = G * NWAVES;
    const gbf* P = (const gbf*)(wsb() + WS_P);
    gbf* KM = (gbf*)(wsb() + WS_KM); gbf* AB = (gbf*)(wsb() + WS_AB);
    gf32* RKV = (gf32*)(wsb() + WS_RKV); gf32* RQ = (gf32*)(wsb() + WS_RQ);
    const gf32* rope = (const gf32*)(wsb() + WS_ROPE);
    const gf32* cw = pin(I_CONVW) + (size_t)l * 3 * 1024;
    const int chunk = (nrows + NGW - 1) / NGW, rbeg = gw * chunk, rend = min(rbeg + chunk, nrows);
    if (rbeg >= rend) return;
    f32x4 w0[4], w1[4], w2[4];
#pragma unroll
    for (int j = 0; j < 4; ++j) { const int c = 4 * lane + 256 * j; w0[j] = *(const GAS f32x4*)(cw + c); w1[j] = *(const GAS f32x4*)(cw + 1024 + c); w2[j] = *(const GAS f32x4*)(cw + 2048 + c); }
    auto seqpos = [](int r, int& t, int& slen) { if (r < NLAT) { t = r & (SEQ - 1); slen = SEQ; } else { t = (r - NLAT) & (CTXL - 1); slen = CTXL; } };
    struct RowIn { u32x2 ckv, q0, q1, cb[4], gc[4], zc_[4], zx_[4]; unsigned short x; float rc, rsn; };
    auto ldrow = [&](int r, RowIn& R) {
        const gbf* pr = P + (size_t)r * PP;
        const bool full = (r < NLAT) || (l == 0);
        const bool okn = (r + 1 < NROW) && ((r + 1 < NLAT) || (l == 0));
#pragma unroll
        for (int j = 0; j < 4; ++j) { const int c = 4 * lane + 256 * j;
            if (okn) { R.zc_[j] = *(const GAS u32x2*)(pr + PP + C_CC + c); R.zx_[j] = *(const GAS u32x2*)(pr + PP + C_CX + c); } else { R.zc_[j] = (u32x2){0u, 0u}; R.zx_[j] = (u32x2){0u, 0u}; } }
        R.ckv = *(const GAS u32x2*)(pr + C_CKV + 4 * lane);
        R.q0 = (u32x2){0u, 0u}; R.q1 = (u32x2){0u, 0u};
        if (full) { R.q0 = *(const GAS u32x2*)(pr + C_QL + 4 * lane); R.q1 = *(const GAS u32x2*)(pr + C_QL + 256 + 4 * lane);
#pragma unroll
            for (int j = 0; j < 4; ++j) { const int c = 4 * lane + 256 * j; R.cb[j] = *(const GAS u32x2*)(pr + C_CB + c); R.gc[j] = *(const GAS u32x2*)(pr + C_GCV + c); } }
        else {
#pragma unroll
            for (int j = 0; j < 4; ++j) { R.cb[j] = (u32x2){0u, 0u}; R.gc[j] = (u32x2){0u, 0u}; } }
        R.x = pr[C_KR + lane];
        R.rc = 1.f; R.rsn = 0.f;
        if (r < NLAT) { const int tt = r & (SEQ - 1), pos = (lane < 32) ? (tt >> 6) : (tt & 63), f = lane & 15; R.rc = rope[(pos * 16 + f) * 2]; R.rsn = rope[(pos * 16 + f) * 2 + 1]; }
    };
    f32x4 zp[4], zc[4];
    { int t, slen; seqpos(rbeg, t, slen); const bool full0 = (rbeg < NLAT) || (l == 0);
      c1_loadz(P + (size_t)(rbeg - 1) * PP, full0 && t > 0, lane, zp); c1_loadz(P + (size_t)rbeg * PP, full0, lane, zc); (void)slen; }
    RowIn cur, nx;
    ldrow(rbeg, cur);
    for (int r = rbeg; r < rend; ++r) {
        const bool full = (r < NLAT) || (l == 0);
        int t, slen; seqpos(r, t, slen);
        if (r + 1 < rend) ldrow(r + 1, nx); else nx = cur;
        asm volatile("" ::: "memory");
        const float mp = (t > 0) ? 1.f : 0.f, mn = (t < slen - 1) ? 1.f : 0.f;
        { const f32x4 v = unpk4(cur.ckv); const float s = wave_sum(v[0] * v[0] + v[1] * v[1] + v[2] * v[2] + v[3] * v[3]);
          if (lane == 0) RKV[r] = rsqrtf(s * (1.0f / 256.0f) + EPS); }
        if (full) { const f32x4 v0 = unpk4(cur.q0), v1 = unpk4(cur.q1);
          const float s = wave_sum(v0[0] * v0[0] + v0[1] * v0[1] + v0[2] * v0[2] + v0[3] * v0[3] + v1[0] * v1[0] + v1[1] * v1[1] + v1[2] * v1[2] + v1[3] * v1[3]);
          if (lane == 0) RQ[r] = rsqrtf(s * (1.0f / 512.0f) + EPS); }
        {
          float x = bf2f(cur.x);
          const float y = __shfl_xor(x, 16);
          x = (lane & 16) ? (y * cur.rsn + x * cur.rc) : (x * cur.rc - y * cur.rsn);
          const bf16_t o = (bf16_t)f2bf(x);
#pragma unroll
          for (int h = 0; h < 8; ++h) KM[hm_row(r, h, 8) * 192 + 128 + lane] = o; }
        f32x4 zn[4];
#pragma unroll
        for (int j = 0; j < 4; ++j) zn[j] = unpk4(cur.zc_[j]) * unpk4(cur.zx_[j]);
        if (full) {
#pragma unroll
          for (int j = 0; j < 4; ++j) { const int c = 4 * lane + 256 * j;
              const f32x4 o = (zp[j] * (w0[j] * mp) + zc[j] * w1[j] + zn[j] * (w2[j] * mn)) * unpk4(cur.cb[j]) * unpk4(cur.gc[j]);
              *(GAS u32x2*)(AB + (size_t)r * ABW + c) = pk4(o); } }
#pragma unroll
        for (int j = 0; j < 4; ++j) { zp[j] = zc[j]; zc[j] = zn[j]; }
        cur = nx;
    }
}

namespace fa {
typedef float f32x16 __attribute__((ext_vector_type(16)));
typedef short s16x4 __attribute__((ext_vector_type(4)));
constexpr float THRL = 8.0f;
__device__ __forceinline__ int crow(int r, int hi) { return (r & 3) + 8 * (r >> 2) + 4 * hi; }
__device__ __forceinline__ unsigned cvtpk(float lo, float hi) { unsigned r; asm volatile("v_cvt_pk_bf16_f32 %0, %1, %2" : "=v"(r) : "v"(lo), "v"(hi)); return r; }
template <int OFF> __device__ __forceinline__ s16x4 tr_read(int vb) { s16x4 r; asm volatile("ds_read_b64_tr_b16 %0, %1 offset:%2" : "=&v"(r) : "v"(vb), "i"(OFF) : "memory"); return r; }
__device__ __forceinline__ int v_rd_base(int lane) { return ((lane & 3) << 3) | (((lane >> 2) & 3) << 6) | (((lane >> 4) & 1) << 5) | (((lane >> 5) & 1) << 8); }
template <int NCB, int D0> __device__ __forceinline__ void pv_one(f32x16& od, int vb, bf16x8 pa0, bf16x8 pa1, bf16x8 pa2, bf16x8 pa3) {
    constexpr int KS = 2 * NCB * 512, HF = NCB * 512, B = D0 * 512;
    const s16x4 l0 = tr_read<B + 0 * KS>(vb), h0 = tr_read<B + 0 * KS + HF>(vb), l1 = tr_read<B + 1 * KS>(vb), h1 = tr_read<B + 1 * KS + HF>(vb);
    const s16x4 l2 = tr_read<B + 2 * KS>(vb), h2 = tr_read<B + 2 * KS + HF>(vb), l3 = tr_read<B + 3 * KS>(vb), h3 = tr_read<B + 3 * KS + HF>(vb);
    asm volatile("s_waitcnt lgkmcnt(0)" ::: "memory"); __builtin_amdgcn_sched_barrier(0);
#define FA_PK(L, H) (bf16x8){L[0], L[1], L[2], L[3], H[0], H[1], H[2], H[3]}
    od = __builtin_amdgcn_mfma_f32_32x32x16_bf16(pa0, FA_PK(l0, h0), od, 0, 0, 0);
    od = __builtin_amdgcn_mfma_f32_32x32x16_bf16(pa1, FA_PK(l1, h1), od, 0, 0, 0);
    od = __builtin_amdgcn_mfma_f32_32x32x16_bf16(pa2, FA_PK(l2, h2), od, 0, 0, 0);
    od = __builtin_amdgcn_mfma_f32_32x32x16_bf16(pa3, FA_PK(l3, h3), od, 0, 0, 0);
#undef FA_PK
}
template <int NCB, int D0> __device__ __forceinline__ void pv_reads(s16x4 (&v)[8], int vb) {
    constexpr int KS = 2 * NCB * 512, HF = NCB * 512, B = D0 * 512;
    v[0] = tr_read<B + 0 * KS>(vb); v[1] = tr_read<B + 0 * KS + HF>(vb); v[2] = tr_read<B + 1 * KS>(vb); v[3] = tr_read<B + 1 * KS + HF>(vb);
    v[4] = tr_read<B + 2 * KS>(vb); v[5] = tr_read<B + 2 * KS + HF>(vb); v[6] = tr_read<B + 3 * KS>(vb); v[7] = tr_read<B + 3 * KS + HF>(vb);
}
__device__ __forceinline__ void pv_mma(f32x16& od, const s16x4 (&v)[8], bf16x8 pa0, bf16x8 pa1, bf16x8 pa2, bf16x8 pa3) {
#define FA_PK(L, H) (bf16x8){L[0], L[1], L[2], L[3], H[0], H[1], H[2], H[3]}
    od = __builtin_amdgcn_mfma_f32_32x32x16_bf16(pa0, FA_PK(v[0], v[1]), od, 0, 0, 0);
    od = __builtin_amdgcn_mfma_f32_32x32x16_bf16(pa1, FA_PK(v[2], v[3]), od, 0, 0, 0);
    od = __builtin_amdgcn_mfma_f32_32x32x16_bf16(pa2, FA_PK(v[4], v[5]), od, 0, 0, 0);
    od = __builtin_amdgcn_mfma_f32_32x32x16_bf16(pa3, FA_PK(v[6], v[7]), od, 0, 0, 0);
#undef FA_PK
}
template <int NCB> __device__ __forceinline__ void pv_all(f32x16* o, int vb, bf16x8 pa0, bf16x8 pa1, bf16x8 pa2, bf16x8 pa3) {
    s16x4 va[8], vb2[8];
    pv_reads<NCB, 0>(va, vb);
    pv_reads<NCB, 1>(vb2, vb);
    asm volatile("s_waitcnt lgkmcnt(8)" ::: "memory"); __builtin_amdgcn_sched_barrier(0);
    pv_mma(o[0], va, pa0, pa1, pa2, pa3);
    if constexpr (NCB == 4) {
        pv_reads<NCB, 2>(va, vb);
        asm volatile("s_waitcnt lgkmcnt(8)" ::: "memory"); __builtin_amdgcn_sched_barrier(0);
        pv_mma(o[1], vb2, pa0, pa1, pa2, pa3);
        pv_reads<NCB, 3>(vb2, vb);
        asm volatile("s_waitcnt lgkmcnt(8)" ::: "memory"); __builtin_amdgcn_sched_barrier(0);
        pv_mma(o[2], va, pa0, pa1, pa2, pa3);
        asm volatile("s_waitcnt lgkmcnt(0)" ::: "memory"); __builtin_amdgcn_sched_barrier(0);
        pv_mma(o[3], vb2, pa0, pa1, pa2, pa3);
    } else {
        asm volatile("s_waitcnt lgkmcnt(0)" ::: "memory"); __builtin_amdgcn_sched_barrier(0);
        pv_mma(o[1], vb2, pa0, pa1, pa2, pa3);
    }
}
struct Desc {
    const gbf* Q; int ldq;
    const gbf* K; int ldk;
    const gbf* V; int ldv;
    int row0a, nta, row0b, NT;
    const gbf* G; int ldg;
    gbf* O; int ldo;
    int r0, wr0; const gf32* rpb;
    int hsa, hsb;
};
template <int N> __device__ __forceinline__ void wait_bar() {
    if constexpr (N == 0) asm volatile("s_waitcnt vmcnt(0) lgkmcnt(0)\n\ts_barrier" ::: "memory");
    else if constexpr (N == 2) asm volatile("s_waitcnt vmcnt(2) lgkmcnt(0)\n\ts_barrier" ::: "memory");
    else if constexpr (N == 5) asm volatile("s_waitcnt vmcnt(5) lgkmcnt(0)\n\ts_barrier" ::: "memory");
    else static_assert(N == 0, "wait_bar count");
}
template <int N> __device__ __forceinline__ void wait_bar2() {
    if constexpr (N == 0) asm volatile("s_waitcnt vmcnt(0) lgkmcnt(0)\n\ts_barrier" ::: "memory");
    else if constexpr (N == 1) asm volatile("s_waitcnt vmcnt(1) lgkmcnt(0)\n\ts_barrier" ::: "memory");
    else if constexpr (N == 2) asm volatile("s_waitcnt vmcnt(2) lgkmcnt(0)\n\ts_barrier" ::: "memory");
    else if constexpr (N == 5) asm volatile("s_waitcnt vmcnt(5) lgkmcnt(0)\n\ts_barrier" ::: "memory");
    else static_assert(N == 0, "wait_bar2 count");
}
template <int MODE, unsigned L0 = 0xFFFFu, unsigned L1 = 0xFFFFu> __device__ __forceinline__ void partial_sm(f32x16& p0, f32x16& p1, float& m_reg, float& alpha) {
    if constexpr (MODE == 1) {
#pragma unroll
        for (int r = 0; r < 16; ++r) { p0[r] *= NASCALE; p1[r] *= NASCALE; }
    }
    float pmax = -3.0e38f;
#pragma unroll
    for (int r = 0; r < 16; ++r) if ((L0 >> r) & 1u) pmax = fmaxf(pmax, p0[r]);
#pragma unroll
    for (int r = 0; r < 16; ++r) if ((L1 >> r) & 1u) pmax = fmaxf(pmax, p1[r]);
    { auto rr = __builtin_amdgcn_permlane32_swap(__float_as_uint(pmax), __float_as_uint(pmax), false, false); pmax = fmaxf(__uint_as_float(rr[0]), __uint_as_float(rr[1])); }
    if (__builtin_expect(__all(pmax - m_reg <= THRL), 1)) alpha = 1.f;
    else { const float mn = fmaxf(m_reg, pmax); alpha = __builtin_amdgcn_exp2f(m_reg - mn); m_reg = mn; }
#pragma unroll
    for (int r = 0; r < 16; ++r) { if ((L0 >> r) & 1u) p0[r] = __builtin_amdgcn_exp2f(p0[r] - m_reg); else p0[r] = 0.f; if ((L1 >> r) & 1u) p1[r] -= m_reg; }
}
template <unsigned L0 = 0xFFFFu, unsigned L1 = 0xFFFFu>
__device__ __forceinline__ void finish_sm(f32x16& p0, f32x16& p1, float alpha, float& l_reg, bf16x8& pa0, bf16x8& pa1, bf16x8& pa2, bf16x8& pa3) {
#pragma unroll
    for (int r = 0; r < 16; ++r) { if ((L1 >> r) & 1u) p1[r] = __builtin_amdgcn_exp2f(p1[r]); else p1[r] = 0.f; }
    float ps = 0.f;
#pragma unroll
    for (int r = 0; r < 16; ++r) if ((L0 >> r) & 1u) ps += p0[r];
#pragma unroll
    for (int r = 0; r < 16; ++r) if ((L1 >> r) & 1u) ps += p1[r];
    { auto rr = __builtin_amdgcn_permlane32_swap(__float_as_uint(ps), __float_as_uint(ps), false, false); ps = __uint_as_float(rr[0]) + __uint_as_float(rr[1]); }
    l_reg = l_reg * alpha + ps;
#define FA_PK4(P, BASE, OUT) do { unsigned a0 = cvtpk(P[BASE + 0], P[BASE + 1]), a1 = cvtpk(P[BASE + 2], P[BASE + 3]); \
    unsigned b0_ = cvtpk(P[BASE + 4], P[BASE + 5]), b1_ = cvtpk(P[BASE + 6], P[BASE + 7]); \
    auto r0_ = __builtin_amdgcn_permlane32_swap(a0, b0_, false, false); auto r1_ = __builtin_amdgcn_permlane32_swap(a1, b1_, false, false); \
    u32x4 w_ = {r0_[0], r1_[0], r0_[1], r1_[1]}; OUT = __builtin_bit_cast(bf16x8, w_); } while (0)
    FA_PK4(p0, 0, pa0); FA_PK4(p0, 8, pa1); FA_PK4(p1, 0, pa2); FA_PK4(p1, 8, pa3);
#undef FA_PK4
}
template <unsigned L0, unsigned L1> __device__ __forceinline__ void bias_win(f32x16& p0, f32x16& p1, const LAS float* brow, int cs, int hi) {
#pragma unroll
    for (int r = 0; r < 16; ++r) { const int kc = crow(r, hi);
        if ((L0 >> r) & 1u) p0[r] = ((unsigned)(kc - cs) < 16u) ? p0[r] + brow[kc] : -30000.f;
        if ((L1 >> r) & 1u) p1[r] = ((unsigned)(kc + 32 - cs) < 16u) ? p1[r] + brow[kc + 32] : -30000.f; }
}
template <int NK, int RB> __device__ __forceinline__ void qkt_pp(f32x16& P0, f32x16& P1, const LAS unsigned char* Ks, const bf16x8 (&qr)[NK], int r32, int hi, int ksw) {
    bf16x8 k0[3], k1[3];
    P0 = f32x16{}; P1 = f32x16{};
    const int kbase = (int)(unsigned)(size_t)Ks + r32 * RB;
#define QK_LD(dd) do { const int a_ = kbase + ((((2 * (dd)) + hi) ^ ksw) << 4); \
        asm volatile("ds_read_b128 %0, %1" : "=v"(k0[(dd) % 3]) : "v"(a_)); asm volatile("ds_read_b128 %0, %1 offset:%2" : "=v"(k1[(dd) % 3]) : "v"(a_), "n"(32 * RB)); } while (0)
    QK_LD(0); QK_LD(1);
#pragma unroll
    for (int d0 = 0; d0 < NK; ++d0) {
        if (d0 + 2 < NK) { QK_LD(d0 + 2); asm volatile("s_waitcnt lgkmcnt(4)" : "+v"(k0[d0 % 3]), "+v"(k1[d0 % 3])); }
        else if (d0 + 1 < NK) asm volatile("s_waitcnt lgkmcnt(2)" : "+v"(k0[d0 % 3]), "+v"(k1[d0 % 3]));
        else asm volatile("s_waitcnt lgkmcnt(0)" : "+v"(k0[d0 % 3]), "+v"(k1[d0 % 3]));
        P0 = __builtin_amdgcn_mfma_f32_32x32x16_bf16(k0[d0 % 3], qr[d0], P0, 0, 0, 0); P1 = __builtin_amdgcn_mfma_f32_32x32x16_bf16(k1[d0 % 3], qr[d0], P1, 0, 0, 0);
        __builtin_amdgcn_sched_barrier(0);
    }
#undef QK_LD
}
template <int N> __device__ __forceinline__ void wait_barn() { asm volatile("s_waitcnt vmcnt(%0) lgkmcnt(0)\n\ts_barrier" :: "n"(N) : "memory"); }
#ifndef PP_GSHIFT
#define PP_GSHIFT 2
#endif
template <int DQK, int DV, int MODE, int S, int NHU = 1, bool PP = false>
__device__ __forceinline__ void unit_pipe(LAS unsigned char* lds, const Desc& d) {
    constexpr int RB = DQK * 2, KB1 = 64 * RB, VB1 = 64 * DV * 2, KB = NHU * KB1, VB = NHU * VB1, SLOT = KB + VB, KP = KB / 8192, VP = VB / 8192, NCB = DV / 32, NK = DQK / 16, NPIECE = KP + VP;
    constexpr int DK = S - 1, DVV = S - 2, WSTEADY = DVV * NPIECE;
    static_assert(S >= 2 && WSTEADY < 64 && S * SLOT + 2048 + NHU * 1920 + 16 <= LDS_BYTES && (NHU == 1 || NHU == 4), "ring geometry");
    const int tid = tid_op(), wid = __builtin_amdgcn_readfirstlane(tid >> 6), lane = tid & 63, r32 = lane & 31, hi = lane >> 5;
    const int hl = (NHU > 1) ? (wid >> 1) : 0, wrow0 = (NHU > 1) ? (wid & 1) * 32 : wid * 32;
    LAS float* wsf = (LAS float*)(lds + S * SLOT) + wid * 64;
    LAS float* rpbs = (LAS float*)(lds + S * SLOT + 2048) + hl * 480;
    unsigned koff[KP], voff[VP], koffb[KP], voffb[VP];
#pragma unroll
    for (int i = 0; i < KP; ++i) { const int pp = (wid * KP + i) * 1024 + lane * 16, hh = pp / KB1, p = pp % KB1, row = p / RB, cs = (p % RB) >> 4, c = cs ^ ((row >> 1) & 7);
        koff[i] = (unsigned)((hh * d.hsa + row) * d.ldk + c * 8) * 2u; koffb[i] = (unsigned)(hh * (d.hsb - d.hsa) * d.ldk) * 2u; }
#pragma unroll
    for (int i = 0; i < VP; ++i) { const int pp = (wid * VP + i) * 1024 + lane * 16, hh = pp / VB1, p = pp % VB1, st = p >> 9, q = p & 511, kk = (st / NCB) * 8 + (q >> 6), c = (st % NCB) * 32 + ((q & 63) >> 1);
        const int k = (kk & ~0xC) | ((kk & 4) << 1) | ((kk & 8) >> 1); voff[i] = (unsigned)((hh * d.hsa + k) * d.ldv + c) * 2u; voffb[i] = (unsigned)(hh * (d.hsb - d.hsa) * d.ldv) * 2u; }
    int qr_row = 0, qc = 0, rs = 0, cs = 0;
    if constexpr (MODE == 2) {
        qr_row = d.r0 + ((NHU > 1) ? 0 : (wid >> 1)); qc = (wid & 1) * 32 + r32; rs = min(max(qr_row - 4, 0), 24); cs = min(max(qc - 8, 0), 48);
        for (int i = tid; i < NHU * 15 * 31; i += NTHREADS) ((LAS float*)(lds + S * SLOT + 2048))[(i / 465) * 480 + i % 465] = d.rpb[i] * LOG2E;
    }
#define FP_ACT(t) ((MODE != 2) || (t) >= d.nta || (d.wr0 + (t) >= rs && d.wr0 + (t) <= rs + 7))
#define FP_VAR(t) ((MODE == 2 && (t) < d.nta) ? 1 + (wid & 1) : 0)
#define FP_PSM(P0, P1, al, t, v) do { if ((v) == 0) partial_sm<MODE>(P0, P1, m_reg, al); \
        else { const LAS float* brow_ = rpbs + (d.wr0 + (t) - qr_row + 7) * 31 - qc + 15; \
               if ((v) == 1) { bias_win<0xFFFFu, 0x000Fu>(P0, P1, brow_, cs, hi); partial_sm<MODE, 0xFFFFu, 0x000Fu>(P0, P1, m_reg, al); } \
               else          { bias_win<0xF000u, 0xFFFFu>(P0, P1, brow_, cs, hi); partial_sm<MODE, 0xF000u, 0xFFFFu>(P0, P1, m_reg, al); } } } while (0)
#define FP_FSM(P0, P1, al, v) do { if ((v) == 0) finish_sm(P0, P1, al, l_reg, pa0, pa1, pa2, pa3); else if ((v) == 1) finish_sm<0xFFFFu, 0x000Fu>(P0, P1, al, l_reg, pa0, pa1, pa2, pa3); \
        else finish_sm<0xF000u, 0xFFFFu>(P0, P1, al, l_reg, pa0, pa1, pa2, pa3); } while (0)
#define FP_ROW(t) (((t) < d.nta) ? d.row0a + 64 * (t) : d.row0b + 64 * ((t) - d.nta))
#define FP_DMAK(t) do { const int t_ = (t); const GAS char* kb_ = (const GAS char*)(d.K + (size_t)FP_ROW(t_) * d.ldk); const int s_ = t_ % S; const unsigned sb_ = (t_ < d.nta) ? 0u : 1u; \
        _Pragma("unroll") for (int i_ = 0; i_ < KP; ++i_) __builtin_amdgcn_global_load_lds((const GAS unsigned*)(kb_ + (koff[i_] + sb_ * koffb[i_])), (LAS unsigned*)(lds + s_ * KB + (wid * KP + i_) * 1024), 16, 0, 0); } while (0)
#define FP_DMAV(t) do { const int t_ = (t); const GAS char* vb_ = (const GAS char*)(d.V + (size_t)FP_ROW(t_) * d.ldv); const int s_ = t_ % S; const unsigned sb_ = (t_ < d.nta) ? 0u : 1u; \
        _Pragma("unroll") for (int i_ = 0; i_ < VP; ++i_) __builtin_amdgcn_global_load_lds((const GAS unsigned*)(vb_ + (voff[i_] + sb_ * voffb[i_])), (LAS unsigned*)(lds + S * KB + s_ * VB + (wid * VP + i_) * 1024), 16, 0, 0); } while (0)
#pragma unroll
    for (int s = -DK; s < 0; ++s) { FP_DMAK(s + DK); if (s + DVV >= 0) FP_DMAV(s + DVV); }
    bf16x8 qr[NK];
    { const gbf* Qw = d.Q + (size_t)(hl * d.hsa + wrow0 + r32) * d.ldq + hi * 8;
#pragma unroll
      for (int d0 = 0; d0 < NK; ++d0) qr[d0] = *(const GAS bf16x8*)(Qw + d0 * 16); }
    float m_reg = -1e30f, l_reg = 0.f;
    f32x16 o[NCB];
#pragma unroll
    for (int i = 0; i < NCB; ++i) o[i] = f32x16{};
    const int vbase = (int)(unsigned)(size_t)(lds + S * KB + hl * VB1) + v_rd_base(lane);
    const int ksw = ((r32 >> 1) & 7);
    const int NT = d.NT;
#define FP_QKT(P0, P1, t) do { const LAS unsigned char* Ks_ = lds + ((t) % S) * KB + hl * KB1; P0 = f32x16{}; P1 = f32x16{}; \
        _Pragma("unroll") for (int d0 = 0; d0 < NK; ++d0) { const int cb_ = ((2 * d0 + hi) ^ ksw) << 4; \
            const bf16x8 b0_ = *(const LAS bf16x8*)(Ks_ + r32 * RB + cb_), b1_ = *(const LAS bf16x8*)(Ks_ + (32 + r32) * RB + cb_); \
            P0 = __builtin_amdgcn_mfma_f32_32x32x16_bf16(b0_, qr[d0], P0, 0, 0, 0); P1 = __builtin_amdgcn_mfma_f32_32x32x16_bf16(b1_, qr[d0], P1, 0, 0, 0); } } while (0)
#define FP_PV(t) do { const int vb_ = vbase + ((t) % S) * VB; pv_one<NCB, 0>(o[0], vb_, pa0, pa1, pa2, pa3); pv_one<NCB, 1>(o[1], vb_, pa0, pa1, pa2, pa3); \
        if constexpr (NCB == 4) { pv_one<NCB, 2>(o[2], vb_, pa0, pa1, pa2, pa3); pv_one<NCB, 3>(o[3], vb_, pa0, pa1, pa2, pa3); } } while (0)
#define FP_RESC(a) do { if (__any((a) < 1.f)) { if (hi == 0) wsf[r32] = (a); asm volatile("s_waitcnt lgkmcnt(0)" ::: "memory"); \
        _Pragma("unroll") for (int dd = 0; dd < NCB; ++dd) _Pragma("unroll") for (int r = 0; r < 16; ++r) o[dd][r] *= wsf[crow(r, hi)]; } } while (0)
#define FP_ENDWAIT(j) do { if ((j) + DK < NT) wait_barn<WSTEADY>(); else wait_barn<0>(); } while (0)
#define FP_STEP(C0, C1, alC, Pv0, Pv1, alP, j) do { \
        if ((j) + DK < NT) FP_DMAK((j) + DK); \
        if ((j) + DVV < NT) FP_DMAV((j) + DVV); \
        __builtin_amdgcn_sched_barrier(0); \
        const bool actC_ = FP_ACT(j); \
        if (actC_) { FP_QKT(C0, C1, j); } \
        FP_FSM(Pv0, Pv1, alP, varP); __builtin_amdgcn_sched_barrier(0); \
        if (actP) { FP_PV((j) - 1); } \
        const int varC_ = FP_VAR(j); \
        if (actC_) { FP_PSM(C0, C1, alC, j, varC_); FP_RESC(alC); } \
        else { _Pragma("unroll") for (int r = 0; r < 16; ++r) { C0[r] = 0.f; C1[r] = -30000.f; } alC = 1.f; }     \
        actP = actC_; varP = varC_; \
        FP_ENDWAIT(j); } while (0)
    bf16x8 pa0, pa1, pa2, pa3;
    if constexpr (PP) {
#define FP_BARPL() asm volatile("s_waitcnt lgkmcnt(0)\n\ts_barrier" ::: "memory")
    const int g = (wid >> PP_GSHIFT) & 1;
    f32x16 pC0, pC1; float alC = 1.f; bool actP = false; int varP = 0;
    wait_barn<WSTEADY>();
    if (g) { if (DK < NT) FP_DMAK(DK); if (DVV < NT) FP_DMAV(DVV); FP_BARPL(); }
    for (int j = 0; ; ++j) {
        const bool actC_ = (j < NT) && FP_ACT(j);
        __builtin_amdgcn_s_setprio(1);
        if (actC_) { qkt_pp<NK, RB>(pC0, pC1, lds + (j % S) * KB + hl * KB1, qr, r32, hi, ksw); }
        if (j > 0 && actP) { pv_all<NCB>(o, vbase + ((j - 1) % S) * VB, pa0, pa1, pa2, pa3); }
        __builtin_amdgcn_s_setprio(0);
        __builtin_amdgcn_sched_barrier(0);
        if (g) { FP_ENDWAIT(j); } else FP_BARPL();
        if (j == NT) break;
        if (g) { if (j + 1 + DK < NT) FP_DMAK(j + 1 + DK); if (j + 1 + DVV < NT) FP_DMAV(j + 1 + DVV); }
        else { if (j + DK < NT) FP_DMAK(j + DK); if (j + DVV < NT) FP_DMAV(j + DVV); }
        __builtin_amdgcn_sched_barrier(0);
        const int varC_ = FP_VAR(j);
        if (actC_) { FP_PSM(pC0, pC1, alC, j, varC_); FP_RESC(alC); FP_FSM(pC0, pC1, alC, varC_); }
        actP = actC_; varP = varC_; (void)varP;
        __builtin_amdgcn_sched_barrier(0);
        if (!g) { FP_ENDWAIT(j); } else FP_BARPL();
    }
    if (!g) FP_BARPL();
#undef FP_BARPL
    } else {
    f32x16 pA0, pA1, pB0, pB1; float alA = 1.f, alB = 1.f;
    wait_barn<WSTEADY>();
    if (DK < NT) FP_DMAK(DK);
    if (DVV < NT) FP_DMAV(DVV);
    bool actP = FP_ACT(0);
    int varP = FP_VAR(0);
    if (actP) { FP_QKT(pA0, pA1, 0); FP_PSM(pA0, pA1, alA, 0, varP); }
    else {
#pragma unroll
        for (int r = 0; r < 16; ++r) { pA0[r] = 0.f; pA1[r] = -30000.f; } }
    FP_ENDWAIT(0);
    for (int j = 1; j + 1 < NT; j += 2) {
        FP_STEP(pB0, pB1, alB, pA0, pA1, alA, j);
        FP_STEP(pA0, pA1, alA, pB0, pB1, alB, j + 1);
    }
    FP_STEP(pB0, pB1, alB, pA0, pA1, alA, NT - 1);
    FP_FSM(pB0, pB1, alB, varP); __builtin_amdgcn_sched_barrier(0);
    if (actP) { FP_PV(NT - 1); }
    }
    if (hi == 0) wsf[32 + r32] = l_reg;
    wait_barn<0>();
    {
        constexpr int RS = DV + 8, CPR = DV / 8, NCHL = 32 * CPR / 64;
        LAS bf16_t* st = (LAS bf16_t*)(lds + wid * (32 * RS * 2));
        const gbf* Gw = d.G + (size_t)wrow0 * d.ldg + hl * DV; gbf* Ow = d.O + (size_t)wrow0 * d.ldo + hl * DV;
        u32x4 gv[NCHL];
#pragma unroll
        for (int i = 0; i < NCHL; ++i) { const int idx = i * 64 + lane, row = idx / CPR, cc = idx % CPR; gv[i] = *(const GAS u32x4*)(Gw + (size_t)row * d.ldg + cc * 8); }
#pragma unroll
        for (int r = 0; r < 16; ++r) { const float rl = __builtin_amdgcn_rcpf(wsf[32 + crow(r, hi)]);
#pragma unroll
            for (int dd = 0; dd < NCB; ++dd) st[crow(r, hi) * RS + dd * 32 + r32] = (bf16_t)f2bf(o[dd][r] * rl); }
        asm volatile("s_waitcnt lgkmcnt(0)" ::: "memory");
#pragma unroll
        for (int i = 0; i < NCHL; ++i) { const int idx = i * 64 + lane, row = idx / CPR, cc = idx % CPR;
            f32x4 va, vb, ga, gb; unpk8(*(const LAS u32x4*)(st + row * RS + cc * 8), va, vb); unpk8(gv[i], ga, gb);
            *(GAS u32x4*)(Ow + (size_t)row * d.ldo + cc * 8) = pk8(va * ga, vb * gb); }
    }
    asm volatile("s_waitcnt lgkmcnt(0)\n\ts_barrier" ::: "memory");
#undef FP_ROW
#undef FP_ACT
#undef FP_VAR
#undef FP_PSM
#undef FP_FSM
#undef FP_DMAK
#undef FP_DMAV
#undef FP_QKT
#undef FP_PV
#undef FP_RESC
#undef FP_ENDWAIT
#undef FP_STEP
}
}

__device__ __forceinline__ void phase_attn_fast(const Params& p, int l, unsigned char* lds_, int gid, int G) {
    LAS unsigned char* lds = (LAS unsigned char*)lds_;
    gu8* ws = wsb();
    const gbf* P = (const gbf*)(ws + WS_P); const gbf* KM = (const gbf*)(ws + WS_KM); const gbf* VM = (const gbf*)(ws + WS_VM); const gbf* QM = (const gbf*)(ws + WS_QM);
    const gbf* NK = (const gbf*)(ws + WS_NK); const gbf* NV = (const gbf*)(ws + WS_NV); const gbf* NQ = (const gbf*)(ws + WS_NQ);
    gbf* AB = (gbf*)(ws + WS_AB);
    const gf32* rpb = pin(I_RPB) + (size_t)l * 16 * 15 * 31;
    const int vcu = (G % 8 == 0) ? (gid % 8) * (G / 8) + gid / 8 : gid;
    const bool split = (l == 0 && G == 256); const int a = gid - 32;
    __syncthreads();
    if (split && gid < 32) { weight_transposes(lds_, TR_X0, TR_PER_L + TR_X0, gid * NWAVES + (tid_op() >> 6), 32 * NWAVES); __syncthreads(); return; }
    if (l == 1 && G == 256 && gid >= 192) { weight_transposes(lds_, TR_PER_L + TR_X0, 2 * TR_PER_L, (gid - 192) * NWAVES + (tid_op() >> 6), 64 * NWAVES); __syncthreads(); }
    {
        const int tid = tid_op(), lane = tid & 63, off = split ? 32 : 0;
        const gbf* GT = (const gbf*)(ws + WS_GT);
        for (int t = (gid - off) * NWAVES + (tid >> 6); t < NB * 1024; t += (G - off) * NWAVES) {
            const int b = t >> 10, ch = t & 1023; const gbf* gr = GT + ((size_t)b * 1024 + ch) * KP4;
            float acc = 0.f;
#pragma unroll
            for (int jj = 0; jj < 4; ++jj) { f32x4 va, vb; unpk8(*(const GAS u32x4*)(gr + lane * 8 + 512 * jj), va, vb); acc += (va[0] - va[1]) + (va[2] - va[3]) + (vb[0] - vb[1]) + (vb[2] - vb[3]); }
            acc = wave_sum(acc) * 0.02209708691207961f;
            if (lane == 0) { const size_t r = (size_t)b * SEQ + SEQ / 2; const float g = bf2f(P[r * PP + C_GFN + ch]); AB[r * ABW + 3072 + ch] = (bf16_t)f2bf(acc * g); }
        }
    }
    const int m_first = split ? (a % 8) * 28 + a / 8 : vcu, m_step = split ? (a < 32 ? 224 + a - m_first : 256) : G;
    for (int rep = 0; rep < (PROBE_DUP == 50 ? 2 : 1); ++rep)
    for (int u = m_first; u < NB * 8 * 8; u += m_step) { const int b = u >> 6, h = (u >> 3) & 7, qb = u & 7; const size_t q0 = (size_t)b * SEQ + qb * 256;
        const int lat0 = (b * 8 + h) * SEQ, ctx0 = NB * 8 * SEQ + (b * 8 + h) * CTXL;
        fa::Desc d{QM + (size_t)(lat0 + qb * 256) * 192, 192, KM, 192, VM, 128, ctx0, 4, lat0, 36, P + q0 * PP + C_GML + h * 128, PP, AB + q0 * ABW + 1024 + h * 128, ABW, 0, 0, nullptr, 0, 0};
        fa::unit_pipe<192, 128, 0, 3, 1, true>(lds, d); }
    int na_b, na_e, na_st;
    if (G != 256) { na_b = gid; na_e = NB * 16 * 8; na_st = G; }
    else if (split) { na_b = (a >= 96) ? (a - 96) * 4 : 0; na_e = (a >= 96) ? na_b + 4 : 0; na_st = 1; }
    else { na_b = gid < 64 ? 0 : gid < 192 ? (gid - 64) * 3 : 384 + (gid - 192) * 2; na_e = gid < 64 ? 0 : gid < 192 ? na_b + 3 : na_b + 2; na_st = 1; }
    for (int rep = 0; rep < (PROBE_DUP == 51 ? 2 : 1); ++rep)
    for (int u = na_b; u < na_e; u += na_st) {
        const int b = u >> 7, h0 = ((u >> 5) & 3) * 4, r = u & 31, rs = min(max(r - 4, 0), 24); const size_t q0 = (size_t)b * SEQ + r * 64;
        const int lat0 = (b * 16 + h0) * SEQ, ctx0 = NB * 16 * SEQ + (b * 16 + h0) * CTXL;
        fa::Desc d{NQ + (size_t)(lat0 + r * 64) * 64, 64, NK, 64, NV, 64, lat0 + rs * 64, 8, ctx0, 12, P + q0 * PP + C_GNA + h0 * 64, PP, AB + q0 * ABW + 2048 + h0 * 64, ABW,
                   r, rs, rpb + h0 * 15 * 31, SEQ, CTXL};
        fa::unit_pipe<64, 64, 2, 2, 4>(lds, d); }
    if (l == 0) {
        const int x0 = split ? 64 : G / 2, x1 = split ? 64 : G / 2 + 32;
        for (int u = gid - x0; u >= 0 && u < NB * 8; u += G) { const int b = u >> 3, h = u & 7; const size_t q0 = (size_t)NLAT + b * CTXL; const int ctx0 = NB * 8 * SEQ + (b * 8 + h) * CTXL;
            fa::Desc d{QM + (size_t)ctx0 * 192, 192, KM, 192, VM, 128, ctx0, 4, 0, 4, P + q0 * PP + C_GML + h * 128, PP, AB + q0 * ABW + 1024 + h * 128, ABW, 0, 0, nullptr, 0, 0};
            fa::unit_pipe<192, 128, 0, 3, 1, true>(lds, d); }
        for (int u = gid - x1; u >= 0 && u < NB * 16; u += G) { const int b = u >> 4, h = u & 15; const size_t q0 = (size_t)NLAT + b * CTXL; const int ctx0 = NB * 16 * SEQ + (b * 16 + h) * CTXL;
            fa::Desc d{NQ + (size_t)ctx0 * 64, 64, NK, 64, NV, 64, ctx0, 4, 0, 4, P + q0 * PP + C_GNA + h * 64, PP, AB + q0 * ABW + 2048 + h * 64, ABW, 0, 0, nullptr, 0, 0};
            fa::unit_pipe<64, 64, 0, 4>(lds, d); }
    }
    __syncthreads();
}


#define XB_TMO      128
#define XB_XCNT(j)  (256  + 64 * (j))
#define XB_XSUB(j)  (1280 + 64 * (j))
#define XB_XGEN(j)  (2304 + 64 * (j))
#define XB_TOP      3328
#define XB_TOPGEN   3392
#define XCD_BAR_WORDS 3456
#define XB_SPIN_CAP (1u << 18)
__device__ __forceinline__ unsigned xb_ld(unsigned* p)              { return __hip_atomic_load(p, __ATOMIC_RELAXED, __HIP_MEMORY_SCOPE_AGENT); }
__device__ __forceinline__ unsigned xb_add(unsigned* p, unsigned v) { return __hip_atomic_fetch_add(p, v, __ATOMIC_RELAXED, __HIP_MEMORY_SCOPE_AGENT); }
__device__ __forceinline__ unsigned xb_xcc_id() { return (unsigned)__builtin_amdgcn_s_getreg((3 << 11) | 20) & 0xFu; }
#define XB_SPIN(cond, bar) do { unsigned _sp = 0; while (cond) { __builtin_amdgcn_s_sleep(1); \
    if ((++_sp & 255u) == 0u) { if (xb_ld(&(bar)[XB_TMO])) break; if (_sp > XB_SPIN_CAP) { atomicAdd(&(bar)[XB_TMO], 1u); break; } } } } while (0)
struct XcdBarrier { unsigned* bar; unsigned x; volatile LAS unsigned* st; };
__device__ __forceinline__ XcdBarrier xcd_barrier_post(unsigned* bar, volatile LAS unsigned* st) {
    XcdBarrier b; b.bar = bar; b.x = xb_xcc_id(); b.st = st;
    if (threadIdx.x == 0) (void)xb_add(&bar[XB_XCNT(b.x)], 1u);
    return b;
}
__device__ __forceinline__ void xcd_barrier_complete(unsigned* bar, unsigned x, unsigned& nloc, unsigned& nx) {
    const unsigned G = gridDim.x * gridDim.y * gridDim.z;
    unsigned sum, cnt, mine, sp = 0u;
    for (;;) {
        sum = 0u; cnt = 0u; mine = 0u;
#pragma unroll
        for (unsigned j = 0; j < 16; ++j) { const unsigned c = xb_ld(&bar[XB_XCNT(j)]); sum += c; cnt += (c > 0u) ? 1u : 0u; mine = (j == x) ? c : mine; }
        if (sum == G) break;
        __builtin_amdgcn_s_sleep(1);
        if ((++sp & 255u) == 0u) { if (xb_ld(&bar[XB_TMO])) break; if (sp > XB_SPIN_CAP) { atomicAdd(&bar[XB_TMO], 1u); break; } }
    }
    nloc = mine > 0u ? mine : 1u; nx = cnt > 0u ? cnt : 1u;
}
__device__ __forceinline__ void xcd_barrier(const XcdBarrier& b) {
    asm volatile("s_waitcnt vmcnt(0)" ::: "memory");
    __syncthreads();
    if (threadIdx.x == 0) {
        unsigned* bar = b.bar;
        __builtin_amdgcn_s_waitcnt(0);
        unsigned nloc = b.st[0], nx = b.st[1];
        if (nloc == 0u) { xcd_barrier_complete(bar, b.x, nloc, nx); b.st[0] = nloc; b.st[1] = nx; }
        const unsigned old = xb_add(&bar[XB_XSUB(b.x)], 1u);
        const unsigned gen = old / nloc;
        if (old + 1u == (gen + 1u) * nloc) {
            __builtin_amdgcn_fence(__ATOMIC_RELEASE, "agent");
            asm volatile("s_waitcnt vmcnt(0)" ::: "memory");
            const unsigned og = xb_add(&bar[XB_TOP], 1u);
            const unsigned tg = og / nx;
            if (og + 1u == (tg + 1u) * nx) xb_add(&bar[XB_TOPGEN], 1u);
            else XB_SPIN(xb_ld(&bar[XB_TOPGEN]) == tg, bar);
            __builtin_amdgcn_fence(__ATOMIC_ACQUIRE, "agent");
            xb_add(&bar[XB_XGEN(b.x)], 1u);
            asm volatile("s_waitcnt vmcnt(0)" ::: "memory");
        } else {
            XB_SPIN(xb_ld(&bar[XB_XGEN(b.x)]) == gen, bar);
            __builtin_amdgcn_fence(__ATOMIC_ACQUIRE, "agent");
            asm volatile("s_waitcnt vmcnt(0)" ::: "memory");
        }
    }
    __syncthreads();
}

#define WSB(off) (wsb() + (off))
__global__ void __launch_bounds__(NTHREADS, 2) fwd_megakernel(Params p) {
    extern __shared__ __attribute__((aligned(16))) unsigned char lds[];
    cg::grid_group grid = cg::this_grid();
    const int gid_ = blockIdx.x, G_ = gridDim.x;
    auto sop = [](int v) { asm volatile("" : "+s"(v)); return v; };
#define gid sop(gid_)
#define G sop(G_)

    { volatile LAS unsigned* st0 = (volatile LAS unsigned*)((LAS unsigned char*)lds + LDS_BYTES - 16); if (threadIdx.x < 4) st0[threadIdx.x] = 0u; __syncthreads(); }
    (void)xcd_barrier_post((unsigned*)(wsb() + WS_BAR), (volatile LAS unsigned*)((LAS unsigned char*)lds + LDS_BYTES - 16));
    if (wsb() == nullptr) grid.sync();
#define GSYNC() xcd_barrier(XcdBarrier{(unsigned*)(wsb() + WS_BAR), xb_xcc_id(), (volatile LAS unsigned*)((LAS unsigned char*)lds + LDS_BYTES - 16)})
    for (int rep = 0; rep < (PROBE_DUP == 0 ? 2 : 1); ++rep) { phase0(p, lds, gid, G); GSYNC(); }

    for (int rep = 0; rep < (PROBE_DUP == 1 ? 2 : 1); ++rep) { phase_uprep0(p, gid, G); GSYNC(); }
    for (int l = 0; l < DEPTH; ++l) {
        const int nq = (l == 0) ? NROW : NLAT;
        for (int rep = 0; rep < ((PROBE_DUP == 2 || PROBE_DUP == 3) ? 2 : 1); ++rep) {
            const gbf* WinT = (const gbf*)WSB(WS_WIN) + (size_t)l * NP * KP2; gbf* U = (gbf*)WSB(WS_U); gbf* P = (gbf*)WSB(WS_P);
            const EpiInProj E{P, 0, (gbf*)WSB(WS_NK), (gbf*)WSB(WS_NV), (gbf*)WSB(WS_NQ), (gbf*)WSB(WS_MG)};
            if (l == 0 && G == 256) {
                __syncthreads();
                { fg::SchedIn0 S{U, WinT, G, gid, 0, 11}; fg::gemm((LAS unsigned char*)lds, KP2, KP2, DM, S, E); }
                __syncthreads();
                GSYNC();
                phase_c1(p, l, NROW, gid, G);
                GSYNC();
            } else {
                gemm_run(lds, GemmJob{U, KP2, WinT, KP2, nq, NP, DM}, E, gid, G);
                GSYNC();
                if (l == 0) phase_c1(p, l, NROW, gid, G);
                else if (gid < 40) gemm_run(lds, GemmJob{(const gbf*)WSB(WS_U) + (size_t)NLAT * KP2, KP2, (const gbf*)WSB(WS_WIN) + (size_t)l * NP * KP2, KP2, NCTX, KVC_P, DM},
                                            EpiInProjC1{(gbf*)WSB(WS_P), (gbf*)WSB(WS_NK), (gbf*)WSB(WS_KM), (gf32*)WSB(WS_SSQ)}, gid, 40);
                else phase_c1(p, l, NLAT, gid - 40, G - 40);
                GSYNC();
            }
        }
        for (int rep = 0; rep < (PROBE_DUP == 4 ? 2 : 1); ++rep) {
            __syncthreads();
            { SchedC2 S{(const gbf*)WSB(WS_P), (const gbf*)WSB(WS_WUKV) + (size_t)l * 2048 * 256, (const gbf*)WSB(WS_WUQ) + (size_t)l * 1536 * 512, (const gbf*)WSB(WS_DC), nq / 256, l == 0 ? 32 : 0, G, gid,
                         (const gbf*)WSB(WS_U), (const gbf*)WSB(WS_WIN) + (size_t)l * NP * KP2, (l == 0 && G == 256) ? 64 : 0};
              EpiC2 E{(gbf*)WSB(WS_KM), (gbf*)WSB(WS_VM), (gbf*)WSB(WS_QM), (gbf*)WSB(WS_GT), (gbf*)WSB(WS_GTC), (const gf32*)WSB(WS_RKV), (const gf32*)WSB(WS_RQ), (const gf32*)WSB(WS_ROPE), l == 1 ? (const gf32*)WSB(WS_SSQ) : (const gf32*)nullptr, (gbf*)WSB(WS_MG)};
              fg::gemm_multi((LAS unsigned char*)lds, S, E); }
            __syncthreads();
            GSYNC();
        }
        for (int rep = 0; rep < (PROBE_DUP == 5 ? 2 : 1); ++rep) {
        phase_attn_fast(p, l, lds, gid, G);
        for (int rep2 = 0; rep2 < (PROBE_DUP == 52 ? 2 : 1); ++rep2)
        gemm_fast_z(lds, MapF2{(const gbf*)WSB(WS_DN), (const gbf*)WSB(WS_GT), KP4}, KP4, KP4, 2 * SEQ, SEQ / 512, 4, NB, EpiF2M{(gbf*)WSB(WS_AB), (const gbf*)WSB(WS_P), 0, SEQ},
                    (G != 256) ? (gid < 64 ? gid : -1) : (l == 0) ? ((gid >= 64 && gid < 128) ? gid - 64 : -1) : (gid < 64 ? gid : -1), 64);
        if (l == 0) gemm_fast_z(lds, MapF2{(const gbf*)WSB(WS_DNC), (const gbf*)WSB(WS_GTC), 2 * CTXL}, 2 * CTXL, 2 * CTXL, 2 * CTXL, 1, 4, NB, EpiF2{(gbf*)WSB(WS_AB), (const gbf*)WSB(WS_P), NLAT, CTXL}, gid - (G == 256 ? 96 : G / 2 + 96), G);
        GSYNC();
        }
        const gbf* WpT = (const gbf*)WSB(WS_WP) + (size_t)l * 4 * 2048 * KP1; const gbf* WoT = (const gbf*)WSB(WS_WO) + (size_t)l * 2048 * KP2;
        const int NC = G / 8;
        for (int rep = 0; rep < (PROBE_DUP == 6 ? 2 : 1); ++rep) {
          __syncthreads();
          { fg::SchedBranch S{(const gbf*)WSB(WS_AB), WpT, NLAT / 256, DM / 256, G, gid, 0};
            fg::gemm((LAS unsigned char*)lds, ABW, KP1, 1024, S, EpiChain{(gbf*)WSB(WS_MB), (const gbf*)WSB(WS_MG), 0}); }
          __syncthreads();
          GSYNC();
        }
        for (int rep = 0; rep < (PROBE_DUP == 7 ? 2 : 1); ++rep) {
          if (l == 0) {
            __syncthreads();
            const int NH = (G >= 128) ? 2 * NC : 0;
            if (NH == 0 && gid < NC) { fg::SchedBranch S{(const gbf*)WSB(WS_AB), WpT, NCTX / 256, DM / 256, NC, gid, NLAT / 256};
                            fg::gemm((LAS unsigned char*)lds, ABW, KP1, 1024, S, EpiChain{(gbf*)WSB(WS_MB), (const gbf*)WSB(WS_MG), NLAT}); }
            else if (gid < NH) { fg::SchedBranchH S{(const gbf*)WSB(WS_AB), WpT, NCTX / 256, DM / 256, gid, NLAT / 256};
                            fg::gemm((LAS unsigned char*)lds, ABW, KP1, 1024, S, EpiChainH{(gbf*)WSB(WS_MB), (const gbf*)WSB(WS_MG), NLAT, (gf32*)WSB(WS_MF), (unsigned*)WSB(WS_BAR) + HC_FLAG0}); }
            else { const int nf = NH ? NH : NC; fg::Sched<fg::MapPlain> S{fg::MapPlain{(const gbf*)WSB(WS_MB), KP2, WoT, KP2}, NLAT / 256, DM / 256, 1, G - nf, gid - nf};
                   fg::gemm((LAS unsigned char*)lds, KP2, KP2, DM, S, EpiOut{(gf32*)WSB(WS_Y), 0}); }
            __syncthreads();
          } else gemm_run(lds, GemmJob{(const gbf*)WSB(WS_MB), KP2, WoT, KP2, NLAT, DM, DM}, EpiOut{(gf32*)WSB(WS_Y), 0}, gid, G);
          GSYNC();
        }
        for (int rep = 0; rep < (PROBE_DUP == 8 ? 2 : 1); ++rep) {
          if (l == 0) {
            if (gid < NC) gemm_run(lds, GemmJob{(const gbf*)WSB(WS_MB) + (size_t)NLAT * KP2, KP2, WoT, KP2, NCTX, DM, DM}, EpiOut{(gf32*)WSB(WS_Y), NLAT}, gid, NC);
            else phase_final(p, l, 0, NLAT, gid - NC, G - NC);
            GSYNC();
            phase_final(p, l, NLAT, NROW, gid, G);
            GSYNC();
          } else {
            phase_final(p, l, 0, NLAT, gid, G);
            if (rep + 1 < (PROBE_DUP == 8 ? 2 : 1)) GSYNC();
          }
        }
    }
}
#undef gid
#undef G

extern "C" void kernel_launch(void* const* d_in, const int* in_sizes, int n_in, void* d_out, int out_size, void* d_ws, size_t ws_size, hipStream_t stream) {
    static int grid_blocks = 0;
    if (grid_blocks == 0) {
        if (n_in != 20 || out_size != NLAT * DM || ws_size < WS_END) { fprintf(stderr, "kernel_launch: unexpected shapes (n_in %d out %d ws %zu, need ws >= %zu)\n", n_in, out_size, ws_size, (size_t)WS_END); grid_blocks = -1; return; }
        int dev = 0, cus = 0, per_cu = 0;
        hipGetDevice(&dev);
        hipDeviceGetAttribute(&cus, hipDeviceAttributeMultiprocessorCount, dev);
        if (hipFuncSetAttribute((const void*)fwd_megakernel, hipFuncAttributeMaxDynamicSharedMemorySize, LDS_BYTES) != hipSuccess) { fprintf(stderr, "kernel_launch: hipFuncSetAttribute failed\n"); grid_blocks = -1; return; }
        if (hipOccupancyMaxActiveBlocksPerMultiprocessor(&per_cu, (const void*)fwd_megakernel, NTHREADS, LDS_BYTES) != hipSuccess || per_cu < 1) { fprintf(stderr, "kernel_launch: occupancy query failed (%d)\n", per_cu); grid_blocks = -1; return; }
        grid_blocks = cus;
        fprintf(stderr, "kernel_launch: cus %d per_cu %d grid %d\n", cus, per_cu, grid_blocks);
    }
    if (grid_blocks < 0) return;
    if (hipMemsetAsync((char*)d_ws + WS_BAR, 0, 16384, stream) != hipSuccess) { fprintf(stderr, "kernel_launch: hipMemsetAsync of the barrier words failed\n"); return; }
    Params p{};
    for (int i = 0; i < 20; ++i) p.in[i] = (const gf32*)d_in[i];
    p.out = (gf32*)d_out; p.ws = (gu8*)d_ws;
    void* args[] = {&p};
    hipError_t e = hipLaunchCooperativeKernel((const void*)fwd_megakernel, dim3(grid_blocks), dim3(NTHREADS), args, LDS_BYTES, stream);
    if (e != hipSuccess) fprintf(stderr, "kernel_launch: cooperative launch failed: %s (grid %d)\n", hipGetErrorString(e), grid_blocks);
}
```
